# Optimizing an MI355X kernel written in HIP

```python
import math
import jax, jax.numpy as jnp
from jax import lax
import numpy as np

D_MODEL = 1024
BATCH = 4
SEQ = 4096
DEPTH = 2
DEC_BATCH = 128
DEC_SEQ = 4
PAST_LEN = 2048
PAGE_SIZE = 128

N_EVEN = (DEPTH + 1) // 2
N_ODD = DEPTH // 2

H_A = 8
HD_A = 64
W_A = H_A * HD_A
MOBA_BLOCK = 256
MOBA_TOPK = 3
MOBA_Q_BLOCK = 32
NUM_BUCKETS = 32
MAX_DISTANCE = 128

H_B = 4
DK_B = 64
DV_B = 128
W_B = H_B * DV_B
RET_CHUNK = 128

E_SPLITS = (W_A, W_A, W_A, W_A, H_B * DK_B, H_B * DK_B, W_B, W_B)
E_IN = sum(E_SPLITS)
E_MIX = W_A + W_B

G_C = 4
W_C = 512
DG_C = W_C // G_C
SGU_CHUNK = 128

H_D = 8
P_D = 64
N_D = 128
G_D = 2
HPG_D = H_D // G_D
W_D = H_D * P_D
CONV_W = 4
CONV_DIM = W_D + 2 * G_D * N_D
SSD_CHUNK = 128

O_SPLITS = (W_C, W_C, W_C, W_D, CONV_DIM, H_D)
O_IN = sum(O_SPLITS)
O_MIX = W_C + W_D

NEG_INF = -1e30
EPS = 1e-6

kernel_name = "hybrid_moba_retention_sgu_ssd_step"


def rms_norm(x, w=None):
    xf = x.astype(jnp.float32)
    y = xf * lax.rsqrt(jnp.mean(xf * xf, axis=-1, keepdims=True) + EPS)
    if w is not None:
        y = y * w.astype(jnp.float32)
    return y.astype(x.dtype)


def layer_norm(x):
    xf = x.astype(jnp.float32)
    mu = jnp.mean(xf, axis=-1, keepdims=True)
    var = jnp.mean(jnp.square(xf - mu), axis=-1, keepdims=True)
    return ((xf - mu) * lax.rsqrt(var + EPS)).astype(x.dtype)


def split_cols(z, sizes):
    return jnp.split(z, [int(s) for s in np.cumsum(sizes)[:-1]], axis=-1)


def to_chunks(a, c):
    b, s = a.shape[:2]
    return a.reshape(b, s // c, c, *a.shape[2:]).swapaxes(0, 1)


def from_chunks(a):
    n, b, c = a.shape[:3]
    return a.swapaxes(0, 1).reshape(b, n * c, *a.shape[3:])


def adaln_in(x, c, norm_w, ada_w, ada_b):
    mod = jnp.einsum('bd,de->be', jax.nn.silu(c), ada_w) + ada_b
    shift, scale, gate = jnp.split(mod, 3, axis=-1)
    h = rms_norm(x, norm_w) * (1.0 + scale[:, None]) + shift[:, None]
    return h, gate[:, None]


def t5_bucket(rel):
    n = jnp.maximum(rel, 0)
    max_exact = NUM_BUCKETS // 2
    nf = jnp.maximum(n, 1).astype(jnp.float32)
    large = max_exact + (jnp.log(nf / max_exact) / math.log(MAX_DISTANCE / max_exact)
                         * (NUM_BUCKETS - max_exact)).astype(jnp.int32)
    large = jnp.minimum(large, NUM_BUCKETS - 1)
    return jnp.where(n < max_exact, n, large)


def rotary(x, pos):
    half = x.shape[-1] // 2
    inv = 1.0 / (10000.0 ** (jnp.arange(half, dtype=jnp.float32) / half))
    ang = pos.astype(jnp.float32)[:, None] * inv[None, :]
    cos = jnp.cos(ang)[None, :, None, :].astype(x.dtype)
    sin = jnp.sin(ang)[None, :, None, :].astype(x.dtype)
    x1, x2 = x[..., :half], x[..., half:]
    return jnp.concatenate([x1 * cos - x2 * sin, x1 * sin + x2 * cos], axis=-1)


def moba_attend(q, q_pos, own_k, own_v, own_pos, rel_bias, sel_kv):
    b, nq, h, d = q.shape
    scale = d ** -0.5
    tab = rel_bias.astype(jnp.float32)
    lo = jnp.einsum('bqhd,bjhd->bhqj', q, own_k).astype(jnp.float32) * scale
    lo = lo + tab[t5_bucket(q_pos[:, None] - own_pos[None, :])].transpose(2, 0, 1)
    lo = jnp.where(own_pos[None, :] <= q_pos[:, None], lo, NEG_INF)
    if sel_kv is None:
        p = jax.nn.softmax(lo, axis=-1).astype(own_v.dtype)
        return jnp.einsum('bhqj,bjhd->bqhd', p, own_v)
    sk, sv, spos, svalid = sel_kv
    nk = sk.shape[3]
    hidx = jnp.arange(h)[None, :, None, None, None]
    ls = jnp.einsum('bqhd,bhqkjd->bhqkj', q, sk).astype(jnp.float32) * scale
    ls = ls + tab[t5_bucket(q_pos[None, None, :, None, None] - spos), hidx]
    ls = jnp.where(svalid[..., None], ls, NEG_INF).reshape(b, h, nq, nk * MOBA_BLOCK)
    p = jax.nn.softmax(jnp.concatenate([ls, lo], axis=-1), axis=-1).astype(own_v.dtype)
    n_sel_rows = nk * MOBA_BLOCK
    out = jnp.einsum('bhqj,bjhd->bqhd', p[..., n_sel_rows:], own_v)
    out = out + jnp.einsum('bhqkj,bhqkjd->bqhd',
                           p[..., :n_sel_rows].reshape(b, h, nq, nk, MOBA_BLOCK), sv)
    return out


def moba_prompt(q, k, v, rel_bias):
    B, S, H, D = q.shape
    nb = -(-S // MOBA_BLOCK)
    pad = nb * MOBA_BLOCK - S
    kb = jnp.pad(k, ((0, 0), (0, pad), (0, 0), (0, 0))).reshape(B, nb, MOBA_BLOCK, H, D)
    vb = jnp.pad(v, ((0, 0), (0, pad), (0, 0), (0, 0))).reshape(B, nb, MOBA_BLOCK, H, D)
    n_sel = min(MOBA_TOPK, nb - 1)
    if n_sel > 0:
        kmean = kb.astype(jnp.float32).mean(axis=2)
        gate = jnp.einsum('bshd,bnhd->bhsn', q.astype(jnp.float32), kmean)
        qblk = jnp.arange(S) // MOBA_BLOCK
        gate = jnp.where(jnp.arange(nb)[None, :] < qblk[:, None], gate, NEG_INF)
        _, sel = lax.top_k(gate, n_sel)
        sel_valid = sel < qblk[None, None, :, None]
    bidx = jnp.arange(B)[:, None, None, None]
    hidx = jnp.arange(H)[None, :, None, None]
    blk_off = jnp.arange(MOBA_BLOCK)

    def one_query_block(i):
        s0 = i * MOBA_Q_BLOCK
        qc = lax.dynamic_slice_in_dim(q, s0, MOBA_Q_BLOCK, axis=1)
        q_pos = s0 + jnp.arange(MOBA_Q_BLOCK)
        ob = s0 // MOBA_BLOCK
        own_k = lax.dynamic_index_in_dim(kb, ob, axis=1, keepdims=False)
        own_v = lax.dynamic_index_in_dim(vb, ob, axis=1, keepdims=False)
        own_pos = ob * MOBA_BLOCK + blk_off
        sel_kv = None
        if n_sel > 0:
            sc = lax.dynamic_slice_in_dim(sel, s0, MOBA_Q_BLOCK, axis=2)
            vc = lax.dynamic_slice_in_dim(sel_valid, s0, MOBA_Q_BLOCK, axis=2)
            sel_kv = (kb[bidx, sc, :, hidx], vb[bidx, sc, :, hidx],
                      sc[..., None] * MOBA_BLOCK + blk_off, vc)
        return moba_attend(qc, q_pos, own_k, own_v, own_pos, rel_bias, sel_kv)

    out = lax.map(one_query_block, jnp.arange(S // MOBA_Q_BLOCK))
    return from_chunks(out)


def moba_sample(q, k_new, v_new, cache_k, cache_v, page_table, rel_bias):
    DB, T, H, D = q.shape
    ppb = MOBA_BLOCK // PAGE_SIZE
    npb = PAST_LEN // MOBA_BLOCK
    own_start = npb * MOBA_BLOCK
    q_pos = PAST_LEN + jnp.arange(T)
    pt_own = page_table[:, own_start // PAGE_SIZE:]
    n_own = pt_own.shape[1] * PAGE_SIZE
    own_k = jnp.concatenate([cache_k[pt_own].reshape(DB, n_own, H, D), k_new], axis=1)
    own_v = jnp.concatenate([cache_v[pt_own].reshape(DB, n_own, H, D), v_new], axis=1)
    own_pos = own_start + jnp.arange(n_own + T)
    n_sel = min(MOBA_TOPK, npb)
    sel_kv = None
    if n_sel > 0:
        page_mean = cache_k.astype(jnp.float32).mean(axis=1)
        kmean = page_mean[page_table[:, :npb * ppb]].reshape(DB, npb, ppb, H, D).mean(axis=2)
        gate = jnp.einsum('bthd,bnhd->bhtn', q.astype(jnp.float32), kmean)
        _, sel = lax.top_k(gate, n_sel)
        bidx = jnp.arange(DB)[:, None, None, None, None]
        hidx = jnp.arange(H)[None, :, None, None, None]
        phys = page_table[bidx, sel[..., None] * ppb + jnp.arange(ppb)]
        sk = cache_k[phys, :, hidx].reshape(DB, H, T, n_sel, MOBA_BLOCK, D)
        sv = cache_v[phys, :, hidx].reshape(DB, H, T, n_sel, MOBA_BLOCK, D)
        spos = sel[..., None] * MOBA_BLOCK + jnp.arange(MOBA_BLOCK)
        sel_kv = (sk, sv, spos, jnp.ones(sel.shape, bool))
    return moba_attend(q, q_pos, own_k, own_v, own_pos, rel_bias, sel_kv)


def retention_chunk(state, q, k, v):
    L = q.shape[1]
    log_g = jnp.log(1.0 - 2.0 ** (-5.0 - jnp.arange(H_B, dtype=jnp.float32)))
    idx = jnp.arange(L, dtype=jnp.float32)
    diff = idx[:, None] - idx[None, :]
    dmat = jnp.where((diff >= 0)[..., None], jnp.exp(jnp.maximum(diff, 0.0)[..., None] * log_g), 0.0)
    dmat = dmat.transpose(2, 0, 1).astype(q.dtype)
    scores = jnp.einsum('bihd,bjhd->bhij', q, k) * dmat
    out = jnp.einsum('bhij,bjhe->bihe', scores, v)
    q_dec = jnp.exp((idx + 1.0)[:, None] * log_g).astype(q.dtype)
    out = out + jnp.einsum('bihd,bhde->bihe', q * q_dec[None, :, :, None], state)
    k_dec = jnp.exp((L - 1.0 - idx)[:, None] * log_g).astype(k.dtype)
    new_state = (state * jnp.exp(L * log_g).astype(state.dtype)[None, :, None, None]
                 + jnp.einsum('bjhd,bjhe->bhde', k * k_dec[None, :, :, None], v))
    return new_state, out


def retention_prompt(q, k, v):
    state0 = jnp.zeros((q.shape[0], H_B, DK_B, DV_B), v.dtype)

    def step(st, inp):
        return retention_chunk(st, *inp)

    st, out = lax.scan(step, state0, (to_chunks(q, RET_CHUNK), to_chunks(k, RET_CHUNK),
                                      to_chunks(v, RET_CHUNK)))
    return st, from_chunks(out)


def ssd_chunk(state, x, dt, A, Bm, Cm):
    L = x.shape[1]
    a = (dt * A).astype(jnp.float32)
    cum = jnp.cumsum(a, axis=1)
    seg = cum[:, :, None] - cum[:, None, :]
    causal = jnp.tril(jnp.ones((L, L), bool))[None, :, :, None, None]
    decay = jnp.exp(jnp.where(causal, seg, -jnp.inf)).astype(x.dtype)
    cb = jnp.einsum('bign,bjgn->bijg', Cm, Bm)
    y = jnp.einsum('bijg,bijgh,bjgh,bjghp->bighp', cb, decay, dt, x)
    y = y + jnp.einsum('bign,bghpn,bigh->bighp', Cm, state, jnp.exp(cum).astype(x.dtype))
    last = cum[:, -1]
    w = jnp.exp(last[:, None] - cum).astype(x.dtype) * dt
    new_state = (state * jnp.exp(last).astype(x.dtype)[..., None, None]
                 + jnp.einsum('bjgn,bjgh,bjghp->bghpn', Bm, w, x))
    return new_state, y


def ssd_prompt(x, dt, A, Bm, Cm):
    state0 = jnp.zeros((x.shape[0], G_D, HPG_D, P_D, N_D), x.dtype)

    def step(st, inp):
        xc, dtc, bc, cc = inp
        return ssd_chunk(st, xc, dtc, A, bc, cc)

    st, y = lax.scan(step, state0, (to_chunks(x, SSD_CHUNK), to_chunks(dt, SSD_CHUNK),
                                    to_chunks(Bm, SSD_CHUNK), to_chunks(Cm, SSD_CHUNK)))
    return st, from_chunks(y)


def dwconv(xpad, w, b):
    c = xpad.shape[-1]
    out = lax.conv_general_dilated(xpad, w[:, None, :], (1,), 'VALID',
                                   dimension_numbers=('NWC', 'WIO', 'NWC'),
                                   feature_group_count=c)
    return out + b


def even_mix(h, pos, in_w, q_norm_w, k_norm_w):
    b, L, _ = h.shape
    z = jnp.einsum('bld,de->ble', h, in_w)
    qa, ka, va, ga, qb, kb, vb, gb = split_cols(z, E_SPLITS)
    qa = rms_norm(qa.reshape(b, L, H_A, HD_A), q_norm_w)
    ka = rms_norm(ka.reshape(b, L, H_A, HD_A), k_norm_w)
    va = va.reshape(b, L, H_A, HD_A)
    qb = rotary(qb.reshape(b, L, H_B, DK_B), pos)
    kb = rotary(kb.reshape(b, L, H_B, DK_B), pos) * (DK_B ** -0.5)
    vb = vb.reshape(b, L, H_B, DV_B)
    return qa, ka, va, ga, qb, kb, vb, gb


def even_out(oa, ga, ob, gb, out_w):
    b, L = oa.shape[:2]
    oa = oa.reshape(b, L, W_A) * jax.nn.silu(ga)
    ob = rms_norm(ob).reshape(b, L, W_B) * jax.nn.silu(gb)
    return jnp.einsum('ble,ed->bld', jnp.concatenate([oa, ob], axis=-1), out_w)


def odd_mix(h, in_w):
    z = jnp.einsum('bld,de->ble', h, in_w)
    u, v, gc, zg, xbc, dt = split_cols(z, O_SPLITS)
    u = jax.nn.gelu(u)
    v = layer_norm(jax.nn.gelu(v))
    return u, v, gc, zg, xbc, dt


def sgu_prompt(v, sgu_w, sgu_b):
    b, s, _ = v.shape
    w = jnp.tril(sgu_w)
    vc = v.reshape(b, s // SGU_CHUNK, SGU_CHUNK, G_C, DG_C)
    out = jnp.einsum('gij,bcjgd->bcigd', w, vc) + sgu_b.T[None, None, :, :, None]
    return out.reshape(b, s, W_C)


def sgu_sample(v, sgu_w, sgu_b):
    b, t, _ = v.shape
    w = jnp.tril(sgu_w[:, :t, :t])
    out = jnp.einsum('gij,bjgd->bigd', w, v.reshape(b, t, G_C, DG_C)) + sgu_b[:, :t].T[None, :, :, None]
    return out.reshape(b, t, W_C)


def ssd_inputs(conv_out, dt, dt_bias, a_log):
    b, L = conv_out.shape[:2]
    xh, bm, cm = split_cols(jax.nn.silu(conv_out), (W_D, G_D * N_D, G_D * N_D))
    xh = xh.reshape(b, L, G_D, HPG_D, P_D)
    bm = bm.reshape(b, L, G_D, N_D)
    cm = cm.reshape(b, L, G_D, N_D)
    dth = jax.nn.softplus(dt + dt_bias).reshape(b, L, G_D, HPG_D)
    A = -jnp.exp(a_log.astype(jnp.float32)).reshape(G_D, HPG_D)
    return xh, dth, A, bm, cm


def odd_out(u, s, gc, y, xh, d_skip, zg, ssm_norm_w, out_w):
    b, L = u.shape[:2]
    oc = u * s * jax.nn.silu(gc)
    y = y + xh * d_skip.reshape(G_D, HPG_D)[:, :, None]
    y = y.reshape(b, L, W_D) * jax.nn.silu(zg)
    y = rms_norm(y.reshape(b, L, G_D, W_D // G_D), ssm_norm_w.reshape(G_D, W_D // G_D)).reshape(b, L, W_D)
    return jnp.einsum('ble,ed->bld', jnp.concatenate([oc, y], axis=-1), out_w)


def setup_inputs(seed: int = 0) -> dict:
    key = jax.random.key(seed)
    keys = iter(jax.random.split(key, 40))

    def nrm(shape, scale):
        return jax.random.normal(next(keys), shape, jnp.float32) * scale

    n_pages = PAST_LEN // PAGE_SIZE
    n_used = DEC_BATCH * n_pages
    n_phys = n_used + max(1, n_used // 4)
    page_table = jax.random.permutation(next(keys), n_phys)[:n_used].reshape(DEC_BATCH, n_pages).astype(jnp.int32)
    dt0 = jnp.exp(jax.random.uniform(next(keys), (N_ODD, H_D), jnp.float32,
                                     minval=math.log(1e-3), maxval=math.log(1e-1)))
    dt_bias = dt0 + jnp.log(-jnp.expm1(-dt0))
    a_log = jnp.log(jax.random.uniform(next(keys), (N_ODD, H_D), jnp.float32, minval=1.0, maxval=16.0))
    d = D_MODEL
    return {
        "x_prompt": nrm((BATCH, SEQ, d), 1.0),
        "x_sample": nrm((DEC_BATCH, DEC_SEQ, d), 1.0),
        "cache_k": nrm((N_EVEN, n_phys, PAGE_SIZE, H_A, HD_A), 1.0),
        "cache_v": nrm((N_EVEN, n_phys, PAGE_SIZE, H_A, HD_A), 1.0),
        "state_ret": nrm((N_EVEN, DEC_BATCH, H_B, DK_B, DV_B), 1.0),
        "state_ssm": nrm((N_ODD, DEC_BATCH, H_D, P_D, N_D), 0.5),
        "state_conv": nrm((N_ODD, DEC_BATCH, CONV_W - 1, CONV_DIM), 1.0),
        "page_table": page_table,
        "c_prompt": nrm((BATCH, d), 1.0),
        "c_sample": nrm((DEC_BATCH, d), 1.0),
        "rel_bias": nrm((NUM_BUCKETS, H_A), 0.5),
        "e_norm_w": 1.0 + nrm((N_EVEN, d), 0.02),
        "e_ada_w": nrm((N_EVEN, d, 3 * d), 0.5 * d ** -0.5),
        "e_ada_b": nrm((N_EVEN, 3 * d), 0.01),
        "e_in_w": nrm((N_EVEN, d, E_IN), d ** -0.5),
        "e_q_norm_w": 1.0 + nrm((N_EVEN, HD_A), 0.02),
        "e_k_norm_w": 1.0 + nrm((N_EVEN, HD_A), 0.02),
        "e_out_w": nrm((N_EVEN, E_MIX, d), E_MIX ** -0.5),
        "o_norm_w": 1.0 + nrm((N_ODD, d), 0.02),
        "o_ada_w": nrm((N_ODD, d, 3 * d), 0.5 * d ** -0.5),
        "o_ada_b": nrm((N_ODD, 3 * d), 0.01),
        "o_in_w": nrm((N_ODD, d, O_IN), d ** -0.5),
        "o_sgu_w": nrm((N_ODD, G_C, SGU_CHUNK, SGU_CHUNK), SGU_CHUNK ** -0.5),
        "o_sgu_b": 1.0 + nrm((N_ODD, G_C, SGU_CHUNK), 0.01),
        "o_conv_w": nrm((N_ODD, CONV_W, CONV_DIM), CONV_W ** -0.5),
        "o_conv_b": nrm((N_ODD, CONV_DIM), 0.01),
        "o_dt_bias": dt_bias,
        "o_A_log": a_log,
        "o_D": 1.0 + nrm((N_ODD, H_D), 0.02),
        "o_ssm_norm_w": 1.0 + nrm((N_ODD, W_D), 0.02),
        "o_out_w": nrm((N_ODD, O_MIX, d), O_MIX ** -0.5),
    }


def reference(x_prompt, x_sample, cache_k, cache_v, state_ret, state_ssm, state_conv, page_table,
              c_prompt, c_sample, rel_bias, e_norm_w, e_ada_w, e_ada_b, e_in_w, e_q_norm_w, e_k_norm_w,
              e_out_w, o_norm_w, o_ada_w, o_ada_b, o_in_w, o_sgu_w, o_sgu_b, o_conv_w, o_conv_b,
              o_dt_bias, o_A_log, o_D, o_ssm_norm_w, o_out_w):
    xp, xs = x_prompt, x_sample
    bp, s_len = xp.shape[:2]
    bs, t_len = xs.shape[:2]
    pos_p = jnp.arange(s_len)
    pos_s = PAST_LEN + jnp.arange(t_len)
    kp_l, vp_l, ks_l, vs_l, retp_l, rets_l = [], [], [], [], [], []
    sguv_l, ssmp_l, ssms_l, convp_l, convs_l = [], [], [], [], []
    for layer in range(DEPTH):
        i = layer // 2
        if layer % 2 == 0:
            h, g = adaln_in(xp, c_prompt, e_norm_w[i], e_ada_w[i], e_ada_b[i])
            qa, ka, va, ga, qb, kb, vb, gb = even_mix(h, pos_p, e_in_w[i], e_q_norm_w[i], e_k_norm_w[i])
            oa = moba_prompt(qa, ka, va, rel_bias)
            st, ob = retention_prompt(qb, kb, vb)
            xp = xp + g * even_out(oa, ga, ob, gb, e_out_w[i])
            kp_l.append(ka)
            vp_l.append(va)
            retp_l.append(st)
            h, g = adaln_in(xs, c_sample, e_norm_w[i], e_ada_w[i], e_ada_b[i])
            qa, ka, va, ga, qb, kb, vb, gb = even_mix(h, pos_s, e_in_w[i], e_q_norm_w[i], e_k_norm_w[i])
            oa = moba_sample(qa, ka, va, cache_k[i], cache_v[i], page_table, rel_bias)
            st, ob = retention_chunk(state_ret[i], qb, kb, vb)
            xs = xs + g * even_out(oa, ga, ob, gb, e_out_w[i])
            ks_l.append(ka)
            vs_l.append(va)
            rets_l.append(st)
        else:
            h, g = adaln_in(xp, c_prompt, o_norm_w[i], o_ada_w[i], o_ada_b[i])
            u, v, gc, zg, xbc, dt = odd_mix(h, o_in_w[i])
            sg = sgu_prompt(v, o_sgu_w[i], o_sgu_b[i])
            conv_out = dwconv(jnp.pad(xbc, ((0, 0), (CONV_W - 1, 0), (0, 0))), o_conv_w[i], o_conv_b[i])
            xh, dth, A, bm, cm = ssd_inputs(conv_out, dt, o_dt_bias[i], o_A_log[i])
            st, y = ssd_prompt(xh, dth, A, bm, cm)
            xp = xp + g * odd_out(u, sg, gc, y, xh, o_D[i], zg, o_ssm_norm_w[i], o_out_w[i])
            ssmp_l.append(st.reshape(bp, H_D, P_D, N_D))
            convp_l.append(xbc[:, -(CONV_W - 1):])
            h, g = adaln_in(xs, c_sample, o_norm_w[i], o_ada_w[i], o_ada_b[i])
            u, v, gc, zg, xbc, dt = odd_mix(h, o_in_w[i])
            sg = sgu_sample(v, o_sgu_w[i], o_sgu_b[i])
            xin = jnp.concatenate([state_conv[i], xbc], axis=1)
            conv_out = dwconv(xin, o_conv_w[i], o_conv_b[i])
            xh, dth, A, bm, cm = ssd_inputs(conv_out, dt, o_dt_bias[i], o_A_log[i])
            st, y = ssd_chunk(state_ssm[i].reshape(bs, G_D, HPG_D, P_D, N_D), xh, dth, A, bm, cm)
            xs = xs + g * odd_out(u, sg, gc, y, xh, o_D[i], zg, o_ssm_norm_w[i], o_out_w[i])
            sguv_l.append(v)
            ssms_l.append(st.reshape(bs, H_D, P_D, N_D))
            convs_l.append(xin[:, -(CONV_W - 1):])
    k_prompt = jnp.stack(kp_l)
    v_prompt = jnp.stack(vp_l)
    k_sample = jnp.stack(ks_l)
    v_sample = jnp.stack(vs_l)
    ret_state_prompt = jnp.stack(retp_l)
    ret_state_sample = jnp.stack(rets_l)
    sgu_v_sample = jnp.stack(sguv_l)
    ssm_state_prompt = jnp.stack(ssmp_l)
    ssm_state_sample = jnp.stack(ssms_l)
    conv_state_prompt = jnp.stack(convp_l)
    conv_state_sample = jnp.stack(convs_l)
    return (xp, xs, k_prompt, v_prompt, k_sample, v_sample, ret_state_prompt, ret_state_sample,
            sgu_v_sample, ssm_state_prompt, ssm_state_sample, conv_state_prompt, conv_state_sample)
```

```cpp
#include <hip/hip_runtime.h>
#include <cstdio>
#include <cstdint>
#include <hip/hip_bf16.h>
#include <cmath>
namespace pg8 {
#define PG8_LAS __attribute__((address_space(3)))
typedef unsigned short bf16_t;
typedef short bf16x8 __attribute__((ext_vector_type(8)));
typedef float f32x4 __attribute__((ext_vector_type(4)));
typedef unsigned u32x4 __attribute__((ext_vector_type(4)));
constexpr int BM = 256, BK = 64, HALF = 128, HTB = HALF * BK * 2  , STAGE_BYTES = 8 * HTB, NXCD = 8, WGM = 8;

__host__ __device__ __forceinline__ int lds_byte(int r, int c) { const int st = (r >> 4) * 2 + (c >> 5), rr = r & 15, cc = c & 31, ob = rr * 64 + cc * 2; return st * 1024 + (ob ^ (((ob >> 9) & 1) << 5)); }
__host__ __device__ __forceinline__ void stage_rc(int b, int& R, int& C) { const int st = b / 1024, sb = b % 1024, swz = sb ^ (((sb >> 9) & 1) << 5); R = (st >> 1) * 16 + swz / 64; C = (st & 1) * 32 + (swz % 64) / 2; }
__host__ __device__ __forceinline__ int perm32(int rho) { const int n = rho >> 4, i = rho & 15; return 8 * (i >> 2) + 4 * n + (i & 3); }

struct Unit { int pm, pn; };
struct Gemm { const bf16_t* A; const bf16_t* Bt; int M, N, K; };

struct StaticOrder {
    int nM, nN, nwg, G, c;
    __host__ __device__ void init(int M, int N, int G_, int c_) { nM = M / BM; nN = N / BM; nwg = nM * nN; G = G_; c = c_; }
    __host__ __device__ bool next(int i, Unit& u) const {
        const long L = (long)i * G + c; if (L >= nwg) return false;
        int wgid = (int)L; { const int q = nwg / NXCD, r = nwg % NXCD, xcd = wgid % NXCD, off = wgid / NXCD; wgid = (xcd < r ? xcd * (q + 1) : r * (q + 1) + (xcd - r) * q) + off; }
        const int nig = WGM * nN, gid = wgid / nig, fm = gid * WGM, gsz = (nM - fm) < WGM ? (nM - fm) : WGM;
        u.pm = fm + ((wgid % nig) % gsz); u.pn = (wgid % nig) / gsz; return true;
    }
    __device__ __forceinline__ void a_ready(const Unit&) const {}
    __device__ __forceinline__ void done(const Unit&) const {}
};
__device__ __forceinline__ unsigned cvt_pk_bf16(float lo, float hi) { unsigned r; asm volatile("v_cvt_pk_bf16_f32 %0, %1, %2" : "=v"(r) : "v"(lo), "v"(hi)); return r; }

template <class Epi, class Sched, bool ALIGN_EPI = false, bool SP2 = false>
__device__ __forceinline__ void gemm_phase(PG8_LAS unsigned char* lds, const Gemm g, const Sched& S, const Epi& E) {
    const int tid = threadIdx.x, wid = __builtin_amdgcn_readfirstlane(tid >> 6), lane = tid & 63, wr = wid >> 2, wc = wid & 3, fr = lane & 15, fq = lane >> 4;
    const int K = g.K, nt = K / BK;
    unsigned voffA[2], voffB[2];
#pragma unroll
    for (int i = 0; i < 2; ++i) { int R, C; stage_rc(tid * 16 + i * 8192, R, C); const int Rb = Epi::PERM ? ((R & ~31) + perm32(R & 31)) : R;
        voffA[i] = (unsigned)(R * K + C) * 2u; voffB[i] = (unsigned)(Rb * K + C) * 2u; }
    const size_t kstep = (size_t)(BK * 2);
    const size_t hstep = (size_t)HALF * K * 2;
    const size_t tstep = 2 * hstep;
    const unsigned ldsw = (unsigned)wid * 1024u;
    const int aoff = lds_byte(wr * 64 + fr, fq * 8), boff = lds_byte(wc * 32 + fr, fq * 8);
#define PG8_SA(b, h) (((b) * 2 + (h)) * HTB)
#define PG8_SB(b, h) ((4 + (b) * 2 + (h)) * HTB)
#define PG8_STAGE(bufoff, gbase, voff) do { _Pragma("unroll") for (int _i = 0; _i < 2; ++_i) \
        __builtin_amdgcn_global_load_lds((const unsigned*)((const char*)(gbase) + (voff)[_i]), (PG8_LAS unsigned*)(lds + (bufoff) + ldsw + _i * 8192), 16, 0, 0); } while (0)
#define PG8_LDA(dst, b, h) do { _Pragma("unroll") for (int m = 0; m < 4; ++m) _Pragma("unroll") for (int k = 0; k < 2; ++k) dst[m][k] = *(const PG8_LAS bf16x8*)(lds + PG8_SA(b, h) + aoff + m * 2048 + k * 1024); } while (0)
#define PG8_LDB(dst, b, h) do { _Pragma("unroll") for (int n = 0; n < 2; ++n) _Pragma("unroll") for (int k = 0; k < 2; ++k) dst[n][k] = *(const PG8_LAS bf16x8*)(lds + PG8_SB(b, h) + boff + n * 2048 + k * 1024); } while (0)
#define PG8_MMA(ai, bj, At, Bt) do { __builtin_amdgcn_s_setprio(1); _Pragma("unroll") for (int m = 0; m < 4; ++m) _Pragma("unroll") for (int n = 0; n < 2; ++n) _Pragma("unroll") for (int k = 0; k < 2; ++k) \
        acc[ai][bj][m][n] = __builtin_amdgcn_mfma_f32_16x16x32_bf16(Bt[n][k], At[m][k], acc[ai][bj][m][n], 0, 0, 0); __builtin_amdgcn_s_setprio(0); } while (0)
#define PG8_WAIT_V(n) asm volatile("s_waitcnt vmcnt(" #n ")" ::: "memory")
#define PG8_WAIT_L(n) asm volatile("s_waitcnt lgkmcnt(" #n ")" ::: "memory")
#define PG8_BAR __builtin_amdgcn_s_barrier()
#define PG8_SCHED __builtin_amdgcn_sched_barrier(0)
    Unit cur, nxt; int ui = 0;
    if (!S.next(0, cur)) return;
    f32x4 acc[2][2][4][2];
#pragma unroll
    for (int a = 0; a < 2; ++a)
#pragma unroll
        for (int b = 0; b < 2; ++b)
#pragma unroll
            for (int m = 0; m < 4; ++m)
#pragma unroll
                for (int n = 0; n < 2; ++n) acc[a][b][m][n] = (f32x4){0.f, 0.f, 0.f, 0.f};
    bf16x8 At[4][2], B0[2][2], B1[2][2];
    const char* cA = (const char*)g.A + (size_t)cur.pm * tstep; const char* cB = (const char*)g.Bt + (size_t)cur.pn * tstep;
    S.a_ready(cur);
    if constexpr (SP2) {
        PG8_STAGE(PG8_SB(0, 0), cB, voffB); PG8_STAGE(PG8_SB(0, 1), cB + hstep, voffB); PG8_STAGE(PG8_SA(0, 0), cA, voffA); PG8_STAGE(PG8_SA(0, 1), cA + hstep, voffA);
        if (wr == 1) PG8_BAR;
        PG8_WAIT_V(2); PG8_BAR;
        PG8_STAGE(PG8_SB(1, 0), cB + kstep, voffB); PG8_STAGE(PG8_SA(1, 0), cA + kstep, voffA); PG8_STAGE(PG8_SB(1, 1), cB + hstep + kstep, voffB);
        PG8_WAIT_V(6); PG8_BAR;
    } else {
        PG8_STAGE(PG8_SB(0, 0), cB, voffB); PG8_STAGE(PG8_SA(0, 0), cA, voffA); PG8_STAGE(PG8_SB(0, 1), cB + hstep, voffB); PG8_STAGE(PG8_SA(0, 1), cA + hstep, voffA);
        if (wr == 1) PG8_BAR;
        PG8_WAIT_V(4); PG8_BAR;
        PG8_STAGE(PG8_SB(1, 0), cB + kstep, voffB); PG8_STAGE(PG8_SA(1, 0), cA + kstep, voffA); PG8_STAGE(PG8_SB(1, 1), cB + hstep + kstep, voffB);
        PG8_WAIT_V(6); PG8_BAR;
    }
    for (;;) {
        const bool has_next = S.next(ui + 1, nxt);
        const char* nA = has_next ? (const char*)g.A + (size_t)nxt.pm * tstep : cA; const char* nB = has_next ? (const char*)g.Bt + (size_t)nxt.pn * tstep : cB;
        for (int t = 0; t < nt; t += 2) {
            const bool last = (t == nt - 2);
            const char* a1 = cA + (size_t)(t + 1) * kstep;
            const char* a2 = last ? nA : cA + (size_t)(t + 2) * kstep; const char* b2 = last ? nB : cB + (size_t)(t + 2) * kstep;
            const char* a3 = a2 + kstep; const char* b3 = b2 + kstep;
            if (last && has_next) S.a_ready(nxt);
            if constexpr (SP2) {
            PG8_LDB(B0, 0, 0); PG8_LDB(B1, 0, 1); PG8_SCHED; PG8_LDA(At, 0, 0); PG8_STAGE(PG8_SA(1, 1), a1 + hstep, voffA);
            PG8_WAIT_V(8); PG8_WAIT_L(0); PG8_BAR; PG8_MMA(0, 0, At, B0); PG8_MMA(0, 1, At, B1); PG8_BAR; PG8_SCHED;
            PG8_LDA(At, 0, 1); PG8_STAGE(PG8_SB(0, 0), b2, voffB); PG8_STAGE(PG8_SB(0, 1), b2 + hstep, voffB); PG8_STAGE(PG8_SA(0, 0), a2, voffA);
            PG8_WAIT_V(8); PG8_WAIT_L(0); PG8_BAR; PG8_MMA(1, 0, At, B0); PG8_MMA(1, 1, At, B1); PG8_BAR; PG8_SCHED;
            PG8_LDB(B0, 1, 0); PG8_LDB(B1, 1, 1); PG8_SCHED; PG8_LDA(At, 1, 0); PG8_STAGE(PG8_SA(0, 1), a2 + hstep, voffA);
            PG8_WAIT_V(8); PG8_WAIT_L(0); PG8_BAR; PG8_MMA(0, 0, At, B0); PG8_MMA(0, 1, At, B1); PG8_BAR; PG8_SCHED;
            PG8_LDA(At, 1, 1); PG8_STAGE(PG8_SB(1, 0), b3, voffB); PG8_STAGE(PG8_SB(1, 1), b3 + hstep, voffB); PG8_STAGE(PG8_SA(1, 0), a3, voffA);
            PG8_WAIT_V(8); PG8_WAIT_L(0); PG8_BAR; PG8_MMA(1, 0, At, B0); PG8_MMA(1, 1, At, B1); PG8_BAR; PG8_SCHED;
            } else {
            PG8_LDB(B0, 0, 0); PG8_SCHED; PG8_LDA(At, 0, 0); PG8_STAGE(PG8_SA(1, 1), a1 + hstep, voffA);
            PG8_WAIT_L(8); PG8_BAR; PG8_WAIT_L(0); PG8_MMA(0, 0, At, B0); PG8_BAR; PG8_SCHED;
            PG8_LDB(B1, 0, 1); PG8_STAGE(PG8_SB(0, 0), b2, voffB);
            PG8_BAR; PG8_WAIT_L(0); PG8_MMA(0, 1, At, B1); PG8_BAR;
            PG8_LDA(At, 0, 1); PG8_STAGE(PG8_SA(0, 0), a2, voffA);
            PG8_BAR; PG8_WAIT_L(0); PG8_MMA(1, 0, At, B0); PG8_BAR; PG8_SCHED;
            PG8_STAGE(PG8_SB(0, 1), b2 + hstep, voffB);
            PG8_WAIT_V(6); PG8_BAR; PG8_MMA(1, 1, At, B1); PG8_BAR;
            PG8_LDB(B0, 1, 0); PG8_SCHED; PG8_LDA(At, 1, 0); PG8_STAGE(PG8_SA(0, 1), a2 + hstep, voffA);
            PG8_WAIT_L(8); PG8_BAR; PG8_WAIT_L(0); PG8_MMA(0, 0, At, B0); PG8_BAR; PG8_SCHED;
            PG8_LDB(B1, 1, 1); PG8_STAGE(PG8_SB(1, 0), b3, voffB);
            PG8_BAR; PG8_WAIT_L(0); PG8_MMA(0, 1, At, B1); PG8_BAR;
            PG8_LDA(At, 1, 1); PG8_STAGE(PG8_SA(1, 0), a3, voffA);
            PG8_BAR; PG8_WAIT_L(0); PG8_MMA(1, 0, At, B0); PG8_BAR; PG8_SCHED;
            PG8_STAGE(PG8_SB(1, 1), b3 + hstep, voffB);
            PG8_WAIT_V(6); PG8_BAR; PG8_MMA(1, 1, At, B1); PG8_BAR;
            }
        }
        if constexpr (ALIGN_EPI) { if (wr == 0) PG8_BAR; }
        if constexpr (!Epi::AFTER_DRAIN) { E(acc, cur, wr, wc, fr, fq); S.done(cur); }
        if (!has_next) break;
#pragma unroll
        for (int a = 0; a < 2; ++a)
#pragma unroll
            for (int b = 0; b < 2; ++b)
#pragma unroll
                for (int m = 0; m < 4; ++m)
#pragma unroll
                    for (int n = 0; n < 2; ++n) acc[a][b][m][n] = (f32x4){0.f, 0.f, 0.f, 0.f};
        cur = nxt; cA = nA; cB = nB; ++ui;
        if constexpr (ALIGN_EPI) { if (wr == 1) PG8_BAR; }
    }
    PG8_WAIT_V(0);
    if constexpr (!ALIGN_EPI) { if (wr == 0) PG8_BAR; }
    PG8_BAR;
    if constexpr (Epi::AFTER_DRAIN) { E.fused(acc, cur, wr, wc, fr, fq, lds, wid, lane); S.done(cur); }
#undef PG8_SA
#undef PG8_SB
#undef PG8_STAGE
#undef PG8_LDA
#undef PG8_LDB
#undef PG8_MMA
#undef PG8_WAIT_V
#undef PG8_WAIT_L
#undef PG8_BAR
#undef PG8_SCHED
}
}
constexpr int NWAVES = 8, NTHR = 512;
constexpr int DM = 1024, SEQ = 4096, NBP = 4, NBS = 128, TS4 = 4;
constexpr int TP = NBP * SEQ, TS = NBS * TS4, MR = TP + TS;
constexpr int NE = 3584, NO = 3080, NOP = 3328;
constexpr int ZQA = 0, ZKA = 512, ZVA = 1024, ZGA = 1536, ZQB = 2048, ZKB = 2304, ZVB = 2560, ZGB = 3072;
constexpr int YU = 0, YV = 512, YGC = 1024, YZG = 1536, YXBC = 2048, YDT = 3072;
constexpr int NPHYS = 2560, PAGE = 128, NPAGES = 16, PAST = 2048;
constexpr float EPS = 1e-6f;
constexpr size_t O_YP = 0, O_YS = O_YP + (size_t)TP * DM, O_KP = O_YS + (size_t)TS * DM, O_VP = O_KP + (size_t)TP * 512, O_KS = O_VP + (size_t)TP * 512,
    O_VS = O_KS + (size_t)TS * 512, O_RSP = O_VS + (size_t)TS * 512, O_RSS = O_RSP + (size_t)NBP * 4 * 8192, O_SGV = O_RSS + (size_t)NBS * 4 * 8192,
    O_SSP = O_SGV + (size_t)TS * 512, O_SSS = O_SSP + (size_t)NBP * 8 * 8192, O_CSP = O_SSS + (size_t)NBS * 8 * 8192, O_CSS = O_CSP + (size_t)NBP * 3 * 1024,
    O_END = O_CSS + (size_t)NBS * 3 * 1024;
static_assert(O_END == 48246784, "output size");
constexpr size_t MiB = 1u << 20;
constexpr size_t WS_CTL = 0, CTL_ZERO_BYTES = 32768;
constexpr size_t WS_WINE = 2 * MiB, WS_WOUTE = 10 * MiB, WS_WINO = 12 * MiB, WS_WOUTO = 19 * MiB;
constexpr size_t WS_MODE = 21 * MiB, WS_MODO = 23 * MiB;
constexpr size_t WS_ROPE = 25 * MiB;
constexpr size_t WS_KMEAN = 26 * MiB;
constexpr size_t WS_KPART = 26 * MiB;
constexpr size_t WS_DTRAW = 27 * MiB, WS_DTH = 28 * MiB, WS_CUM = 29 * MiB, WS_CDEC = 30 * MiB;
constexpr size_t WS_H = 32 * MiB;
constexpr size_t WS_Z = 66 * MiB;
constexpr size_t WS_MIX = 182 * MiB;
constexpr size_t WS_X1 = 216 * MiB;
constexpr size_t WS_SLR = 282 * MiB;
constexpr size_t WS_SLS = 298 * MiB;
constexpr size_t WS_XC = 330 * MiB;
constexpr size_t WS_SC = 364 * MiB;
constexpr size_t WS_KMS = 396 * MiB;
constexpr size_t WS_PBR = 400 * MiB;
constexpr size_t WS_PBS = 410 * MiB;
constexpr size_t WS_END = 432 * MiB;
constexpr int CW_BAR = 4096;
constexpr int XCH_OFF = 131072;
constexpr int SCR_BYTES = 155648;
constexpr int MISC_OFF = SCR_BYTES;
constexpr int LDS_BYTES = SCR_BYTES + 256;

#define GAS __attribute__((address_space(1)))
#define LAS __attribute__((address_space(3)))
typedef unsigned short bf16;
typedef unsigned v4u __attribute__((ext_vector_type(4)));
typedef unsigned v2u __attribute__((ext_vector_type(2)));
typedef float f32x4 __attribute__((ext_vector_type(4)));
typedef float f32x2 __attribute__((ext_vector_type(2)));
typedef GAS unsigned gu32;
#define RLX_AGENT __ATOMIC_RELAXED, __HIP_MEMORY_SCOPE_AGENT
__device__ __forceinline__ float bf2f(unsigned v16) { return __uint_as_float(v16 << 16); }
__device__ __forceinline__ unsigned f2bf(float f) { unsigned u = __float_as_uint(f); return (u + 0x7fffu + ((u >> 16) & 1u)) >> 16; }
__device__ __forceinline__ unsigned pk2(float lo, float hi) { return f2bf(lo) | (f2bf(hi) << 16); }
__device__ __forceinline__ void unpack8(v4u w, float* f) {
    f[0] = __uint_as_float(w.x << 16); f[1] = __uint_as_float(w.x & 0xffff0000u); f[2] = __uint_as_float(w.y << 16); f[3] = __uint_as_float(w.y & 0xffff0000u);
    f[4] = __uint_as_float(w.z << 16); f[5] = __uint_as_float(w.z & 0xffff0000u); f[6] = __uint_as_float(w.w << 16); f[7] = __uint_as_float(w.w & 0xffff0000u); }
__device__ __forceinline__ v4u pack8(const float* f) { v4u w; w.x = pk2(f[0], f[1]); w.y = pk2(f[2], f[3]); w.z = pk2(f[4], f[5]); w.w = pk2(f[6], f[7]); return w; }
__device__ __forceinline__ float silu_f(float x) { return x / (1.f + __expf(-x)); }
__device__ __forceinline__ float gelu_f(float x) { const float y = 0.7978845608028654f * (x + 0.044715f * x * x * x); const float t = 1.f - 2.f / (__expf(2.f * y) + 1.f); return 0.5f * x * (1.f + t); }
__device__ __forceinline__ float softplus_f(float x) { return x > 20.f ? x : log1pf(__expf(x)); }
__device__ __forceinline__ float wave_sum(float v) {
#pragma unroll
    for (int o = 1; o < 64; o <<= 1) v += __shfl_xor(v, o);
    return v;
}
__device__ __forceinline__ float red8_dpp(float s) {
    s += __int_as_float(__builtin_amdgcn_update_dpp(0, __float_as_int(s), 0xB1, 0xF, 0xF, true));
    s += __int_as_float(__builtin_amdgcn_update_dpp(0, __float_as_int(s), 0x4E, 0xF, 0xF, true));
    s += __int_as_float(__builtin_amdgcn_update_dpp(0, __float_as_int(s), 0x141, 0xF, 0xF, true));
    return s;
}
__device__ __forceinline__ float red16_dpp(float s) {
    s = red8_dpp(s);
    s += __int_as_float(__builtin_amdgcn_update_dpp(0, __float_as_int(s), 0x140, 0xF, 0xF, true));
    return s;
}
__device__ __forceinline__ float wave_max(float v) {
#pragma unroll
    for (int o = 1; o < 64; o <<= 1) v = fmaxf(v, __shfl_xor(v, o));
    return v;
}
__device__ __forceinline__ int t5_bucket(int n) { if (n < 16) return n; const int l = 16 + (int)(logf((float)n * 0.0625f) / 2.0794415416798357f * 16.f); return l < 31 ? l : 31; }
__device__ __forceinline__ int mod_row(int r) { return r < TP ? (r >> 12) : 4 + ((r - TP) >> 2); }
__device__ __forceinline__ int pos_of(int r) { return r < TP ? (r & (SEQ - 1)) : PAST + (r & 3); }
template <int I> __device__ __forceinline__ const float* inp_ptr() {
    const unsigned long long kp = (unsigned long long)__builtin_amdgcn_kernarg_segment_ptr(); unsigned long long v;
    asm volatile("s_load_dwordx2 %0, %1, %2\n\ts_waitcnt lgkmcnt(0)" : "=s"(v) : "s"(kp), "i"(I * 8));
    return (const float*)(const GAS float*)v;
}
#define INP(i) inp_ptr<i>()
namespace attn_body {
using bf16=__hip_bfloat16;
using bf16x8=__attribute__((ext_vector_type(8)))short;
using s16x4=__attribute__((ext_vector_type(4)))short;
using f32x16=__attribute__((ext_vector_type(16)))float;
using u32x4=__attribute__((ext_vector_type(4)))unsigned;
constexpr int BATCH=4,NHEAD=8,SEQ=4096,D=64,DM=3584;
constexpr int NW=8,QBLK=32,QB=QBLK*NW,KVBLK=64,NQB=SEQ/QB;
constexpr int ATTN_PITCH=DM, ATTN_UNIT_ROWS=QB;
__device__ __forceinline__ int crow(int r,int hi){return (r&3)+8*(r>>2)+4*hi;}
#define SBAR() __builtin_amdgcn_sched_barrier(0)
__device__ __forceinline__ void cmask(f32x16&p0,f32x16&p1,int jb,int qrel,int hi){
  const float NEG=-INFINITY; int kb=64*jb+4*hi;
  #pragma unroll
  for(int r=0;r<16;++r){int kv=kb+(r&3)+8*(r>>2); if(kv>qrel)p0[r]=NEG; if(kv+32>qrel)p1[r]=NEG;}
}

__device__ __forceinline__ void cinit(f32x16&c0,f32x16&c1,int t,int NT,int qb,int qrel,int hi,unsigned selm,const float*lut,float mhat){
  const float NEG=-INFINITY; const bool band=t<4; const int pt=band?4*qb+t:t-4;
  const bool keep=(((selm>>((pt>>2)&15))&1u)!=0u);
  if(t>=4&&t<NT-2){ const float v=keep?-mhat:NEG;
    #pragma unroll
    for(int r=0;r<16;++r){c0[r]=v;c1[r]=v;} }
  else { const int lim=band?(qrel-64*t-4*hi):(keep?4096:-4096); const float*lp=lut+256+(256*qb+qrel-64*pt)-4*hi;
    #pragma unroll
    for(int r=0;r<16;++r){ const int c=(r&3)+8*(r>>2); const float b0=lp[-c], b1=lp[-c-32]; c0[r]=(c>lim)?NEG:b0-mhat; c1[r]=(c+32>lim)?NEG:b1-mhat; } }
}
constexpr int NSLOT=3, SLOTB=8192;
constexpr int LDS_K=0, LDS_V=NSLOT*SLOTB, LDS_WS=2*NSLOT*SLOTB, LDS_OST=LDS_WS+NW*64*4, LDS_BYTES=LDS_OST+NW*4096;
constexpr int LUTN=4352;
constexpr int LDS_KM=LDS_BYTES, LDS_LUT=LDS_KM+4096, LDS_TOTAL=LDS_LUT+LUTN*4;
constexpr float C2=0.125f*1.4426950408889634f;
__device__ __forceinline__ void glds16(const void*gsrc,unsigned lds_dst){unsigned keep;
  asm volatile("s_mov_b32 %0, m0\n\ts_mov_b32 m0, %2\n\ts_nop 0\n\tglobal_load_lds_dwordx4 %1, off\n\ts_mov_b32 m0, %0":"=&s"(keep):"v"(gsrc),"s"(lds_dst):"memory");}
__device__ __forceinline__ float max3f(float a,float b,float c){float r;asm("v_max3_f32 %0, %1, %2, %3":"=v"(r):"v"(a),"v"(b),"v"(c));return r;}
__device__ __forceinline__ float max2f(float a,float b){float r;asm("v_max_f32_e32 %0, %1, %2":"=v"(r):"v"(a),"v"(b));return r;}
__device__ __forceinline__ float fadd_s(float a,float b){float r;asm("v_add_f32_e32 %0, %1, %2":"=v"(r):"v"(a),"v"(b));return r;}
__device__ __forceinline__ float fsub_s(float a,float b){float r;asm("v_sub_f32_e32 %0, %1, %2":"=v"(r):"v"(a),"v"(b));return r;}
typedef float f32x2_t __attribute__((ext_vector_type(2))); typedef __bf16 bf16x2_t __attribute__((ext_vector_type(2)));
__device__ __forceinline__ unsigned cvtpk_s(float lo,float hi){f32x2_t v={lo,hi};bf16x2_t b=__builtin_convertvector(v,bf16x2_t);return __builtin_bit_cast(unsigned,b);}
#define WAIT_BAR(N) asm volatile("s_waitcnt vmcnt(" #N ") lgkmcnt(0)\n\ts_barrier":::"memory")

__device__ __forceinline__ void qkt(f32x16&p0,f32x16&p1,const char*Kslot,const bf16x8*qr,int r32,int hi){
  const char*kb=Kslot+hi*1024+r32*16;
  #pragma unroll
  for(int d0=0;d0<4;++d0){
    const bf16x8 b0=*reinterpret_cast<const bf16x8*>(kb+d0*2048);
    const bf16x8 b1=*reinterpret_cast<const bf16x8*>(kb+d0*2048+512);
    p0=__builtin_amdgcn_mfma_f32_32x32x16_bf16(b0,qr[d0],p0,0,0,0);p1=__builtin_amdgcn_mfma_f32_32x32x16_bf16(b1,qr[d0],p1,0,0,0);}
}
typedef __attribute__((address_space(3))) const char* lds_cptr;
typedef short v4i16_t __attribute__((ext_vector_type(4)));
__device__ __forceinline__ void kload8(bf16x8*kf,lds_cptr kp){
  kf[0]=*(const __attribute__((address_space(3))) bf16x8*)(kp);      kf[1]=*(const __attribute__((address_space(3))) bf16x8*)(kp+512);
  kf[2]=*(const __attribute__((address_space(3))) bf16x8*)(kp+2048); kf[3]=*(const __attribute__((address_space(3))) bf16x8*)(kp+2560);
  kf[4]=*(const __attribute__((address_space(3))) bf16x8*)(kp+4096); kf[5]=*(const __attribute__((address_space(3))) bf16x8*)(kp+4608);
  kf[6]=*(const __attribute__((address_space(3))) bf16x8*)(kp+6144); kf[7]=*(const __attribute__((address_space(3))) bf16x8*)(kp+6656);
}
__device__ __forceinline__ void kload2(bf16x8*kf,lds_cptr kp,int j){ kf[2*j]=*(const __attribute__((address_space(3))) bf16x8*)(kp+j*2048); kf[2*j+1]=*(const __attribute__((address_space(3))) bf16x8*)(kp+j*2048+512); }
__device__ __forceinline__ s16x4 vtr(lds_cptr p){ return __builtin_bit_cast(s16x4,__builtin_amdgcn_ds_read_tr16_b64_v4i16((__attribute__((address_space(3))) v4i16_t*)p)); }
__device__ __forceinline__ float rowmax(const f32x16&p0,const f32x16&p1){
  float a=max3f(p0[0],p0[1],p1[0]),b=max3f(p0[2],p0[3],p1[1]);a=max3f(a,p1[2],p1[3]);
  #pragma unroll
  for(int r=4;r<16;r+=4){a=max3f(a,p0[r],p0[r+1]);b=max3f(b,p0[r+2],p0[r+3]);a=max3f(a,p1[r],p1[r+1]);b=max3f(b,p1[r+2],p1[r+3]);}
  const float m=max2f(a,b);
  auto rr=__builtin_amdgcn_permlane32_swap(__float_as_uint(m),__float_as_uint(m),false,false);
  return max2f(__uint_as_float(rr[0]),__uint_as_float(rr[1]));
}
__device__ __forceinline__ void pv(f32x16*o,int vb,bf16x8 pa0,bf16x8 pa1,bf16x8 pa2,bf16x8 pa3){
  #pragma unroll
  for(int d0=0;d0<2;++d0){s16x4 lo[4],hi[4];
    #pragma unroll
    for(int ks=0;ks<4;++ks){
      asm volatile("ds_read_b64_tr_b16 %0,%1 offset:%c2":"=&v"(lo[ks]):"v"(vb),"i"(d0*4096+ks*1024):"memory");
      asm volatile("ds_read_b64_tr_b16 %0,%1 offset:%c2":"=&v"(hi[ks]):"v"(vb),"i"(d0*4096+ks*1024+512):"memory");}
    asm volatile("s_waitcnt lgkmcnt(0)":::"memory");SBAR();
    #define PK(k) (bf16x8){lo[k][0],lo[k][1],lo[k][2],lo[k][3],hi[k][0],hi[k][1],hi[k][2],hi[k][3]}
    o[d0]=__builtin_amdgcn_mfma_f32_32x32x16_bf16(pa0,PK(0),o[d0],0,0,0);
    o[d0]=__builtin_amdgcn_mfma_f32_32x32x16_bf16(pa1,PK(1),o[d0],0,0,0);
    o[d0]=__builtin_amdgcn_mfma_f32_32x32x16_bf16(pa2,PK(2),o[d0],0,0,0);
    o[d0]=__builtin_amdgcn_mfma_f32_32x32x16_bf16(pa3,PK(3),o[d0],0,0,0);
    #undef PK
  }
}

#ifndef ATTN_STORE16
#define ATTN_STORE16(p,v) (*(u32x4*)(p)=(v))
#endif
template<int THRL> __device__ __forceinline__ void attn_unit(int b,int h,int qb,const bf16*Q,const bf16*__restrict__ K,const bf16*__restrict__ V,const bf16*__restrict__ GA,bf16*O,const float*__restrict__ kpart,const float*__restrict__ relb,char*shm,bool setup){
  const int tid=threadIdx.x,lane=tid&63,r32=lane&31,hi=lane>>5; const int wid=__builtin_amdgcn_readfirstlane(tid>>6);
  const long rowbase=(long)b*SEQ; const int q0=qb*QB;
  const bf16*Qw=Q+(rowbase+q0+wid*QBLK)*DM+h*D;
  const bf16*Kh=K+rowbase*DM+h*D,*Vh=V+rowbase*DM+h*D;
  const unsigned lds0=(unsigned)(uintptr_t)shm;
  float*wsf=(float*)(shm+LDS_WS)+wid*64;
  const bf16*ksrc=Kh+(long)lane*DM+wid*8;
  const bf16*vsrc=Vh+(long)(16*(wid&3)+(lane>>2))*DM+(wid>>2)*32+(lane&3)*8;
  const unsigned kdst=lds0+LDS_K+wid*1024, vdst=lds0+LDS_V+wid*1024;
  #define PHYS(t) (((t)<4)?(4*qb+(t)):((t)-4))
  #define DMA_K(t,slot) glds16(ksrc+(long)(PHYS(t))*KVBLK*DM,(unsigned)__builtin_amdgcn_readfirstlane(kdst+(slot)))
  #define DMA_V(t,slot) glds16(vsrc+(long)(PHYS(t))*KVBLK*DM,(unsigned)__builtin_amdgcn_readfirstlane(vdst+(slot)))
  const int vb0=(int)(lds0+LDS_V)+((lane>>4)&1)*32+(lane&3)*8+(4*hi+((lane&15)>>2))*64;
  const char*Kbase=shm+LDS_K; bf16x8 kf[8];
  const lds_cptr shm3=(lds_cptr)shm; const lds_cptr kp0=shm3+LDS_K+hi*1024+r32*16; const lds_cptr vp0=shm3+LDS_V+((lane>>4)&1)*32+(lane&3)*8+(4*hi+((lane&15)>>2))*64;
  const int NT=(q0+QB)/KVBLK;
  bf16x8 qr[4];
  #pragma unroll
  for(int d0=0;d0<4;++d0)qr[d0]=*reinterpret_cast<const bf16x8*>(&Qw[(long)r32*DM+d0*16+hi*8]);
  unsigned selm=0u; const float*lut=(const float*)(shm+LDS_LUT);
  { float*kmn=(float*)(shm+LDS_KM); float*lw=(float*)(shm+LDS_LUT);
    if(setup){
    for(int e=tid;e<qb*64;e+=512){ const int n=e>>6,d=e&63; kmn[e]=kpart[(size_t)(b*16+n)*512+h*64+d]; }
    for(int e=tid;e<LUTN;e+=512){ float v=0.f; if(e>=256&&e<384){ const int dd=e-256; int bk=dd; if(dd>=16){ bk=16+(int)(logf((float)dd*0.0625f)/2.0794415416798357f*16.f); bk=bk<31?bk:31; } v=(relb[bk*8+h]-relb[31*8+h])*1.4426950408889634f; } lw[e]=v; }
    __syncthreads(); }
    float v1=-3e38f,v2=-3e38f,v3=-3e38f; int i1=-1,i2=-1,i3=-1;
    for(int n=0;n<qb;++n){ float s=0.f;
      #pragma unroll
      for(int d0=0;d0<4;++d0){ const float*kp=kmn+n*64+16*d0+8*hi;
        #pragma unroll
        for(int jj=0;jj<8;++jj)s+=__uint_as_float(((unsigned)(unsigned short)qr[d0][jj])<<16)*kp[jj]; }
      s+=__shfl_xor(s,32);
      if(s>v1){v3=v2;i3=i2;v2=v1;i2=i1;v1=s;i1=n;} else if(s>v2){v3=v2;i3=i2;v2=s;i2=n;} else if(s>v3){v3=s;i3=n;} }
    if(i1>=0)selm|=1u<<i1; if(i2>=0)selm|=1u<<i2; if(i3>=0)selm|=1u<<i3; }
  DMA_K(0,0);DMA_V(0,0);DMA_K(1,SLOTB);
  float mhat=0.f,l_reg=0.f;f32x16 o[2];o[0]=f32x16{};o[1]=f32x16{};
  const int qrel=wid*QBLK+r32;
  #define CINIT(P0,P1,t) cinit(P0,P1,(t),NT,qb,qrel,hi,selm,lut,mhat)
  bool resc=false;
  #define START(P0,P1) do{ const float rm=rowmax(P0,P1); resc=false; \
    { const float dl=rm; mhat=fadd_s(mhat,dl); \
      _Pragma("unroll") for(int r=0;r<16;++r){P0[r]=fsub_s(P0[r],dl);P1[r]=fsub_s(P1[r],dl);} \
      } \
    _Pragma("unroll") for(int r=0;r<16;++r)P0[r]=__builtin_amdgcn_exp2f(P0[r]); }while(0)
  #define RESC() do{ if(resc){ asm volatile("s_waitcnt lgkmcnt(0)":::"memory"); \
      _Pragma("unroll") for(int d_=0;d_<2;++d_) _Pragma("unroll") for(int r=0;r<16;++r)o[d_][r]*=wsf[crow(r,hi)]; } }while(0)
  f32x16 pA0,pA1,pB0,pB1;
  int sl_prev=0,sl_cur=0,sl_next=SLOTB;
  #define ROT() do{sl_prev=sl_cur;sl_cur=sl_next;sl_next=(sl_next==(NSLOT-1)*SLOTB)?0:sl_next+SLOTB;}while(0)
  DMA_K(2,2*SLOTB);
  WAIT_BAR(3);
  CINIT(pA0,pA1,0); qkt(pA0,pA1,Kbase,qr,r32,hi);asm volatile("s_nop 15\n\ts_nop 7":"+v"(pA0),"+v"(pA1));
  START(pA0,pA1);
  _Pragma("unroll") for(int r=0;r<16;++r)pA1[r]=__builtin_amdgcn_exp2f(pA1[r]);
  WAIT_BAR(0);
  DMA_K(3,0);DMA_V(1,SLOTB);
  ROT();
  kload8(kf,kp0+sl_cur);
  WAIT_BAR(2);
  s16x4 vlo[8],vhi[8]; u32x4 pw0,pw1,pw2,pw3;
  #define PKW(P,B) cvtpk_s(P[B],P[B+1])
  #define PAF(k) __builtin_bit_cast(bf16x8,pw##k)
  #define VFR(i) (bf16x8){vlo[i][0],vlo[i][1],vlo[i][2],vlo[i][3],vhi[i][0],vhi[i][1],vhi[i][2],vhi[i][3]}
  #define PIN(x) asm volatile("":"+v"(x))
  #define MX3(a,b,c) __builtin_fmaxf(__builtin_fmaxf((a),(b)),(c))
  #define GAPA(MF,A0,A1,A2,A3,W0,W1,PW) do{ MF; sacc+=A0; sacc+=A1; sacc+=A2; sacc+=A3; PIN(sacc); W0; W1; PIN(PW); SBAR(); }while(0)
  #define EX(v) __builtin_amdgcn_exp2f(v)
  #define GAPB(MF,X,B) do{ MF; X[B]=EX(X[B]); X[B+1]=EX(X[B+1]); X[B+2]=EX(X[B+2]); X[B+3]=EX(X[B+3]); PIN(X); SBAR(); }while(0)
  #define VRD(i) do{ vlo[i]=vtr(vp_+(((i)>>2)*4096+((i)&3)*1024)); vhi[i]=vtr(vp_+(((i)>>2)*4096+((i)&3)*1024+512)); }while(0)
  #define KRD(G,j) do{ if(G){ kload2(kf,kp0+sl_next,j); SBAR(); } }while(0)
  #define STEP(C0,C1,P0,P1,t,GK,GV,GL) do{ CINIT(C0,C1,t); SBAR(); \
    const lds_cptr vp_=vp0+sl_prev; \
    VRD(0); SBAR(); float sacc=(P0[0]+P0[1]); \
    GAPA(C0=__builtin_amdgcn_mfma_f32_32x32x16_bf16(kf[0],qr[0],C0,0,0,0), P0[2],P0[3],P0[4],P0[5],     pw0[0]=PKW(P0,0), pw0[1]=PKW(P0,2), pw0); \
    VRD(4); SBAR(); GAPA(C1=__builtin_amdgcn_mfma_f32_32x32x16_bf16(kf[1],qr[0],C1,0,0,0), P0[6],P0[7],P0[8],P0[9],     pw0[2]=PKW(P0,4), pw0[3]=PKW(P0,6), pw0); \
    VRD(1); SBAR(); GAPA(C0=__builtin_amdgcn_mfma_f32_32x32x16_bf16(kf[2],qr[1],C0,0,0,0),   P0[10],P0[11],P0[12],P0[13], pw1[0]=PKW(P0,8), pw1[1]=PKW(P0,10), pw1); \
    VRD(5); SBAR(); GAPA(C1=__builtin_amdgcn_mfma_f32_32x32x16_bf16(kf[3],qr[1],C1,0,0,0),   P0[14],P0[15],P1[0],P1[1],   pw1[2]=PKW(P0,12),pw1[3]=PKW(P0,14), pw1); \
    VRD(2); SBAR(); GAPA(C0=__builtin_amdgcn_mfma_f32_32x32x16_bf16(kf[4],qr[2],C0,0,0,0),   P1[2],P1[3],P1[4],P1[5],     pw2[0]=PKW(P1,0), pw2[1]=PKW(P1,2), pw2); \
    VRD(6); SBAR(); GAPA(C1=__builtin_amdgcn_mfma_f32_32x32x16_bf16(kf[5],qr[2],C1,0,0,0),   P1[6],P1[7],P1[8],P1[9],     pw2[2]=PKW(P1,4), pw2[3]=PKW(P1,6), pw2); \
    VRD(3); SBAR(); GAPA(C0=__builtin_amdgcn_mfma_f32_32x32x16_bf16(kf[6],qr[3],C0,0,0,0),   P1[10],P1[11],P1[12],P1[13], pw3[0]=PKW(P1,8), pw3[1]=PKW(P1,10), pw3); \
    VRD(7); SBAR(); GAPA(C1=__builtin_amdgcn_mfma_f32_32x32x16_bf16(kf[7],qr[3],C1,0,0,0),   P1[14],P1[15],0.f,0.f,       pw3[2]=PKW(P1,12),pw3[3]=PKW(P1,14), pw3); \
    l_reg+=sacc; \
    if(GK){DMA_K((t)+3,sl_cur);} if(GV){DMA_V((t)+1,sl_next);} \
    { float a=MX3(C0[0],C0[1],C1[0]),b=MX3(C0[2],C0[3],C1[1]); a=MX3(a,C1[2],C1[3]); \
      _Pragma("unroll") for(int r=4;r<16;r+=4){a=MX3(a,C0[r],C0[r+1]);b=MX3(b,C0[r+2],C0[r+3]);a=MX3(a,C1[r],C1[r+1]);b=MX3(b,C1[r+2],C1[r+3]);} \
      float rm=__builtin_fmaxf(a,b); { auto rr=__builtin_amdgcn_permlane32_swap(__float_as_uint(rm),__float_as_uint(rm),false,false); rm=__builtin_fmaxf(__uint_as_float(rr[0]),__uint_as_float(rr[1])); } \
      resc=false; \
      if(__builtin_expect(__any(rm>(float)THRL),0)){ const float dl=__builtin_fmaxf(rm,0.f); mhat+=dl; \
        _Pragma("unroll") for(int r=0;r<16;++r){C0[r]-=dl;C1[r]-=dl;} \
        const float f=__builtin_amdgcn_exp2f(-dl); l_reg*=f; if(hi==0)wsf[r32]=f; resc=true; } } \
    SBAR(); \
    GAPB(o[0]=__builtin_amdgcn_mfma_f32_32x32x16_bf16(PAF(0),VFR(0),o[0],0,0,0), C0,0); \
    GAPB(o[1]=__builtin_amdgcn_mfma_f32_32x32x16_bf16(PAF(0),VFR(4),o[1],0,0,0), C0,4); \
    KRD(GL,0); GAPB(o[0]=__builtin_amdgcn_mfma_f32_32x32x16_bf16(PAF(1),VFR(1),o[0],0,0,0), C0,8); \
    KRD(GL,1); GAPB(o[1]=__builtin_amdgcn_mfma_f32_32x32x16_bf16(PAF(1),VFR(5),o[1],0,0,0), C0,12); \
    KRD(GL,2); GAPB(o[0]=__builtin_amdgcn_mfma_f32_32x32x16_bf16(PAF(2),VFR(2),o[0],0,0,0), C1,0); \
    KRD(GL,3); GAPB(o[1]=__builtin_amdgcn_mfma_f32_32x32x16_bf16(PAF(2),VFR(6),o[1],0,0,0), C1,4); \
    GAPB(o[0]=__builtin_amdgcn_mfma_f32_32x32x16_bf16(PAF(3),VFR(3),o[0],0,0,0), C1,8); \
    GAPB(o[1]=__builtin_amdgcn_mfma_f32_32x32x16_bf16(PAF(3),VFR(7),o[1],0,0,0), C1,12); \
    }while(0)
  int t=1;
  for(;t+5<NT;t+=2){
    STEP(pB0,pB1,pA0,pA1,t,true,true,true);     WAIT_BAR(2); RESC(); ROT();
    STEP(pA0,pA1,pB0,pB1,t+1,true,true,true);   WAIT_BAR(2); RESC(); ROT();
  }
  #define ENDW(tt) do{ if((tt)+3<NT){WAIT_BAR(2);} else if((tt)+2<NT){WAIT_BAR(1);} else {WAIT_BAR(0);} }while(0)
  for(;t+1<NT;t+=2){
    STEP(pB0,pB1,pA0,pA1,t,(t+3<NT),(t+1<NT),(t+1<NT));       ENDW(t);   RESC(); ROT();
    STEP(pA0,pA1,pB0,pB1,t+1,(t+4<NT),(t+2<NT),(t+2<NT));     ENDW(t+1); RESC(); ROT();
  }
  STEP(pB0,pB1,pA0,pA1,NT-1,false,false,false); RESC();
  { float sacc=pB0[0]+pB0[1]; _Pragma("unroll") for(int r=2;r<16;++r)sacc+=pB0[r]; _Pragma("unroll") for(int r=0;r<16;++r)sacc+=pB1[r]; l_reg+=sacc;
    pw0=(u32x4){PKW(pB0,0),PKW(pB0,2),PKW(pB0,4),PKW(pB0,6)};pw1=(u32x4){PKW(pB0,8),PKW(pB0,10),PKW(pB0,12),PKW(pB0,14)};pw2=(u32x4){PKW(pB1,0),PKW(pB1,2),PKW(pB1,4),PKW(pB1,6)};pw3=(u32x4){PKW(pB1,8),PKW(pB1,10),PKW(pB1,12),PKW(pB1,14)};
    SBAR(); pv(o,vb0+sl_cur,PAF(0),PAF(1),PAF(2),PAF(3)); }
  #undef PKW
  #undef PAF
  #undef VFR
  #undef PIN
  #undef MX3
  #undef GAPA
  #undef GAPB
  #undef EX
  #undef VRD
  #undef KRD
  #undef STEP
  #undef ENDW
  {auto rr=__builtin_amdgcn_permlane32_swap(__float_as_uint(l_reg),__float_as_uint(l_reg),false,false);l_reg=__uint_as_float(rr[0])+__uint_as_float(rr[1]);}
  if(hi==0)wsf[32+r32]=l_reg;asm volatile("s_waitcnt lgkmcnt(0)":::"memory");
  float rli[16];
  #pragma unroll
  for(int r=0;r<16;++r)rli[r]=__builtin_amdgcn_rcpf(wsf[32+crow(r,hi)]);
  bf16*Ow=O+(rowbase+q0+wid*QBLK)*1024+h*D; const bf16*Gw=GA+(rowbase+q0+wid*QBLK)*DM+h*D;
  u32x4 gpre[4];
  #pragma unroll
  for(int i=0;i<4;++i){const int row=i*8+(lane>>3),ch=lane&7; gpre[i]=*(const u32x4*)(Gw+(long)row*DM+ch*8);}
  { bf16*stg=(bf16*)(shm+LDS_OST)+wid*2048;
    #pragma unroll
    for(int r=0;r<16;++r){const int orow=crow(r,hi);
      #pragma unroll
      for(int d0=0;d0<2;++d0)stg[orow*64+d0*32+r32]=__float2bfloat16(o[d0][r]*rli[r]);}
    asm volatile("s_waitcnt lgkmcnt(0)":::"memory");
    #pragma unroll
    for(int i=0;i<4;++i){const int row=i*8+(lane>>3),ch=lane&7; const u32x4 v=*(const u32x4*)(stg+row*64+ch*8); const u32x4 g=gpre[i]; u32x4 w;
      #pragma unroll
      for(int k=0;k<4;++k){ const float lo=__uint_as_float(v[k]<<16)*__uint_as_float(g[k]<<16), hh=__uint_as_float(v[k]&0xffff0000u)*__uint_as_float(g[k]&0xffff0000u); w[k]=cvtpk_s(lo,hh); }
      ATTN_STORE16(Ow+(long)row*1024+ch*8,w);} }
  asm volatile("s_waitcnt lgkmcnt(0)\n\ts_barrier":::"memory");
  #undef DMA_K
  #undef PHYS
  #undef DMA_V
  #undef CINIT
  #undef START
  #undef RESC
  #undef ROT
}
constexpr int ATTN_LDS_BYTES=LDS_TOTAL;
#undef SBAR
#undef WAIT_BAR
}
#define XB_TMO      128
#define XB_XCNT(j)  (256  + 64 * (j))
#define XB_XSUB(j)  (1280 + 64 * (j))
#define XB_XGEN(j)  (2304 + 64 * (j))
#define XB_TOP      3328
#define XB_TOPGEN   3392
#define XCD_BAR_WORDS 3456
#define XB_SPIN_CAP (1u << 18)

__device__ __forceinline__ unsigned xb_ld(unsigned* p)              { return __hip_atomic_load(p, __ATOMIC_RELAXED, __HIP_MEMORY_SCOPE_AGENT); }
__device__ __forceinline__ unsigned xb_add(unsigned* p, unsigned v) { return __hip_atomic_fetch_add(p, v, __ATOMIC_RELAXED, __HIP_MEMORY_SCOPE_AGENT); }
__device__ __forceinline__ unsigned xb_xcc_id() { return (unsigned)__builtin_amdgcn_s_getreg((3 << 11) | 20) & 0xFu; }
#define XB_SPIN(cond, bar) do { unsigned _sp = 0; while (cond) { __builtin_amdgcn_s_sleep(1); \
    if ((++_sp & 255u) == 0u) { if (xb_ld(&(bar)[XB_TMO])) break; if (_sp > XB_SPIN_CAP) { atomicAdd(&(bar)[XB_TMO], 1u); break; } } } } while (0)

struct XcdBarrier {
    unsigned* bar; unsigned x;
    volatile LAS unsigned* st;
};

__device__ __forceinline__ XcdBarrier xcd_barrier_post(unsigned* bar, volatile LAS unsigned* st) {
    XcdBarrier b; b.bar = bar; b.x = xb_xcc_id(); b.st = st;
    if (threadIdx.x == 0) (void)xb_add(&bar[XB_XCNT(b.x)], 1u);
    return b;
}
__device__ __forceinline__ void xcd_barrier_complete(unsigned* bar, unsigned x, unsigned& nloc, unsigned& nx) {
    const unsigned G = gridDim.x * gridDim.y * gridDim.z;
    unsigned sum, cnt, mine, sp = 0u;
    for (;;) {
        sum = 0u; cnt = 0u; mine = 0u;
#pragma unroll
        for (unsigned j = 0; j < 16; ++j) { const unsigned c = xb_ld(&bar[XB_XCNT(j)]); sum += c; cnt += (c > 0u) ? 1u : 0u; mine = (j == x) ? c : mine; }
        if (sum == G) break;
        __builtin_amdgcn_s_sleep(1);
        if ((++sp & 255u) == 0u) { if (xb_ld(&bar[XB_TMO])) break; if (sp > XB_SPIN_CAP) { atomicAdd(&bar[XB_TMO], 1u); break; } }
    }
    nloc = mine > 0u ? mine : 1u; nx = cnt > 0u ? cnt : 1u;
}

__device__ __forceinline__ void xcd_barrier(const XcdBarrier& b) {
    asm volatile("s_waitcnt vmcnt(0)" ::: "memory");
    __syncthreads();
    if (threadIdx.x == 0) {
        unsigned* bar = b.bar;
        __builtin_amdgcn_s_waitcnt(0);
        unsigned nloc = b.st[0], nx = b.st[1];
        if (nloc == 0u) { xcd_barrier_complete(bar, b.x, nloc, nx); b.st[0] = nloc; b.st[1] = nx; }
        const unsigned old = xb_add(&bar[XB_XSUB(b.x)], 1u);
        const unsigned gen = old / nloc;
        if (old + 1u == (gen + 1u) * nloc) {
            __builtin_amdgcn_fence(__ATOMIC_RELEASE, "agent");
            asm volatile("s_waitcnt vmcnt(0)" ::: "memory");
            const unsigned og = xb_add(&bar[XB_TOP], 1u);
            const unsigned tg = og / nx;
            if (og + 1u == (tg + 1u) * nx) xb_add(&bar[XB_TOPGEN], 1u);
            else XB_SPIN(xb_ld(&bar[XB_TOPGEN]) == tg, bar);
            __builtin_amdgcn_fence(__ATOMIC_ACQUIRE, "agent");
            asm volatile("s_waitcnt vmcnt(0)" ::: "memory");
        } else {
            XB_SPIN(xb_ld(&bar[XB_TOPGEN]) == gen, bar);
            __builtin_amdgcn_fence(__ATOMIC_ACQUIRE, "agent");
            asm volatile("s_waitcnt vmcnt(0)" ::: "memory");
        }
    }
    __syncthreads();
}

struct Frame {
    unsigned char* lds;
    int tid, lane, wave, G;
    float* out; unsigned char* ws;
};
#define WSP(T, off) ((T*)(F.ws + (off)))

struct EpiZ {
    static constexpr bool PERM = true, AFTER_DRAIN = false;
    bf16* O; int ldc; float* dt;
    __device__ __forceinline__ void operator()(const pg8::f32x4 (&acc)[2][2][4][2], const pg8::Unit& u, int wr_, int wc_, int fr_, int fq_) const {
        int tz_ = threadIdx.x; asm volatile("" : "+v"(tz_));
        const int fr = tz_ & 15, fq = (tz_ & 63) >> 4, wid_ = __builtin_amdgcn_readfirstlane(tz_ >> 6), wr = wid_ >> 2, wc = wid_ & 3; (void)wr_; (void)wc_; (void)fr_; (void)fq_;
        const int row0 = u.pm * 256 + wr * 64 + fr, col0 = u.pn * 256 + wc * 32 + 8 * fq;
#pragma unroll
        for (int ai = 0; ai < 2; ++ai)
#pragma unroll
            for (int m = 0; m < 4; ++m) { const int row = row0 + ai * 128 + m * 16; bf16* rp = O + (size_t)row * ldc + col0;
#pragma unroll
                for (int bj = 0; bj < 2; ++bj) { const pg8::f32x4 v0 = acc[ai][bj][m][0], v1 = acc[ai][bj][m][1];
                    v4u w; w.x = pg8::cvt_pk_bf16(v0[0], v0[1]); w.y = pg8::cvt_pk_bf16(v0[2], v0[3]); w.z = pg8::cvt_pk_bf16(v1[0], v1[1]); w.w = pg8::cvt_pk_bf16(v1[2], v1[3]);
                    *(v4u*)(rp + bj * 128) = w;
                    if (dt != nullptr && bj == 0 && col0 == YDT) { *(f32x4*)(dt + (size_t)row * 8) = v0; *(f32x4*)(dt + (size_t)row * 8 + 4) = v1; } } }
    }
};
template <bool XB16, bool OB16> struct EpiRes {
    static constexpr bool PERM = true, AFTER_DRAIN = false;
    const void* xp; const void* xs; const float* mod; void* out;
    __device__ __forceinline__ void operator()(const pg8::f32x4 (&acc)[2][2][4][2], const pg8::Unit& u, int wr_, int wc_, int fr_, int fq_) const {
        int tz_ = threadIdx.x; asm volatile("" : "+v"(tz_));
        const int fr = tz_ & 15, fq = (tz_ & 63) >> 4, wid_ = __builtin_amdgcn_readfirstlane(tz_ >> 6), wr = wid_ >> 2, wc = wid_ & 3; (void)wr_; (void)wc_; (void)fr_; (void)fq_;
        const int row0 = u.pm * 256 + wr * 64 + fr, col0 = u.pn * 256 + wc * 32 + 8 * fq;
#pragma unroll
        for (int ai = 0; ai < 2; ++ai)
#pragma unroll
            for (int m = 0; m < 4; ++m) { const int row = row0 + ai * 128 + m * 16;
                const size_t xo = (row < TP) ? (size_t)row * DM : (size_t)(row - TP) * DM; const void* xb = (row < TP) ? xp : xs; const float* gr = mod + (size_t)mod_row(row) * 3072 + 2048;
#pragma unroll
                for (int bj = 0; bj < 2; ++bj) { const int c = col0 + bj * 128; float x8[8];
                    if (XB16) unpack8(*(const v4u*)((const bf16*)xb + xo + c), x8);
                    else { const f32x4 x0 = *(const f32x4*)((const float*)xb + xo + c), x1 = *(const f32x4*)((const float*)xb + xo + c + 4); x8[0] = x0.x; x8[1] = x0.y; x8[2] = x0.z; x8[3] = x0.w; x8[4] = x1.x; x8[5] = x1.y; x8[6] = x1.z; x8[7] = x1.w; }
                    const f32x4 g0 = *(const f32x4*)(gr + c), g1 = *(const f32x4*)(gr + c + 4); const pg8::f32x4 a0 = acc[ai][bj][m][0], a1 = acc[ai][bj][m][1];
                    float o[8] = {x8[0] + g0.x * a0[0], x8[1] + g0.y * a0[1], x8[2] + g0.z * a0[2], x8[3] + g0.w * a0[3], x8[4] + g1.x * a1[0], x8[5] + g1.y * a1[1], x8[6] + g1.z * a1[2], x8[7] + g1.w * a1[3]};
                    if (OB16) *(v4u*)((bf16*)out + (size_t)row * DM + c) = pack8(o);
                    else { float* op = (float*)out + (size_t)row * DM + c; *(f32x4*)(op) = (f32x4){o[0], o[1], o[2], o[3]}; *(f32x4*)((op + 4)) = (f32x4){o[4], o[5], o[6], o[7]}; } } }
    }
};

template <bool PERMQK> __device__ __forceinline__ void transpose_item(const float* W, int K, int N, int Npad, bf16* WT, float* scr, int item, int lane) {
    const int nblk = Npad / 32, kb = item / nblk, nb = item % nblk, k0 = 64 * kb, n0 = 32 * nb;
    int nn = n0 + (lane & 31);
    if (PERMQK && nn >= ZQB && nn < ZVB) { const int p = nn & 63; nn = (nn & ~63) + (p >> 1) + 32 * (p & 1); }
#pragma unroll 8
    for (int i = 0; i < 32; ++i) { const int kk = 2 * i + (lane >> 5); scr[kk * 33 + (lane & 31)] = (nn < N) ? W[(size_t)(k0 + kk) * N + nn] : 0.f; }
    asm volatile("s_waitcnt lgkmcnt(0)" ::: "memory");
    const int c = lane & 7;
#pragma unroll
    for (int j = 0; j < 4; ++j) { const int n = (lane >> 3) + 8 * j; const float* s = scr + (8 * c) * 33 + n;
        v4u o; o.x = pk2(s[0 * 33], s[1 * 33]); o.y = pk2(s[2 * 33], s[3 * 33]); o.z = pk2(s[4 * 33], s[5 * 33]); o.w = pk2(s[6 * 33], s[7 * 33]);
        *(v4u*)(WT + (size_t)(n0 + n) * K + k0 + 8 * c) = o; }
    asm volatile("s_waitcnt lgkmcnt(0)" ::: "memory");
}
__device__ __forceinline__ void weights_phase(Frame& F, int nwg) {
    if ((int)blockIdx.x >= nwg) return;
    const int gw = blockIdx.x * NWAVES + F.wave, NGW = nwg * NWAVES;
    float* scr = (float*)(F.lds + F.wave * 8704);
    constexpr int I_EIN = 16 * (NE / 32), I_EOUT = 16 * 32, I_OIN = 16 * (NOP / 32), I_OOUT = 16 * 32;
    for (int it = gw; it < I_EIN + I_EOUT + I_OIN + I_OOUT; it += NGW) {
        int r = it;
        if (r < I_EIN) { transpose_item<true>(INP(14), DM, NE, NE, WSP(bf16, WS_WINE), scr, r, F.lane); continue; } r -= I_EIN;
        if (r < I_EOUT) { transpose_item<false>(INP(17), DM, DM, DM, WSP(bf16, WS_WOUTE), scr, r, F.lane); continue; } r -= I_EOUT;
        if (r < I_OIN) { transpose_item<false>(INP(21), DM, NO, NOP, WSP(bf16, WS_WINO), scr, r, F.lane); continue; } r -= I_OIN;
        transpose_item<false>(INP(30), DM, DM, DM, WSP(bf16, WS_WOUTO), scr, r, F.lane);
    }
}
__device__ __forceinline__ void rope_phase(Frame& F) {
    f32x2* rope = WSP(f32x2, WS_ROPE);
    for (int e = blockIdx.x * NTHR + F.tid; e < 4096 * 32; e += F.G * NTHR) { const int pos = e >> 5, i = e & 31;
        const float inv = exp2f(-(float)i * (13.287712379549449f / 32.f));
        const double turns = (double)((float)pos * inv) * 0.15915494309189535;
        const float fr = (float)(turns - floor(turns));
        f32x2 cs; cs.x = __builtin_amdgcn_cosf(fr); cs.y = __builtin_amdgcn_sinf(fr); rope[e] = cs; }
}
template <bool XB16> __device__ __forceinline__ void normmod_phase(Frame& F, const void* xp, const void* xs, const float* nw, const float* mod) {
    const int gw = blockIdx.x * NWAVES + F.wave, NGW = F.G * NWAVES; bf16* H = WSP(bf16, WS_H);
    f32x4 w4[4];
#pragma unroll
    for (int j = 0; j < 4; ++j) w4[j] = *(const f32x4*)(nw + 4 * F.lane + 256 * j);
    for (int r = gw; r < MR; r += NGW) {
        const size_t xo = (r < TP) ? (size_t)r * DM : (size_t)(r - TP) * DM; const void* xb = (r < TP) ? xp : xs; const float* mr = mod + (size_t)mod_row(r) * 3072;
        f32x4 v[4], sh[4], scl[4]; float s = 0.f;
#pragma unroll
        for (int j = 0; j < 4; ++j) { const int c = 4 * F.lane + 256 * j;
            if (XB16) { const v2u w = *(const v2u*)((const bf16*)xb + xo + c); v[j] = (f32x4){bf2f(w.x & 0xffffu), __uint_as_float(w.x & 0xffff0000u), bf2f(w.y & 0xffffu), __uint_as_float(w.y & 0xffff0000u)}; }
            else v[j] = *(const f32x4*)((const float*)xb + xo + c);
            sh[j] = *(const f32x4*)(mr + c); scl[j] = *(const f32x4*)(mr + 1024 + c); }
#pragma unroll
        for (int j = 0; j < 4; ++j) s += (v[j].x * v[j].x + v[j].y * v[j].y) + (v[j].z * v[j].z + v[j].w * v[j].w);
        const float rstd = rsqrtf(wave_sum(s) * (1.f / DM) + EPS);
#pragma unroll
        for (int j = 0; j < 4; ++j) { const int c = 4 * F.lane + 256 * j; const f32x4 w = w4[j];
            const float a = v[j].x * rstd * w.x * (1.f + scl[j].x) + sh[j].x, b = v[j].y * rstd * w.y * (1.f + scl[j].y) + sh[j].y, cc = v[j].z * rstd * w.z * (1.f + scl[j].z) + sh[j].z, d = v[j].w * rstd * w.w * (1.f + scl[j].w) + sh[j].w;
            v2u o; o.x = pk2(a, b); o.y = pk2(cc, d); *(v2u*)(H + (size_t)r * DM + c) = o; }
    }
}
struct EpiL0 {
    static constexpr bool PERM = true, AFTER_DRAIN = false;
    bf16* Z; float* out; const float* qw; const float* kw; const f32x2* rope; float* kmean; float* xs;
    __device__ __forceinline__ void store8(bf16* p, const float* f) const { v4u w; w.x = pg8::cvt_pk_bf16(f[0], f[1]); w.y = pg8::cvt_pk_bf16(f[2], f[3]); w.z = pg8::cvt_pk_bf16(f[4], f[5]); w.w = pg8::cvt_pk_bf16(f[6], f[7]); *(v4u*)p = w; }
    __device__ __forceinline__ void operator()(const pg8::f32x4 (&acc)[2][2][4][2], const pg8::Unit& u, int wr_, int wc_, int fr_, int fq_) const {
        int tz_ = threadIdx.x; asm volatile("" : "+v"(tz_));
        const int fr = tz_ & 15, fq = (tz_ & 63) >> 4, wid_ = __builtin_amdgcn_readfirstlane(tz_ >> 6), wr = wid_ >> 2, wc = wid_ & 3; (void)wr_; (void)wc_; (void)fr_; (void)fq_;
        const int pn = u.pn, rl0 = wr * 64 + fr, cw = wc * 32 + 8 * fq, col0 = pn * 256 + cw;
        if (pn < 4) {
            const bool isk = pn >= 2; const float* nw = isk ? kw : qw; const int ch = cw & 63;
            float w8[8];
#pragma unroll
            for (int j = 0; j < 8; ++j) w8[j] = nw[ch + j];
#pragma unroll
            for (int ai = 0; ai < 2; ++ai)
#pragma unroll
                for (int bj = 0; bj < 2; ++bj)
#pragma unroll
                    for (int m = 0; m < 4; ++m) { const pg8::f32x4 v0 = acc[ai][bj][m][0], v1 = acc[ai][bj][m][1];
                        float s = (v0[0] * v0[0] + v0[1] * v0[1]) + (v0[2] * v0[2] + v0[3] * v0[3]) + (v1[0] * v1[0] + v1[1] * v1[1]) + (v1[2] * v1[2] + v1[3] * v1[3]);
                        s += __shfl_xor(s, 16); s += __shfl_xor(s, 32);
                        if (fq == 0) xs[(ai * 128 + rl0 + m * 16) * 8 + bj * 4 + wc] = s; }
            asm volatile("s_waitcnt lgkmcnt(0)" ::: "memory"); __builtin_amdgcn_s_barrier(); asm volatile("" ::: "memory");
            float cs[2][8];
#pragma unroll
            for (int bj = 0; bj < 2; ++bj)
#pragma unroll
                for (int j = 0; j < 8; ++j) cs[bj][j] = 0.f;
#pragma unroll
            for (int ai = 0; ai < 2; ++ai)
#pragma unroll
                for (int m = 0; m < 4; ++m) { const int rl = ai * 128 + rl0 + m * 16, row = u.pm * 256 + rl;
#pragma unroll
                    for (int bj = 0; bj < 2; ++bj) { const float tot = xs[rl * 8 + bj * 4 + wc] + xs[rl * 8 + bj * 4 + (wc ^ 1)];
                        float rs = rsqrtf(tot * (1.f / 64.f) + EPS); if (!isk && row < TP) rs *= attn_body::C2;
                        const pg8::f32x4 v0 = acc[ai][bj][m][0], v1 = acc[ai][bj][m][1];
                        float f[8] = {v0[0] * rs * w8[0], v0[1] * rs * w8[1], v0[2] * rs * w8[2], v0[3] * rs * w8[3], v1[0] * rs * w8[4], v1[1] * rs * w8[5], v1[2] * rs * w8[6], v1[3] * rs * w8[7]};
                        store8(Z + (size_t)row * NE + col0 + bj * 128, f);
                        if (isk) { float* ko = ((row < TP) ? out + O_KP + (size_t)row * 512 : out + O_KS + (size_t)(row - TP) * 512) + (pn - 2) * 256 + bj * 128 + cw;
                            *(f32x4*)(ko) = (f32x4){f[0], f[1], f[2], f[3]}; *(f32x4*)((ko + 4)) = (f32x4){f[4], f[5], f[6], f[7]};
#pragma unroll
                            for (int j = 0; j < 8; ++j) cs[bj][j] += f[j]; } } }
            if (isk && u.pm < TP / 256) { float* ks = xs + 2048;
#pragma unroll
                for (int bj = 0; bj < 2; ++bj)
#pragma unroll
                    for (int j = 0; j < 8; ++j) { float v = cs[bj][j]; v += __shfl_xor(v, 1); v += __shfl_xor(v, 2); v += __shfl_xor(v, 4); v += __shfl_xor(v, 8); cs[bj][j] = v;
                        if (wr == 1 && fr == 0) ks[bj * 128 + cw + j] = v; }
                asm volatile("s_waitcnt lgkmcnt(0)" ::: "memory"); __builtin_amdgcn_s_barrier(); asm volatile("" ::: "memory");
                if (wr == 0 && fr == 0) {
#pragma unroll
                    for (int bj = 0; bj < 2; ++bj)
#pragma unroll
                        for (int j = 0; j < 8; ++j) kmean[(size_t)u.pm * 512 + (pn - 2) * 256 + bj * 128 + cw + j] = (cs[bj][j] + ks[bj * 128 + cw + j]) * (1.f / 256.f); } }
        } else if (pn == 8 || pn == 9) {
            const float sc = (pn == 9) ? 0.125f : 1.f; const int i0 = (cw & 63) >> 1;
#pragma unroll
            for (int ai = 0; ai < 2; ++ai)
#pragma unroll
                for (int m = 0; m < 4; ++m) { const int row = u.pm * 256 + ai * 128 + rl0 + m * 16; const f32x2* rp = rope + pos_of(row) * 32 + i0;
                    const f32x4 r01 = *(const f32x4*)rp, r23 = *(const f32x4*)(rp + 2);
#pragma unroll
                    for (int bj = 0; bj < 2; ++bj) { const pg8::f32x4 v0 = acc[ai][bj][m][0], v1 = acc[ai][bj][m][1];
                        float f[8] = {(v0[0] * r01.x - v0[1] * r01.y) * sc, (v0[0] * r01.y + v0[1] * r01.x) * sc, (v0[2] * r01.z - v0[3] * r01.w) * sc, (v0[2] * r01.w + v0[3] * r01.z) * sc,
                                      (v1[0] * r23.x - v1[1] * r23.y) * sc, (v1[0] * r23.y + v1[1] * r23.x) * sc, (v1[2] * r23.z - v1[3] * r23.w) * sc, (v1[2] * r23.w + v1[3] * r23.z) * sc};
                        store8(Z + (size_t)row * NE + col0 + bj * 128, f); } }
        } else {
            const bool act = (pn == 6 || pn == 7 || pn >= 12), isv = (pn == 4 || pn == 5);
#pragma unroll
            for (int ai = 0; ai < 2; ++ai)
#pragma unroll
                for (int m = 0; m < 4; ++m) { const int row = u.pm * 256 + ai * 128 + rl0 + m * 16;
#pragma unroll
                    for (int bj = 0; bj < 2; ++bj) { const pg8::f32x4 v0 = acc[ai][bj][m][0], v1 = acc[ai][bj][m][1];
                        float f[8] = {v0[0], v0[1], v0[2], v0[3], v1[0], v1[1], v1[2], v1[3]};
                        if (act) {
#pragma unroll
                            for (int j = 0; j < 8; ++j) f[j] = silu_f(f[j]); }
                        store8(Z + (size_t)row * NE + col0 + bj * 128, f);
                        if (isv) { float* vo = ((row < TP) ? out + O_VP + (size_t)row * 512 : out + O_VS + (size_t)(row - TP) * 512) + (pn - 4) * 256 + bj * 128 + cw;
                            *(f32x4*)(vo) = (f32x4){f[0], f[1], f[2], f[3]}; *(f32x4*)((vo + 4)) = (f32x4){f[4], f[5], f[6], f[7]}; } } }
        }
    }
};
__device__ __forceinline__ float ret_log2g(int h) { return log2f(1.f - exp2f(-5.f - (float)h)); }
__device__ __forceinline__ void smp_pass1_item(Frame& F, int item) {
    const int n = item & 7, b = item >> 3; const bf16* Z = WSP(bf16, WS_Z); const float* ck = INP(2); const int* pt = (const int*)INP(7);
    float* scs = (float*)F.lds;
    float* red = scs + 32 * 256;
    const int lane = F.lane, c4 = lane * 4;
    float q[4][8];
#pragma unroll
    for (int t = 0; t < 4; ++t) { const bf16* qr = Z + (size_t)(TP + b * 4 + t) * NE + ZQA + c4; const uint2 lo = *(const uint2*)qr, hi = *(const uint2*)(qr + 256);
        q[t][0] = __uint_as_float(lo.x << 16); q[t][1] = __uint_as_float(lo.x & 0xffff0000u); q[t][2] = __uint_as_float(lo.y << 16); q[t][3] = __uint_as_float(lo.y & 0xffff0000u);
        q[t][4] = __uint_as_float(hi.x << 16); q[t][5] = __uint_as_float(hi.x & 0xffff0000u); q[t][6] = __uint_as_float(hi.y << 16); q[t][7] = __uint_as_float(hi.y & 0xffff0000u); }
    float ks[8];
#pragma unroll
    for (int i = 0; i < 8; ++i) ks[i] = 0.f;
    const int pg0 = pt[b * NPAGES + 2 * n], pg1 = pt[b * NPAGES + 2 * n + 1];
    __syncthreads();
    const float* kbase0 = ck + ((size_t)pg0 * PAGE + F.wave) * 512 + c4; const float* kbase1 = ck + ((size_t)pg1 * PAGE + F.wave) * 512 + c4;
    f32x4 ka0[4], kb0[4], ka1[4], kb1[4];
#define P1_LOAD(KA, KB, bt) do { const float* kb_ = ((bt) < 4 ? kbase0 : kbase1) + (size_t)(((bt) & 3) * 32) * 512; \
        _Pragma("unroll") for (int u = 0; u < 4; ++u) { KA[u] = __builtin_nontemporal_load((const f32x4*)(kb_ + (size_t)u * 8 * 512)); KB[u] = __builtin_nontemporal_load((const f32x4*)(kb_ + (size_t)u * 8 * 512 + 256)); } } while (0)
#define P1_COMP(KA, KB, bt) do { _Pragma("unroll") for (int u = 0; u < 4; ++u) { const int r = F.wave + 8 * (4 * (bt) + u); \
        const float k[8] = {KA[u].x, KA[u].y, KA[u].z, KA[u].w, KB[u].x, KB[u].y, KB[u].z, KB[u].w}; \
        _Pragma("unroll") for (int i = 0; i < 8; ++i) ks[i] += k[i]; \
        _Pragma("unroll") for (int t = 0; t < 4; ++t) { float s0 = (q[t][0] * k[0] + q[t][1] * k[1]) + (q[t][2] * k[2] + q[t][3] * k[3]), s1 = (q[t][4] * k[4] + q[t][5] * k[5]) + (q[t][6] * k[6] + q[t][7] * k[7]); \
            s0 = red16_dpp(s0); s1 = red16_dpp(s1); \
            if ((lane & 15) == 0) { scs[((lane >> 4) * 4 + t) * 256 + r] = s0; scs[((4 + (lane >> 4)) * 4 + t) * 256 + r] = s1; } } } } while (0)
    P1_LOAD(ka0, kb0, 0);
#pragma unroll 1
    for (int bt = 0; bt < 8; bt += 2) {
        P1_LOAD(ka1, kb1, bt + 1); __builtin_amdgcn_sched_barrier(0);
        P1_COMP(ka0, kb0, bt);     __builtin_amdgcn_sched_barrier(0);
        if (bt + 2 < 8) { P1_LOAD(ka0, kb0, bt + 2); } __builtin_amdgcn_sched_barrier(0);
        P1_COMP(ka1, kb1, bt + 1); __builtin_amdgcn_sched_barrier(0);
    }
#undef P1_LOAD
#undef P1_COMP
#pragma unroll
    for (int i = 0; i < 8; ++i) red[F.wave * 512 + (i >> 2) * 256 + c4 + (i & 3)] = ks[i];
    __syncthreads();
    { float s = 0.f;
#pragma unroll
      for (int w = 0; w < 8; ++w) s += red[w * 512 + F.tid];
      WSP(float, WS_KMS)[(size_t)(b * 8 + n) * 512 + F.tid] = s * (1.f / 256.f); }
    float* SC = WSP(float, WS_SC);
    for (int e = F.tid; e < 32 * 256; e += NTHR) { const int ht = e >> 8, r = e & 255; SC[((size_t)(b * 8 + (ht >> 2)) * 4 + (ht & 3)) * 2048 + n * 256 + r] = scs[e]; }
}
__device__ __forceinline__ void smp_ret_item(Frame& F, int item) {
    const int h = item & 3, b = item >> 2; const bf16* Z = WSP(bf16, WS_Z); bf16* MIX = WSP(bf16, WS_MIX);
    float* qs = (float*)F.lds;
    float* ks = qs + 256;
    float* vs = ks + 256;
    float* po = vs + 512;
    float* qk = po + 2048;
    float* red = qk + 16;
    const int tid = F.tid, e = tid & 127, dq = tid >> 7; const int rs0 = TP + b * 4; const float lg = ret_log2g(h);
    const float* stp = INP(4) + (size_t)((b * 4 + h) * 64 + dq * 16) * 128 + e; float* nsp = F.out + O_RSS + (size_t)((b * 4 + h) * 64 + dq * 16) * 128 + e;
    float st[16];
#pragma unroll
    for (int dd = 0; dd < 16; ++dd) st[dd] = __builtin_nontemporal_load(stp + dd * 128);
    const float gb = bf2f(Z[(size_t)(rs0 + dq) * NE + ZGB + h * 128 + e]);
    __syncthreads();
    if (tid < 256) { const int i = tid >> 6, d = tid & 63, pd = 2 * (d & 31) + (d >> 5);
        qs[tid] = bf2f(Z[(size_t)(rs0 + i) * NE + ZQB + h * 64 + pd]); ks[tid] = bf2f(Z[(size_t)(rs0 + i) * NE + ZKB + h * 64 + pd]); }
    { const int i = tid >> 7; vs[tid] = bf2f(Z[(size_t)(rs0 + i) * NE + ZVB + h * 128 + e]); }
    __syncthreads();
    if (tid < 16) { const int i = tid >> 2, jj = tid & 3; float s = 0.f; for (int d = 0; d < 64; ++d) s += qs[i * 64 + d] * ks[jj * 64 + d]; qk[tid] = (jj <= i) ? s * exp2f((float)(i - jj) * lg) : 0.f; }
    float pa[4] = {0.f, 0.f, 0.f, 0.f};
    const float g4 = exp2f(4.f * lg), g3 = exp2f(3.f * lg), g2 = exp2f(2.f * lg), g1 = exp2f(lg);
#pragma unroll
    for (int dd = 0; dd < 16; ++dd) { const int d = dq * 16 + dd;
        const float ns = st[dd] * g4 + g3 * ks[d] * vs[e] + g2 * ks[64 + d] * vs[128 + e] + g1 * ks[128 + d] * vs[256 + e] + ks[192 + d] * vs[384 + e];
        __builtin_nontemporal_store(ns, nsp + dd * 128);
#pragma unroll
        for (int i = 0; i < 4; ++i) pa[i] += qs[i * 64 + d] * st[dd]; }
#pragma unroll
    for (int i = 0; i < 4; ++i) po[(dq * 4 + i) * 128 + e] = pa[i];
    __syncthreads();
    { const int i = dq; float inter = po[(0 * 4 + i) * 128 + e] + po[(1 * 4 + i) * 128 + e] + po[(2 * 4 + i) * 128 + e] + po[(3 * 4 + i) * 128 + e];
      inter *= exp2f((float)(i + 1) * lg); float intra = 0.f;
      for (int jj = 0; jj <= i; ++jj) intra += qk[i * 4 + jj] * vs[jj * 128 + e];
      const float ov = intra + inter; const float ss = wave_sum(ov * ov);
      if (F.lane == 0) red[F.wave] = ss;
      __syncthreads();
      const float rstd = rsqrtf((red[2 * i] + red[2 * i + 1]) * (1.f / 128.f) + EPS);
      MIX[(size_t)(rs0 + i) * DM + 512 + h * 128 + e] = (bf16)f2bf(ov * rstd * gb); }
}
__device__ __forceinline__ void ret_scan_phase(Frame& F) {
    const float* S = WSP(float, WS_SLR); bf16* PB = WSP(bf16, WS_PBR);
    for (int idx = blockIdx.x * NTHR + F.tid; idx < 16 * 4096; idx += F.G * NTHR) { const int bh = idx >> 12, e = (idx & 4095) * 2; const float g128 = exp2f(128.f * ret_log2g(bh & 3));
        const float* p = S + (size_t)bh * 32 * 8192 + e; bf16* q = PB + (size_t)bh * 32 * 8192 + e; f32x2 st = (f32x2){0.f, 0.f};
        f32x2 loc[32];
#pragma unroll
        for (int c = 0; c < 32; ++c) loc[c] = *(const f32x2*)(p + (size_t)c * 8192);
#pragma unroll
        for (int c = 0; c < 32; ++c) { *(unsigned*)(q + (size_t)c * 8192) = pk2(st.x, st.y); st = st * g128 + loc[c]; }
        { const int dp = e >> 7, dorig = (dp >> 1) + 32 * (dp & 1); *(f32x2*)(F.out + O_RSP + (size_t)bh * 8192 + dorig * 128 + (e & 127)) = st; } }
}
__device__ __forceinline__ void smp_pass2_item(Frame& F, int item) {
    const int h = item & 7, b = item >> 3; const bf16* Z = WSP(bf16, WS_Z); bf16* MIX = WSP(bf16, WS_MIX); const float* cv = INP(3); const int* pt = (const int*)INP(7);
    float* P = (float*)F.lds;
    float* km = P + 4 * 2056;
    float* qs = km + 512;
    float* gts = qs + 256;
    float* biasT = gts + 32;
    float* red = biasT + 264;
    float* stat = red + 2304;
    unsigned* selm = (unsigned*)(stat + 8);
    int* pgl = (int*)(selm + 8);
    int tz_ = threadIdx.x; asm volatile("" : "+v"(tz_));
    const int tid = tz_, lane_ = tz_ & 63, rs0 = TP + b * 4;
    float scv[16];
    { const float* SC = WSP(float, WS_SC) + (size_t)(b * 8 + h) * 4 * 2048;
#pragma unroll
      for (int k = 0; k < 16; ++k) scv[k] = SC[tid + NTHR * k]; }
    __syncthreads();
    if (tid < 16) pgl[tid] = pt[b * NPAGES + tid];
    { const int n = tid >> 6, d = tid & 63; km[tid] = WSP(float, WS_KMS)[(size_t)(b * 8 + n) * 512 + h * 64 + d]; }
    if (tid < 256) qs[tid] = bf2f(Z[(size_t)(rs0 + (tid >> 6)) * NE + ZQA + h * 64 + (tid & 63)]);
    { const float* rb = INP(10); for (int e = tid; e < 264; e += NTHR) biasT[e] = rb[t5_bucket(e) * 8 + h]; }
    __syncthreads();
    if (tid < 32) { const int t = tid >> 3, n = tid & 7; float s = 0.f; for (int d = 0; d < 64; ++d) s += qs[t * 64 + d] * km[n * 64 + d]; gts[tid] = s; }
    __syncthreads();
    if (tid < 4) { unsigned mk = 0u;
        for (int r = 0; r < 3; ++r) { float best = -3e38f; int bi = 0; for (int n = 0; n < 8; ++n) if (!((mk >> n) & 1u) && gts[tid * 8 + n] > best) { best = gts[tid * 8 + n]; bi = n; } mk |= 1u << bi; }
        selm[tid] = mk; }
    __syncthreads();
    const unsigned un = selm[0] | selm[1] | selm[2] | selm[3]; const int rsub = lane_ >> 4, d4 = (lane_ & 15) * 4;
    f32x4 va[8], vb[8];
    const __amdgpu_buffer_rsrc_t vrs = __builtin_amdgcn_make_buffer_rsrc((void*)cv, (short)0, (int)((size_t)NPHYS * PAGE * 512 * 4), 0x00020000);
    const int vvo = rsub * 2048 + h * 256 + d4 * 4;
#define P2_LOAD(V, n) do { const int pg0_ = __builtin_amdgcn_readfirstlane(pgl[2 * (n)]), pg1_ = __builtin_amdgcn_readfirstlane(pgl[2 * (n) + 1]); \
        _Pragma("unroll") for (int it = 0; it < 8; ++it) { const int so_ = (((it < 4) ? pg0_ : pg1_) * PAGE + (it & 3) * 32 + F.wave * 4) * 2048; \
            V[it] = __builtin_bit_cast(f32x4, __builtin_amdgcn_raw_buffer_load_b128(vrs, vvo, so_, 2)); } } while (0)
    unsigned rem = un; int nA = __ffs(rem) - 1; rem &= rem - 1u; P2_LOAD(va, nA);
#pragma unroll
    for (int k = 0; k < 16; ++k) { const int e = tid + NTHR * k, t = e >> 11, idx = e & 2047, n = idx >> 8; const int dist = PAST + t - idx;
        P[t * 2056 + idx] = ((selm[t] >> n) & 1u) ? scv[k] * 0.125f + biasT[dist > 263 ? 263 : dist] : -1e30f; }
    if (tid < 16) { const int t = tid >> 2, t2 = tid & 3; float s = -1e30f;
        if (t2 <= t) { float a = 0.f; for (int d = 0; d < 64; ++d) a += qs[t * 64 + d] * bf2f(Z[(size_t)(rs0 + t2) * NE + ZKA + h * 64 + d]); s = a * 0.125f + biasT[t - t2]; }
        P[t * 2056 + 2048 + t2] = s; }
    __syncthreads();
    { const int t = F.wave >> 1, hf = F.wave & 1; float mx = -1e30f;
      for (int i = lane_ + 64 * hf; i < 2052; i += 128) mx = fmaxf(mx, P[t * 2056 + i]);
      mx = wave_max(mx); if (lane_ == 0) red[F.wave] = mx;
      __syncthreads();
      const float M = fmaxf(red[2 * t], red[2 * t + 1]); float sm = 0.f;
      for (int i = lane_ + 64 * hf; i < 2052; i += 128) { const float x = P[t * 2056 + i]; const float p = (x > -1e29f) ? __expf(x - M) : 0.f; P[t * 2056 + i] = p; sm += p; }
      sm = wave_sum(sm); if (lane_ == 0) red[8 + F.wave] = sm;
      __syncthreads();
      if (tid < 4) stat[4 + tid] = 1.f / (red[8 + 2 * tid] + red[8 + 2 * tid + 1]); }
    __syncthreads();
    float acc[4][4];
#pragma unroll
    for (int t = 0; t < 4; ++t)
#pragma unroll
        for (int k = 0; k < 4; ++k) acc[t][k] = 0.f;
#define P2_COMP(V, n) do { _Pragma("unroll") for (int it = 0; it < 8; ++it) { const int r = (it * 8 + F.wave) * 4 + rsub; \
        _Pragma("unroll") for (int t = 0; t < 4; ++t) { const float p = P[t * 2056 + (n) * 256 + r]; acc[t][0] += p * V[it].x; acc[t][1] += p * V[it].y; acc[t][2] += p * V[it].z; acc[t][3] += p * V[it].w; } } } while (0)
    f32x4 vc[8];
    int nB = __ffs(rem) - 1; rem &= rem - 1u; P2_LOAD(vb, nB);
    int nC = __ffs(rem) - 1; rem &= rem - 1u; P2_LOAD(vc, nC);
    for (;;) {
        P2_COMP(va, nA); nA = -1; if (rem) { nA = __ffs(rem) - 1; rem &= rem - 1u; P2_LOAD(va, nA); }
        if (nB < 0) break;
        P2_COMP(vb, nB); nB = -1; if (rem) { nB = __ffs(rem) - 1; rem &= rem - 1u; P2_LOAD(vb, nB); }
        if (nC < 0) break;
        P2_COMP(vc, nC); nC = -1; if (rem) { nC = __ffs(rem) - 1; rem &= rem - 1u; P2_LOAD(vc, nC); }
        if (nA < 0) break; }
#undef P2_LOAD
#undef P2_COMP
    if (F.wave == 0 && rsub == 0) { for (int t2 = 0; t2 < 4; ++t2) { float vf[4];
#pragma unroll
            for (int k = 0; k < 4; ++k) vf[k] = bf2f(Z[(size_t)(rs0 + t2) * NE + ZVA + h * 64 + d4 + k]);
#pragma unroll
            for (int t = 0; t < 4; ++t) { const float p = P[t * 2056 + 2048 + t2];
#pragma unroll
                for (int k = 0; k < 4; ++k) acc[t][k] += p * vf[k]; } } }
#pragma unroll
    for (int t = 0; t < 4; ++t)
#pragma unroll
        for (int k = 0; k < 4; ++k) { float v = acc[t][k]; v += __shfl_xor(v, 16); v += __shfl_xor(v, 32); acc[t][k] = v; }
    if (rsub == 0) {
#pragma unroll
        for (int t = 0; t < 4; ++t)
#pragma unroll
            for (int k = 0; k < 4; ++k) red[256 + (F.wave * 4 + t) * 64 + d4 + k] = acc[t][k]; }
    __syncthreads();
    if (tid < 256) { const int t = tid >> 6, d = tid & 63; float s = 0.f;
#pragma unroll
        for (int w = 0; w < 8; ++w) s += red[256 + (w * 4 + t) * 64 + d];
        const float g = bf2f(Z[(size_t)(rs0 + t) * NE + ZGA + h * 64 + d]);
        MIX[(size_t)(rs0 + t) * DM + h * 64 + d] = (bf16)f2bf(s * stat[4 + t] * g); }
}
__device__ __forceinline__ void post1_phase(Frame& F) {
    bf16* Z = WSP(bf16, WS_Z); bf16* XC = WSP(bf16, WS_XC); const float* cw = INP(24); const float* cb = INP(25); const float* scv = INP(6); const float* dtb = INP(26);
    const int gw = blockIdx.x * NWAVES + F.wave, NGW = F.G * NWAVES, lane = F.lane, c8 = lane * 8;
    float wgt[2][4][8], bia[2][8];
#pragma unroll
    for (int hf = 0; hf < 2; ++hf) { const int cc = hf * 512 + c8;
#pragma unroll
        for (int i = 0; i < 8; ++i) { bia[hf][i] = cb[cc + i];
#pragma unroll
            for (int w = 0; w < 4; ++w) wgt[hf][w][i] = cw[w * 1024 + cc + i]; } }
    const float dtbl = (lane < 8) ? dtb[lane] : 0.f;
    auto tap = [&](int r, int w, int cc) -> v4u { const int t = (r < TP) ? (r & (SEQ - 1)) : (r & 3), tt = t - 3 + w;
        if (tt >= 0) return *(const v4u*)(Z + (size_t)(r - 3 + w) * NOP + YXBC + cc);
        if (r >= TP) { const float* sp = scv + (size_t)(((r - TP) >> 2) * 3 + (tt + 3)) * 1024 + cc; const f32x4 a = *(const f32x4*)sp, b = *(const f32x4*)(sp + 4);
            v4u o; o.x = pk2(a.x, a.y); o.y = pk2(a.z, a.w); o.z = pk2(b.x, b.y); o.w = pk2(b.z, b.w); return o; }
        return (v4u){0u, 0u, 0u, 0u}; };
    for (int r0 = gw; r0 < MR; r0 += 2 * NGW) {
        const int r1 = (r0 + NGW < MR) ? r0 + NGW : r0;
        v4u vraw[2], xt[2][2][4]; float dtr[2];
#pragma unroll
        for (int q = 0; q < 2; ++q) { const int r = q ? r1 : r0; vraw[q] = *(const v4u*)(Z + (size_t)r * NOP + YV + c8); dtr[q] = (lane < 8) ? WSP(float, WS_DTRAW)[(size_t)r * 8 + lane] : 0.f;
#pragma unroll
            for (int hf = 0; hf < 2; ++hf)
#pragma unroll
                for (int w = 0; w < 4; ++w) xt[q][hf][w] = tap(r, w, hf * 512 + c8); }
#pragma unroll
        for (int q = 0; q < 2; ++q) { const int r = q ? r1 : r0; bf16* zr = Z + (size_t)r * NOP; float f[8];
            unpack8(vraw[q], f); float s = 0.f;
#pragma unroll
            for (int i = 0; i < 8; ++i) { f[i] = gelu_f(f[i]); s += f[i]; }
            const float mu = wave_sum(s) * (1.f / 512.f); float s2 = 0.f;
#pragma unroll
            for (int i = 0; i < 8; ++i) { f[i] -= mu; s2 += f[i] * f[i]; }
            const float rstd = rsqrtf(wave_sum(s2) * (1.f / 512.f) + EPS);
#pragma unroll
            for (int i = 0; i < 8; ++i) f[i] *= rstd;
            *(v4u*)(zr + YV + c8) = pack8(f);
            if (r >= TP) { float* o = F.out + O_SGV + (size_t)(r - TP) * 512 + c8; *(f32x4*)o = (f32x4){f[0], f[1], f[2], f[3]}; *(f32x4*)(o + 4) = (f32x4){f[4], f[5], f[6], f[7]}; }
            const int t = (r < TP) ? (r & (SEQ - 1)) : (r & 3); const int bs = (r - TP) >> 2;
#pragma unroll
            for (int hf = 0; hf < 2; ++hf) { const int cc = hf * 512 + c8; float a[8], x[8];
#pragma unroll
                for (int i = 0; i < 8; ++i) a[i] = bia[hf][i];
#pragma unroll
                for (int w = 0; w < 4; ++w) { unpack8(xt[q][hf][w], x);
#pragma unroll
                    for (int i = 0; i < 8; ++i) a[i] += x[i] * wgt[hf][w][i]; }
#pragma unroll
                for (int i = 0; i < 8; ++i) a[i] = silu_f(a[i]);
                *(v4u*)(XC + (size_t)r * 1024 + cc) = pack8(a);
                float* so = nullptr;
                if (r < TP) { if (t >= SEQ - 3) so = F.out + O_CSP + (size_t)((r >> 12) * 3 + (t - (SEQ - 3))) * 1024 + cc; }
                else if (t >= 1) so = F.out + O_CSS + (size_t)(bs * 3 + (t - 1)) * 1024 + cc;
                if (so) { *(f32x4*)so = (f32x4){x[0], x[1], x[2], x[3]}; *(f32x4*)(so + 4) = (f32x4){x[4], x[5], x[6], x[7]}; } }
            if (lane < 8) WSP(float, WS_DTH)[(size_t)r * 8 + lane] = softplus_f(dtr[q] + dtbl);
        }
    }
}
__device__ __forceinline__ void smp_l1_item(Frame& F, int item) {
    const int g = item & 1, b = item >> 1; const bf16* Z = WSP(bf16, WS_Z); const bf16* XC = WSP(bf16, WS_XC); bf16* MIX = WSP(bf16, WS_MIX); const float* DTH = WSP(float, WS_DTH);
    float* st = (float*)F.lds;
    float* xs = st + 64 * 129;
    float* bsm = xs + 1024;
    float* csm = bsm + 512;
    float* ygs = csm + 512;
    float* yp = ygs + 1024;
    float* cum = yp + 512;
    float* dts = cum + 16;
    float* cbs = dts + 16;
    const int tid = F.tid, rs0 = TP + b * 4;
    const float* sgw = INP(22); const float* sgb = INP(23); const float* alog = INP(27); const float* ssm_in = INP(5); const float* Dp = INP(28); const float* nw = INP(29);
    f32x4 sreg[4];
#pragma unroll
    for (int k = 0; k < 4; ++k) sreg[k] = __builtin_nontemporal_load((const f32x4*)(ssm_in + (size_t)(b * 8 + g * 4) * 8192 + tid * 4 + 2048 * k));
    __syncthreads();
    if (tid < 256) { const int col = g * 256 + tid, gc = col >> 7; float vn[4];
#pragma unroll
        for (int i = 0; i < 4; ++i) vn[i] = bf2f(Z[(size_t)(rs0 + i) * NOP + YV + col]);
#pragma unroll
        for (int i = 0; i < 4; ++i) { float a = sgb[gc * 128 + i];
#pragma unroll
            for (int jj = 0; jj < 4; ++jj) if (jj <= i) a += sgw[(size_t)gc * 16384 + i * 128 + jj] * vn[jj];
            const size_t zo = (size_t)(rs0 + i) * NOP + col;
            MIX[(size_t)(rs0 + i) * DM + col] = (bf16)f2bf(gelu_f(bf2f(Z[zo + YU])) * a * silu_f(bf2f(Z[zo + YGC]))); } }
    for (int e = tid; e < 1024; e += NTHR) { const int i = e >> 8, cc = e & 255; xs[e] = bf2f(XC[(size_t)(rs0 + i) * 1024 + g * 256 + cc]); }
    { const int i = tid >> 7, n = tid & 127; bsm[tid] = bf2f(XC[(size_t)(rs0 + i) * 1024 + 512 + g * 128 + n]); csm[tid] = bf2f(XC[(size_t)(rs0 + i) * 1024 + 768 + g * 128 + n]); }
    if (tid < 16) dts[tid] = DTH[(size_t)(rs0 + (tid >> 2)) * 8 + g * 4 + (tid & 3)];
    __syncthreads();
    if (tid < 4) { const float A = -__expf(alog[g * 4 + tid]); float s = 0.f; for (int i = 0; i < 4; ++i) { s += dts[i * 4 + tid] * A; cum[i * 4 + tid] = s; } }
    if (tid >= 64 && tid < 80) { const int i = (tid - 64) >> 2, jj = (tid - 64) & 3; float s = 0.f; for (int n = 0; n < 128; ++n) s += csm[i * 128 + n] * bsm[jj * 128 + n]; cbs[i * 4 + jj] = s; }
    __syncthreads();
    for (int hq = 0; hq < 4; ++hq) { const int h = g * 4 + hq; const float* sp = ssm_in + (size_t)(b * 8 + h) * 8192; float* so = F.out + O_SSS + (size_t)(b * 8 + h) * 8192;
#pragma unroll
        for (int k = 0; k < 4; ++k) { const int e = tid * 4 + 2048 * k; float* sd = st + (e >> 7) * 129 + (e & 127); sd[0] = sreg[k].x; sd[1] = sreg[k].y; sd[2] = sreg[k].z; sd[3] = sreg[k].w; }
        __syncthreads();
        if (hq < 3) {
#pragma unroll
            for (int k = 0; k < 4; ++k) sreg[k] = __builtin_nontemporal_load((const f32x4*)(sp + 8192 + tid * 4 + 2048 * k)); }
        const float c0 = cum[0 * 4 + hq], c1 = cum[1 * 4 + hq], c2 = cum[2 * 4 + hq], c3 = cum[3 * 4 + hq];
        { const int n = tid & 127, pq = tid >> 7; const float e3 = __expf(c3);
          const float w0 = __expf(c3 - c0) * dts[0 * 4 + hq] * bsm[n], w1 = __expf(c3 - c1) * dts[1 * 4 + hq] * bsm[128 + n], w2 = __expf(c3 - c2) * dts[2 * 4 + hq] * bsm[256 + n], w3 = dts[3 * 4 + hq] * bsm[384 + n];
#pragma unroll 4
          for (int pp = 0; pp < 16; ++pp) { const int p = pq * 16 + pp;
              __builtin_nontemporal_store(st[p * 129 + n] * e3 + w0 * xs[hq * 64 + p] + w1 * xs[256 + hq * 64 + p] + w2 * xs[512 + hq * 64 + p] + w3 * xs[768 + hq * 64 + p], so + p * 128 + n); } }
        { const int p = tid & 63, i = (tid >> 6) & 3, nh = tid >> 8; float s = 0.f;
          for (int n = nh * 64; n < nh * 64 + 64; ++n) s += csm[i * 128 + n] * st[p * 129 + n];
          yp[(nh * 4 + i) * 64 + p] = s; }
        __syncthreads();
        if (tid < 256) { const int p = tid & 63, i = tid >> 6; const float ci = cum[i * 4 + hq]; float y = __expf(ci) * (yp[i * 64 + p] + yp[(4 + i) * 64 + p]);
            for (int jj = 0; jj <= i; ++jj) y += cbs[i * 4 + jj] * __expf(ci - cum[jj * 4 + hq]) * dts[jj * 4 + hq] * xs[jj * 256 + hq * 64 + p];
            y += Dp[h] * xs[i * 256 + hq * 64 + p];
            ygs[i * 256 + hq * 64 + p] = y * silu_f(bf2f(Z[(size_t)(rs0 + i) * NOP + YZG + h * 64 + p])); }
        __syncthreads();
    }
    if (tid < 256) { const int i = tid >> 6; float v[4]; float ss = 0.f;
#pragma unroll
        for (int k = 0; k < 4; ++k) { v[k] = ygs[i * 256 + F.lane + 64 * k]; ss += v[k] * v[k]; }
        const float rstd = rsqrtf(wave_sum(ss) * (1.f / 256.f) + EPS);
#pragma unroll
        for (int k = 0; k < 4; ++k) { const int col = g * 256 + F.lane + 64 * k; MIX[(size_t)(rs0 + i) * DM + 512 + col] = (bf16)f2bf(v[k] * rstd * nw[col]); } }
}
__device__ __forceinline__ void ssd_scan_phase(Frame& F) {
    const float* S = WSP(float, WS_SLS); bf16* PB = WSP(bf16, WS_PBS); const float* cdec = WSP(float, WS_CDEC);
    for (int idx = blockIdx.x * NTHR + F.tid; idx < 32 * 4096; idx += F.G * NTHR) { const int bh = idx >> 12, e = (idx & 4095) * 2, b = bh >> 3, h = bh & 7; f32x2 st = (f32x2){0.f, 0.f};
        f32x2 loc[32];
#pragma unroll
        for (int c = 0; c < 32; ++c) loc[c] = *(const f32x2*)(S + (size_t)((b * 32 + c) * 8 + h) * 8192 + e);
#pragma unroll
        for (int c = 0; c < 32; ++c) { const size_t o = (size_t)((b * 32 + c) * 8 + h) * 8192 + e; *(unsigned*)(PB + o) = pk2(st.x, st.y); st = st * cdec[(b * 32 + c) * 8 + h] + loc[c]; }
        *(f32x2*)(F.out + O_SSP + (size_t)bh * 8192 + e) = st; }
}
namespace mm {
typedef short bf16x8 __attribute__((ext_vector_type(8)));
typedef short s16x4 __attribute__((ext_vector_type(4)));
#define MM_LAS __attribute__((address_space(3)))
__device__ __forceinline__ f32x4 mfma16(bf16x8 a, bf16x8 b, f32x4 c) { return __builtin_amdgcn_mfma_f32_16x16x32_bf16(a, b, c, 0, 0, 0); }
__device__ __forceinline__ bf16x8 frag_kc(const bf16* X, int pitch, int r0, int k0, int lane) { return *(const bf16x8*)(X + (r0 + (lane & 15)) * pitch + k0 + 8 * (lane >> 4)); }
__device__ __forceinline__ s16x4 trd(const bf16* p) { return __builtin_bit_cast(s16x4, __builtin_amdgcn_ds_read_tr16_b64_v4i16((MM_LAS s16x4*)p)); }
__device__ __forceinline__ bf16x8 frag_tr(const bf16* Y, int pitch, int ka, int kb, int n0, int lane) {
    const int m = lane & 15; const bf16* pa = Y + (ka + (m >> 2)) * pitch + n0 + 4 * (m & 3); const bf16* pb = Y + (kb + (m >> 2)) * pitch + n0 + 4 * (m & 3);
    const s16x4 lo = trd(pa), hi = trd(pb); return (bf16x8){lo[0], lo[1], lo[2], lo[3], hi[0], hi[1], hi[2], hi[3]};
}
__device__ __forceinline__ bf16x8 frag_tr_std(const bf16* Y, int pitch, int k0, int n0, int lane) { const int g = lane >> 4; return frag_tr(Y, pitch, k0 + 8 * g, k0 + 8 * g + 4, n0, lane); }
__device__ __forceinline__ bf16x8 frag_tr_acc(const bf16* Y, int pitch, int k0, int n0, int lane) { const int g = lane >> 4; return frag_tr(Y, pitch, k0 + 4 * g, k0 + 16 + 4 * g, n0, lane); }
__device__ __forceinline__ bf16x8 pack_acc(const float* l0, const float* l1) { v4u w; w.x = pk2(l0[0], l0[1]); w.y = pk2(l0[2], l0[3]); w.z = pk2(l1[0], l1[1]); w.w = pk2(l1[2], l1[3]); return __builtin_bit_cast(bf16x8, w); }
}

template <bool SSD> __device__ __forceinline__ void kv_local_item(Frame& F, int item) {
    bf16* As = (bf16*)F.lds;
    bf16* Bs = As + 128 * 72;
    float* wj = (float*)(Bs + 128 * 144);
    float* cum = wj + 128;
    const int tid = F.tid; int b, c, h; float* S;
    if (SSD) { h = item & 7; c = (item >> 3) & 31; b = item >> 8; S = WSP(float, WS_SLS) + (size_t)((b * 32 + c) * 8 + h) * 8192; }
    else { c = item & 31; h = (item >> 5) & 3; b = item >> 7; S = WSP(float, WS_SLR) + (size_t)((b * 4 + h) * 32 + c) * 8192; }
    const int r0 = b * SEQ + c * 128;
    const bf16* srcA = SSD ? WSP(bf16, WS_XC) + (size_t)r0 * 1024 + h * 64 : WSP(bf16, WS_Z) + (size_t)r0 * NE + ZKB + h * 64;
    const bf16* srcB = SSD ? WSP(bf16, WS_XC) + (size_t)r0 * 1024 + 512 + (h >> 2) * 128 : WSP(bf16, WS_Z) + (size_t)r0 * NE + ZVB + h * 128;
    const int pitch = SSD ? 1024 : NE;
    v4u ra[2], rb[4];
#pragma unroll
    for (int k = 0; k < 2; ++k) { const int e = tid + NTHR * k; ra[k] = *(const v4u*)(srcA + (size_t)(e >> 3) * pitch + (e & 7) * 8); }
#pragma unroll
    for (int k = 0; k < 4; ++k) { const int e = tid + NTHR * k; rb[k] = *(const v4u*)(srcB + (size_t)(e >> 4) * pitch + (e & 15) * 8); }
    float dthv = 0.f, Aneg = 0.f;
    if (SSD) { if (tid < 128) dthv = WSP(float, WS_DTH)[(size_t)(r0 + tid) * 8 + h]; Aneg = -__expf(INP(27)[h]); }
    __syncthreads();
    if (SSD) { float* dts = cum + 128;
        if (tid < 128) dts[tid] = dthv;
        __syncthreads();
        if (tid < 64) { const float a0 = dts[2 * tid] * Aneg, a1 = dts[2 * tid + 1] * Aneg; float s = a0 + a1;
#pragma unroll
            for (int o = 1; o < 64; o <<= 1) { const float t = __shfl_up(s, o); if (F.lane >= o) s += t; }
            cum[2 * tid] = s - a1; cum[2 * tid + 1] = s; }
        __syncthreads();
        if (tid < 128) { const float cj = cum[tid], cl = cum[127]; WSP(float, WS_CUM)[(size_t)(r0 + tid) * 8 + h] = cj; wj[tid] = __expf(cl - cj) * dthv;
            if (tid == 0) WSP(float, WS_CDEC)[(b * 32 + c) * 8 + h] = __expf(cl); }
    } else { if (tid < 128) wj[tid] = exp2f((float)(127 - tid) * ret_log2g(h)); }
    __syncthreads();
#pragma unroll
    for (int k = 0; k < 2; ++k) { const int e = tid + NTHR * k, j = e >> 3, cc = (e & 7) * 8; float f[8]; unpack8(ra[k], f); const float w = wj[j];
#pragma unroll
        for (int q = 0; q < 8; ++q) f[q] *= w;
        *(v4u*)(As + j * 72 + cc) = pack8(f); }
#pragma unroll
    for (int k = 0; k < 4; ++k) { const int e = tid + NTHR * k; *(v4u*)(Bs + (e >> 4) * 144 + (e & 15) * 8) = rb[k]; }
    __syncthreads();
    const int lane = F.lane, dt = F.wave & 3, et0 = (F.wave >> 2) * 4;
    f32x4 acc[4];
#pragma unroll
    for (int q = 0; q < 4; ++q) acc[q] = (f32x4){0.f, 0.f, 0.f, 0.f};
#pragma unroll
    for (int ks = 0; ks < 4; ++ks) { const mm::bf16x8 af = mm::frag_tr_std(As, 72, 32 * ks, 16 * dt, lane);
#pragma unroll
        for (int q = 0; q < 4; ++q) acc[q] = mm::mfma16(af, mm::frag_tr_std(Bs, 144, 32 * ks, 16 * (et0 + q), lane), acc[q]); }
    const int gq = lane >> 4, cl = lane & 15;
#pragma unroll
    for (int q = 0; q < 4; ++q)
#pragma unroll
        for (int r = 0; r < 4; ++r) S[(16 * dt + 4 * gq + r) * 128 + 16 * (et0 + q) + cl] = acc[q][r];
}
__device__ __forceinline__ void ret_out_mfma(Frame& F, int item) {
    const int c = item & 31, h = (item >> 5) & 3, b = item >> 7; const bf16* Z = WSP(bf16, WS_Z); bf16* MIX = WSP(bf16, WS_MIX);
    bf16* Qs = (bf16*)F.lds;
    bf16* Ks = Qs + 128 * 72;
    bf16* Vs = Ks + 128 * 72;
    bf16* Ps = Vs + 128 * 144;
    const int tid = F.tid, r0 = b * SEQ + c * 128; const float lg = ret_log2g(h);
    __syncthreads();
    for (int e = tid; e < 128 * 8; e += NTHR) { const int j = e >> 3, cc = (e & 7) * 8; const size_t zo = (size_t)(r0 + j) * NE + h * 64 + cc;
        *(v4u*)(Qs + j * 72 + cc) = *(const v4u*)(Z + zo + ZQB); *(v4u*)(Ks + j * 72 + cc) = *(const v4u*)(Z + zo + ZKB); }
    for (int e = tid; e < 128 * 16; e += NTHR) { const int j = e >> 4, cc = (e & 15) * 8; *(v4u*)(Vs + j * 144 + cc) = *(const v4u*)(Z + (size_t)(r0 + j) * NE + ZVB + h * 128 + cc); }
    { const bf16* Pp = WSP(bf16, WS_PBR) + (size_t)((b * 4 + h) * 32 + c) * 8192;
      for (int e = tid; e < 64 * 16; e += NTHR) { const int d = e >> 4, cc = (e & 15) * 8; *(v4u*)(Ps + d * 144 + cc) = *(const v4u*)(Pp + d * 128 + cc); } }
    __syncthreads();
    v4u gbr[4];
#pragma unroll
    for (int k = 0; k < 4; ++k) { const int e = tid + NTHR * k; gbr[k] = *(const v4u*)(Z + (size_t)(r0 + (e >> 4)) * NE + ZGB + h * 128 + (e & 15) * 8); }
    const int w = F.wave, lane = F.lane, gq = lane >> 4, cl = lane & 15;
    f32x4 sT[8];
#pragma unroll
    for (int a = 0; a < 8; ++a) { sT[a] = (f32x4){0.f, 0.f, 0.f, 0.f};
        if (a <= w) {
#pragma unroll
            for (int ks = 0; ks < 2; ++ks) sT[a] = mm::mfma16(mm::frag_kc(Ks, 72, 16 * a, 32 * ks, lane), mm::frag_kc(Qs, 72, 16 * w, 32 * ks, lane), sT[a]); } }
    f32x4 ain[8], aix[8];
#pragma unroll
    for (int et = 0; et < 8; ++et) { ain[et] = (f32x4){0.f, 0.f, 0.f, 0.f}; aix[et] = (f32x4){0.f, 0.f, 0.f, 0.f}; }
#pragma unroll
    for (int ks = 0; ks < 2; ++ks) { const mm::bf16x8 af = mm::frag_kc(Qs, 72, 16 * w, 32 * ks, lane);
#pragma unroll
        for (int et = 0; et < 8; ++et) ain[et] = mm::mfma16(af, mm::frag_tr_std(Ps, 144, 32 * ks, 16 * et, lane), ain[et]); }
    const int ii = 16 * w + cl;
#pragma unroll
    for (int m = 0; m < 4; ++m) { if (2 * m <= w) { float l0[4], l1[4];
#pragma unroll
            for (int r = 0; r < 4; ++r) { const int j0 = 32 * m + 4 * gq + r, j1 = j0 + 16;
                l0[r] = (j0 <= ii) ? sT[2 * m][r] * exp2f((float)(ii - j0) * lg) : 0.f; l1[r] = (j1 <= ii) ? sT[2 * m + 1][r] * exp2f((float)(ii - j1) * lg) : 0.f; }
            const mm::bf16x8 af = mm::pack_acc(l0, l1);
#pragma unroll
            for (int et = 0; et < 8; ++et) aix[et] = mm::mfma16(af, mm::frag_tr_acc(Vs, 144, 32 * m, 16 * et, lane), aix[et]); } }
    float ssq[4], qd[4];
#pragma unroll
    for (int r = 0; r < 4; ++r) { ssq[r] = 0.f; qd[r] = exp2f((float)(16 * w + 4 * gq + r + 1) * lg); }
#pragma unroll
    for (int et = 0; et < 8; ++et)
#pragma unroll
        for (int r = 0; r < 4; ++r) { const float o = aix[et][r] + qd[r] * ain[et][r]; aix[et][r] = o; ssq[r] += o * o; }
#pragma unroll
    for (int r = 0; r < 4; ++r) { float s = ssq[r]; s += __shfl_xor(s, 1); s += __shfl_xor(s, 2); s += __shfl_xor(s, 4); s += __shfl_xor(s, 8); ssq[r] = rsqrtf(s * (1.f / 128.f) + EPS); }
    __syncthreads();
    bf16* Ot = Vs;
#pragma unroll
    for (int et = 0; et < 8; ++et)
#pragma unroll
        for (int r = 0; r < 4; ++r) Ot[(16 * w + 4 * gq + r) * 144 + 16 * et + cl] = (bf16)f2bf(aix[et][r] * ssq[r]);
    __syncthreads();
#pragma unroll
    for (int k = 0; k < 4; ++k) { const int e = tid + NTHR * k, i = e >> 4, cc = (e & 15) * 8; float o[8], g8[8];
        unpack8(*(const v4u*)(Ot + i * 144 + cc), o); unpack8(gbr[k], g8);
#pragma unroll
        for (int k = 0; k < 8; ++k) o[k] *= g8[k];
        *(v4u*)(MIX + (size_t)(r0 + i) * DM + 512 + h * 128 + cc) = pack8(o); }
}
__device__ __forceinline__ void sgu_mfma(Frame& F, int item) {
    const int g = item & 3, c = (item >> 2) & 31, b = item >> 7; const bf16* Z = WSP(bf16, WS_Z); bf16* MIX = WSP(bf16, WS_MIX);
    bf16* Ws = (bf16*)F.lds;
    bf16* Vs = Ws + 128 * 136;
    const int tid = F.tid, r0 = b * SEQ + c * 128; const float* W = INP(22) + (size_t)g * 16384; const float* sgb = INP(23);
    __syncthreads();
    for (int e = tid; e < 128 * 16; e += NTHR) { const int i = e >> 4, cc = (e & 15) * 8; const f32x4 a = *(const f32x4*)(W + i * 128 + cc), bb = *(const f32x4*)(W + i * 128 + cc + 4);
        float f[8] = {a.x, a.y, a.z, a.w, bb.x, bb.y, bb.z, bb.w};
#pragma unroll
        for (int k = 0; k < 8; ++k) if (cc + k > i) f[k] = 0.f;
        *(v4u*)(Ws + i * 136 + cc) = pack8(f);
        *(v4u*)(Vs + i * 144 + cc) = *(const v4u*)(Z + (size_t)(r0 + i) * NOP + YV + g * 128 + cc); }
    __syncthreads();
    v4u ur[4], gr[4];
#pragma unroll
    for (int k = 0; k < 4; ++k) { const int e = tid + NTHR * k; const size_t zo = (size_t)(r0 + (e >> 4)) * NOP + g * 128 + (e & 15) * 8; ur[k] = *(const v4u*)(Z + zo + YU); gr[k] = *(const v4u*)(Z + zo + YGC); }
    const int w = F.wave, lane = F.lane, gq = lane >> 4, cl = lane & 15;
    float sbv[4];
#pragma unroll
    for (int r = 0; r < 4; ++r) sbv[r] = sgb[g * 128 + 16 * w + 4 * gq + r];
    f32x4 acc[8];
#pragma unroll
    for (int dt = 0; dt < 8; ++dt) acc[dt] = (f32x4){0.f, 0.f, 0.f, 0.f};
#pragma unroll
    for (int ks = 0; ks < 4; ++ks) { if (ks <= (w >> 1)) { const mm::bf16x8 af = mm::frag_kc(Ws, 136, 16 * w, 32 * ks, lane);
#pragma unroll
            for (int dt = 0; dt < 8; ++dt) acc[dt] = mm::mfma16(af, mm::frag_tr_std(Vs, 144, 32 * ks, 16 * dt, lane), acc[dt]); } }
    __syncthreads();
    bf16* St = Ws;
#pragma unroll
    for (int r = 0; r < 4; ++r) { const int i = 16 * w + 4 * gq + r; const float sb = sbv[r];
#pragma unroll
        for (int dt = 0; dt < 8; ++dt) St[i * 136 + 16 * dt + cl] = (bf16)f2bf(acc[dt][r] + sb); }
    __syncthreads();
#pragma unroll
    for (int k = 0; k < 4; ++k) { const int e = tid + NTHR * k, i = e >> 4, cc = (e & 15) * 8; float s8[8], u8[8], g8[8];
        unpack8(*(const v4u*)(St + i * 136 + cc), s8); unpack8(ur[k], u8); unpack8(gr[k], g8);
#pragma unroll
        for (int k = 0; k < 8; ++k) s8[k] = gelu_f(u8[k]) * s8[k] * silu_f(g8[k]);
        *(v4u*)(MIX + (size_t)(r0 + i) * DM + g * 128 + cc) = pack8(s8); }
}
__device__ __forceinline__ void ssd_out_mfma(Frame& F, int item) {
    const int g = item & 1, c = (item >> 1) & 31, b = item >> 6; const bf16* Z = WSP(bf16, WS_Z); const bf16* XC = WSP(bf16, WS_XC); bf16* MIX = WSP(bf16, WS_MIX);
    bf16* Xs = (bf16*)F.lds;
    bf16* Cs = Xs + 128 * 272;
    bf16* Bs = Cs + 128 * 144;
    float* cums = (float*)(Bs + 128 * 144);
    float* dths = cums + 512;
    const int tid = F.tid, r0 = b * SEQ + c * 128; const float* Dp = INP(28); const float* nw = INP(29);
    const f32x4 n0 = *(const f32x4*)(nw + g * 256 + (tid & 31) * 8), n1 = *(const f32x4*)(nw + g * 256 + (tid & 31) * 8 + 4);
    __syncthreads();
    for (int e = tid; e < 128 * 32; e += NTHR) { const int j = e >> 5, cc = (e & 31) * 8; *(v4u*)(Xs + j * 272 + cc) = *(const v4u*)(XC + (size_t)(r0 + j) * 1024 + g * 256 + cc); }
    for (int e = tid; e < 128 * 16; e += NTHR) { const int j = e >> 4, cc = (e & 15) * 8; *(v4u*)(Bs + j * 144 + cc) = *(const v4u*)(XC + (size_t)(r0 + j) * 1024 + 512 + g * 128 + cc);
        *(v4u*)(Cs + j * 144 + cc) = *(const v4u*)(XC + (size_t)(r0 + j) * 1024 + 768 + g * 128 + cc); }
    { const int hq = tid >> 7, j = tid & 127; cums[tid] = WSP(float, WS_CUM)[(size_t)(r0 + j) * 8 + g * 4 + hq]; dths[tid] = WSP(float, WS_DTH)[(size_t)(r0 + j) * 8 + g * 4 + hq]; }
    v4u pra[2];
    { const bf16* Pn = WSP(bf16, WS_PBS) + (size_t)((b * 32 + c) * 8 + g * 4) * 8192;
#pragma unroll
      for (int k = 0; k < 2; ++k) { const int e = tid + NTHR * k, p = e >> 4, cc = (e & 15) * 8; pra[k] = *(const v4u*)(Pn + p * 128 + cc); } }
    __syncthreads();
    const int w = F.wave, lane = F.lane, gq = lane >> 4, cl = lane & 15;
    f32x4 cb[8];
#pragma unroll
    for (int a = 0; a < 8; ++a) { cb[a] = (f32x4){0.f, 0.f, 0.f, 0.f};
        if (a <= w) {
#pragma unroll
            for (int ks = 0; ks < 4; ++ks) cb[a] = mm::mfma16(mm::frag_kc(Bs, 144, 16 * a, 32 * ks, lane), mm::frag_kc(Cs, 144, 16 * w, 32 * ks, lane), cb[a]); } }
    __syncthreads();
    bf16* Ps = Bs;
    float* ssqs = dths + 512;
    if (tid < 128) ssqs[tid] = 0.f;
    const int ii = 16 * w + cl;
#pragma unroll 1
    for (int hq = 0; hq < 4; ++hq) { const int h = g * 4 + hq;
#pragma unroll
        for (int k = 0; k < 2; ++k) { const int e = tid + NTHR * k, p = e >> 4, cc = (e & 15) * 8; *(v4u*)(Ps + p * 144 + cc) = pra[k]; }
        __syncthreads();
        if (hq < 3) { const bf16* Pn = WSP(bf16, WS_PBS) + (size_t)((b * 32 + c) * 8 + h + 1) * 8192;
#pragma unroll
            for (int k = 0; k < 2; ++k) { const int e = tid + NTHR * k, p = e >> 4, cc = (e & 15) * 8; pra[k] = *(const v4u*)(Pn + p * 128 + cc); } }
        v4u zgr[2];
#pragma unroll
        for (int k = 0; k < 2; ++k) { const int e = tid + NTHR * k, i = e >> 3, cc = (e & 7) * 8; zgr[k] = *(const v4u*)(Z + (size_t)(r0 + i) * NOP + YZG + h * 64 + cc); }
        f32x4 ain[4], aix[4];
#pragma unroll
        for (int pt = 0; pt < 4; ++pt) { ain[pt] = (f32x4){0.f, 0.f, 0.f, 0.f}; aix[pt] = (f32x4){0.f, 0.f, 0.f, 0.f}; }
#pragma unroll
        for (int ks = 0; ks < 4; ++ks) { const mm::bf16x8 af = mm::frag_kc(Cs, 144, 16 * w, 32 * ks, lane);
#pragma unroll
            for (int pt = 0; pt < 4; ++pt) ain[pt] = mm::mfma16(af, mm::frag_kc(Ps, 144, 16 * pt, 32 * ks, lane), ain[pt]); }
        const float ci = cums[hq * 128 + ii];
#pragma unroll
        for (int m = 0; m < 4; ++m) { if (2 * m <= w) { float l0[4], l1[4];
#pragma unroll
                for (int r = 0; r < 4; ++r) { const int j0 = 32 * m + 4 * gq + r, j1 = j0 + 16;
                    l0[r] = (j0 <= ii) ? cb[2 * m][r] * __expf(ci - cums[hq * 128 + j0]) * dths[hq * 128 + j0] : 0.f;
                    l1[r] = (j1 <= ii) ? cb[2 * m + 1][r] * __expf(ci - cums[hq * 128 + j1]) * dths[hq * 128 + j1] : 0.f; }
                const mm::bf16x8 af = mm::pack_acc(l0, l1);
#pragma unroll
                for (int pt = 0; pt < 4; ++pt) aix[pt] = mm::mfma16(af, mm::frag_tr_acc(Xs, 272, 32 * m, hq * 64 + 16 * pt, lane), aix[pt]); } }
        const float Dh = Dp[h];
        bf16* Yt = Bs + 64 * 144;
#pragma unroll
        for (int r = 0; r < 4; ++r) { const int i = 16 * w + 4 * gq + r; const float ei = __expf(cums[hq * 128 + i]);
#pragma unroll
            for (int pt = 0; pt < 4; ++pt) Yt[i * 72 + 16 * pt + cl] = (bf16)f2bf(aix[pt][r] + ei * ain[pt][r]); }
        __syncthreads();
#pragma unroll
        for (int k = 0; k < 2; ++k) { const int e = tid + NTHR * k, i = e >> 3, cc = (e & 7) * 8; float y8[8], x8[8], z8[8];
            unpack8(*(const v4u*)(Yt + i * 72 + cc), y8); unpack8(*(const v4u*)(Xs + i * 272 + hq * 64 + cc), x8); unpack8(zgr[k], z8);
            float s = 0.f;
#pragma unroll
            for (int k = 0; k < 8; ++k) { y8[k] = (y8[k] + Dh * x8[k]) * silu_f(z8[k]); s += y8[k] * y8[k]; }
            s = red8_dpp(s); if ((e & 7) == 0) ssqs[i] += s;
            *(v4u*)(Xs + i * 272 + hq * 64 + cc) = pack8(y8); }
        __syncthreads();
    }
    for (int e = tid; e < 128 * 32; e += NTHR) { const int i = e >> 5, cc = (e & 31) * 8; const float rstd = rsqrtf(ssqs[i] * (1.f / 256.f) + EPS); float v8[8]; unpack8(*(const v4u*)(Xs + i * 272 + cc), v8);
        v8[0] *= rstd * n0.x; v8[1] *= rstd * n0.y; v8[2] *= rstd * n0.z; v8[3] *= rstd * n0.w; v8[4] *= rstd * n1.x; v8[5] *= rstd * n1.y; v8[6] *= rstd * n1.z; v8[7] *= rstd * n1.w;
        *(v4u*)(MIX + (size_t)(r0 + i) * DM + 512 + g * 256 + cc) = pack8(v8); }
}
__device__ __forceinline__ void mod_item_mfma(Frame& F, int item) {
    const int l = item / 48, nb = item % 48;
    const float* We = INP(12); const float* Wo = INP(19); const float* be = INP(13); const float* bo = INP(20); const float* cpp = INP(8); const float* csp = INP(9);
    const float* W = (l ? Wo : We) + nb * 64; const float* bias = (l ? bo : be) + nb * 64; float* mod = WSP(float, l ? WS_MODO : WS_MODE) + nb * 64;
    bf16* As = (bf16*)F.lds;
    bf16* Ws = As + 144 * 136;
    const int tid = F.tid, lane = F.lane, w = F.wave, nt = w & 3, m0 = w >> 2, gq = lane >> 4, cl = lane & 15;
    f32x4 acc[5];
#pragma unroll
    for (int q = 0; q < 5; ++q) acc[q] = (f32x4){0.f, 0.f, 0.f, 0.f};
    f32x4 ca[5], cbv[5], wa[2], wb[2];
#define MOD_LOAD(k0) do { _Pragma("unroll") for (int k = 0; k < 5; ++k) { const int e = tid + NTHR * k, m = e >> 4, cc = (e & 15) * 8; ca[k] = (f32x4){0.f, 0.f, 0.f, 0.f}; cbv[k] = ca[k]; \
            if (e < 144 * 16 && m < 132) { const float* cr = (m < 4) ? cpp + (size_t)m * DM : csp + (size_t)(m - 4) * DM; ca[k] = *(const f32x4*)(cr + (k0) + cc); cbv[k] = *(const f32x4*)(cr + (k0) + cc + 4); } } \
        _Pragma("unroll") for (int k = 0; k < 2; ++k) { const int e = tid + NTHR * k, kk = e >> 3, cc = (e & 7) * 8; wa[k] = *(const f32x4*)(W + (size_t)((k0) + kk) * 3072 + cc); wb[k] = *(const f32x4*)(W + (size_t)((k0) + kk) * 3072 + cc + 4); } } while (0)
    MOD_LOAD(0);
    for (int k0 = 0; k0 < DM; k0 += 128) {
        __syncthreads();
#pragma unroll
        for (int k = 0; k < 5; ++k) { const int e = tid + NTHR * k, m = e >> 4, cc = (e & 15) * 8;
            if (e < 144 * 16) { float f[8] = {silu_f(ca[k].x), silu_f(ca[k].y), silu_f(ca[k].z), silu_f(ca[k].w), silu_f(cbv[k].x), silu_f(cbv[k].y), silu_f(cbv[k].z), silu_f(cbv[k].w)};
                *(v4u*)(As + m * 136 + cc) = pack8(f); } }
#pragma unroll
        for (int k = 0; k < 2; ++k) { const int e = tid + NTHR * k, kk = e >> 3, cc = (e & 7) * 8; v4u wv; wv.x = pk2(wa[k].x, wa[k].y); wv.y = pk2(wa[k].z, wa[k].w); wv.z = pk2(wb[k].x, wb[k].y); wv.w = pk2(wb[k].z, wb[k].w);
            *(v4u*)(Ws + kk * 72 + cc) = wv; }
        __syncthreads();
        if (k0 + 128 < DM) MOD_LOAD(k0 + 128);
#pragma unroll
        for (int ks = 0; ks < 4; ++ks) { const mm::bf16x8 bfr = mm::frag_tr_std(Ws, 72, 32 * ks, 16 * nt, lane);
#pragma unroll
            for (int q = 0; q < 5; ++q) { const int mt = m0 + 2 * q; if (mt < 9) acc[q] = mm::mfma16(mm::frag_kc(As, 136, 16 * mt, 32 * ks, lane), bfr, acc[q]); } }
    }
#undef MOD_LOAD
    const float bn = bias[16 * nt + cl];
#pragma unroll
    for (int q = 0; q < 5; ++q) { const int mt = m0 + 2 * q;
#pragma unroll
        for (int r = 0; r < 4; ++r) { const int m = 16 * mt + 4 * gq + r; if (mt < 9 && m < 132) mod[(size_t)m * 3072 + 16 * nt + cl] = acc[q][r] + bn; } }
    __syncthreads();
}

template <bool XB16, bool OB16> __device__ __forceinline__ void smp_outproj_item(Frame& F, int item, const bf16* Wt, const void* xsrc, const float* mod, void* out) {
    const int rt = item >> 4, ct = item & 15, row0 = TP + rt * 32, col0 = ct * 64; const bf16* MIX = WSP(bf16, WS_MIX);
    bf16* As = (bf16*)F.lds;
    bf16* Bs = As + 32 * 264;
    const int tid = F.tid, lane = F.lane, w = F.wave, mt = w >> 2, nt = w & 3, gq = lane >> 4, cl = lane & 15;
    f32x4 acc = (f32x4){0.f, 0.f, 0.f, 0.f};
    v4u pa[2], pb[4];
#define SO_LOAD(k0) do { _Pragma("unroll") for (int k = 0; k < 2; ++k) { const int e = tid + NTHR * k; pa[k] = *(const v4u*)(MIX + (size_t)(row0 + (e >> 5)) * DM + (k0) + (e & 31) * 8); } \
        _Pragma("unroll") for (int k = 0; k < 4; ++k) { const int e = tid + NTHR * k; pb[k] = *(const v4u*)(Wt + (size_t)(col0 + (e >> 5)) * DM + (k0) + (e & 31) * 8); } } while (0)
    SO_LOAD(0);
    float xv4[4], gm4[4];
#pragma unroll
    for (int r = 0; r < 4; ++r) { const int rr = row0 + 16 * mt + 4 * gq + r, cc = col0 + 16 * nt + cl; const size_t o = (size_t)(rr - TP) * DM + cc;
        xv4[r] = XB16 ? bf2f(((const bf16*)xsrc)[o]) : ((const float*)xsrc)[o]; gm4[r] = mod[(size_t)mod_row(rr) * 3072 + 2048 + cc]; }
    for (int k0 = 0; k0 < DM; k0 += 256) {
        __syncthreads();
#pragma unroll
        for (int k = 0; k < 2; ++k) { const int e = tid + NTHR * k; *(v4u*)(As + (e >> 5) * 264 + (e & 31) * 8) = pa[k]; }
#pragma unroll
        for (int k = 0; k < 4; ++k) { const int e = tid + NTHR * k; *(v4u*)(Bs + (e >> 5) * 264 + (e & 31) * 8) = pb[k]; }
        __syncthreads();
        if (k0 + 256 < DM) SO_LOAD(k0 + 256);
#pragma unroll
        for (int ks = 0; ks < 8; ++ks) acc = mm::mfma16(mm::frag_kc(As, 264, 16 * mt, 32 * ks, lane), mm::frag_kc(Bs, 264, 16 * nt, 32 * ks, lane), acc);
    }
#undef SO_LOAD
#pragma unroll
    for (int r = 0; r < 4; ++r) { const int rr = row0 + 16 * mt + 4 * gq + r, cc = col0 + 16 * nt + cl; const size_t o = (size_t)(rr - TP) * DM + cc;
        const float ov = xv4[r] + gm4[r] * acc[r];
        if (OB16) ((bf16*)out)[o] = (bf16)f2bf(ov); else ((float*)out)[o] = ov; }
    __syncthreads();
}
constexpr int NPHASE = 14;
struct Args { const float* in[31]; float* out; unsigned char* ws; int ph_lo, ph_hi; };
__global__ void __launch_bounds__(NTHR, 2) fwd_kernel(Args args) {
    extern __shared__ __attribute__((aligned(16))) unsigned char lds[];
    Frame F;
    F.lds = lds; F.tid = threadIdx.x; F.lane = F.tid & 63; F.wave = __builtin_amdgcn_readfirstlane(F.tid >> 6); F.G = gridDim.x;
    F.out = args.out; F.ws = args.ws;
    volatile LAS unsigned* MISC = (volatile LAS unsigned*)((LAS unsigned char*)lds + MISC_OFF);
    if (F.tid < 64) MISC[F.tid] = 0u;
    __syncthreads();
    const int lo = args.ph_lo, hi = args.ph_hi;
    XcdBarrier bar; bar.bar = (unsigned*)(F.ws + WS_CTL) + CW_BAR; bar.x = 0; bar.st = MISC + 8;
    if (hi - lo > 1) bar = xcd_barrier_post((unsigned*)(F.ws + WS_CTL) + CW_BAR, MISC + 8);
#ifndef DBL
#define DBL 0
#endif
#ifndef PH_MASK
#define PH_MASK 0xffff
#endif
#define IN(k) (((PH_MASK >> (k)) & 1) && lo <= (k) && (k) < hi)
#define SEAM(k) do { if (IN(k) && IN((k) + 1)) xcd_barrier(bar); } while (0)
#define REFRESH() do { int tz_ = threadIdx.x; asm volatile("" : "+v"(tz_)); F.tid = tz_; F.lane = tz_ & 63; } while (0)
    LAS unsigned char* ldsl = (LAS unsigned char*)lds;
    const int bx = blockIdx.x, G = F.G;
    const int vx = (G % 8 == 0) ? (bx % 8) * (G / 8) + bx / 8 : bx;

    if (IN(0)) { REFRESH(); for (int it = G - 1 - bx; it < 96; it += G) mod_item_mfma(F, it);
        rope_phase(F); weights_phase(F, G > 96 ? G - 96 : G); } SEAM(0);
    if (IN(1)) { REFRESH(); normmod_phase<false>(F, INP(0), INP(1), INP(11), WSP(float, WS_MODE)); } SEAM(1);
    if (IN(2)) { REFRESH(); pg8::Gemm g{WSP(bf16, WS_H), WSP(bf16, WS_WINE), MR, NE, DM}; pg8::StaticOrder S; S.init(MR, NE, G, bx);
        EpiL0 E{WSP(bf16, WS_Z), F.out, INP(15), INP(16), WSP(f32x2, WS_ROPE), WSP(float, WS_KMEAN), (float*)(lds + XCH_OFF)}; pg8::gemm_phase<EpiL0, pg8::StaticOrder, true, true>(ldsl, g, S, E); } SEAM(2);
    if (IN(3)) { REFRESH();
        const bool attn_first = (vx & 1) == 0;
        if (!attn_first) { for (int it = bx; it < 1536; it += G) { if (it < 512) kv_local_item<false>(F, it); else smp_pass1_item(F, it - 512); } __syncthreads(); }
        { typedef attn_body::bf16 abf; const abf* Zb = (const abf*)WSP(bf16, WS_Z); abf* MX = (abf*)WSP(bf16, WS_MIX); const float* kpart = WSP(float, WS_KPART); const float* relb = INP(10);
          for (int pi = vx; pi < 256; pi += G) { const int bh = pi >> 3, s = pi & 7;
              attn_body::attn_unit<8>(bh >> 3, bh & 7, 15 - s, Zb + ZQA, Zb + ZKA, Zb + ZVA, Zb + ZGA, MX, kpart, relb, (char*)lds, true);
              attn_body::attn_unit<8>(bh >> 3, bh & 7, s, Zb + ZQA, Zb + ZKA, Zb + ZVA, Zb + ZGA, MX, kpart, relb, (char*)lds, false); } }
        if (attn_first) { for (int it = bx; it < 1536; it += G) { if (it < 512) kv_local_item<false>(F, it); else smp_pass1_item(F, it - 512); } }
    } SEAM(3);
    if (IN(4)) { REFRESH(); ret_scan_phase(F); for (int it = bx; it < 1024; it += G) smp_pass2_item(F, it); } SEAM(4);
    if (IN(5)) { REFRESH(); for (int rep_ = 0; rep_ <= ((DBL >> 0) & 1); ++rep_) for (int it = bx; it < 1024; it += G) { if (it < 512) ret_out_mfma(F, it); else smp_ret_item(F, it - 512); } } SEAM(5);
    if (IN(6)) { REFRESH(); pg8::Gemm g{WSP(bf16, WS_MIX), WSP(bf16, WS_WOUTE), TP, DM, DM}; pg8::StaticOrder S; S.init(TP, DM, G, bx);
        EpiRes<false, true> E{INP(0), INP(1), WSP(float, WS_MODE), WSP(bf16, WS_X1)}; pg8::gemm_phase<EpiRes<false, true>, pg8::StaticOrder, true, true>(ldsl, g, S, E);
        for (int it = bx; it < 256; it += G) smp_outproj_item<false, true>(F, it, WSP(bf16, WS_WOUTE), INP(1), WSP(float, WS_MODE), WSP(bf16, WS_X1) + (size_t)TP * DM); } SEAM(6);
    if (IN(7)) { REFRESH(); normmod_phase<true>(F, WSP(bf16, WS_X1), WSP(bf16, WS_X1) + (size_t)TP * DM, INP(18), WSP(float, WS_MODO)); } SEAM(7);
    if (IN(8)) { REFRESH(); pg8::Gemm g{WSP(bf16, WS_H), WSP(bf16, WS_WINO), MR, NOP, DM}; pg8::StaticOrder S; S.init(MR, NOP, G, bx);
        EpiZ E{WSP(bf16, WS_Z), NOP, WSP(float, WS_DTRAW)}; pg8::gemm_phase<EpiZ, pg8::StaticOrder, true, true>(ldsl, g, S, E); } SEAM(8);
    if (IN(9)) { REFRESH(); post1_phase(F); } SEAM(9);
    if (IN(10)) { REFRESH(); for (int rep_ = 0; rep_ <= ((DBL >> 1) & 1); ++rep_) for (int it = vx; it < 1536; it += G) { if (it < 1024) kv_local_item<true>(F, it); else sgu_mfma(F, it - 1024); } } SEAM(10);
    if (IN(11)) { REFRESH(); ssd_scan_phase(F); for (int rep_ = 0; rep_ <= ((DBL >> 2) & 1); ++rep_) for (int it = bx; it < 256; it += G) smp_l1_item(F, it); } SEAM(11);
    if (IN(12)) { REFRESH(); for (int rep_ = 0; rep_ <= ((DBL >> 3) & 1); ++rep_) for (int it = vx; it < 256; it += G) ssd_out_mfma(F, it); } SEAM(12);
    if (IN(13)) { REFRESH(); pg8::Gemm g{WSP(bf16, WS_MIX), WSP(bf16, WS_WOUTO), TP, DM, DM}; pg8::StaticOrder S; S.init(TP, DM, G, bx);
        EpiRes<true, false> E{WSP(bf16, WS_X1), WSP(bf16, WS_X1) + (size_t)TP * DM, WSP(float, WS_MODO), F.out + O_YP}; pg8::gemm_phase<EpiRes<true, false>, pg8::StaticOrder, true, true>(ldsl, g, S, E);
        for (int it = bx; it < 256; it += G) smp_outproj_item<true, false>(F, it, WSP(bf16, WS_WOUTO), WSP(bf16, WS_X1) + (size_t)TP * DM, WSP(float, WS_MODO), F.out + O_YS); }
#undef IN
#undef SEAM
}

#ifndef N_LAUNCH_MODE
#define N_LAUNCH_MODE 1
#endif
extern "C" void kernel_launch(void* const* d_in, const int* in_sizes, int n_in, void* d_out, int out_size, void* d_ws, size_t ws_size, hipStream_t stream) {
    static int grid = 0;
    if (grid == 0) {
        if (n_in != 31 || out_size != (int)O_END || ws_size < WS_END) { fprintf(stderr, "kernel_launch: unexpected problem shape (n_in %d, out %d, ws %zu)\n", n_in, out_size, ws_size); grid = -1; return; }
        int dev = 0, cus = 0, per_cu = 0;
        if (hipGetDevice(&dev) != hipSuccess || hipDeviceGetAttribute(&cus, hipDeviceAttributeMultiprocessorCount, dev) != hipSuccess) { grid = -1; return; }
        if (hipFuncSetAttribute((const void*)fwd_kernel, hipFuncAttributeMaxDynamicSharedMemorySize, LDS_BYTES) != hipSuccess) { fprintf(stderr, "kernel_launch: hipFuncSetAttribute failed\n"); grid = -1; return; }
        if (hipOccupancyMaxActiveBlocksPerMultiprocessor(&per_cu, (const void*)fwd_kernel, NTHR, LDS_BYTES) != hipSuccess || per_cu < 1) fprintf(stderr, "kernel_launch: occupancy query reports %d\n", per_cu);
        (void)hipGetLastError();
        grid = cus;
    }
    if (grid < 0) return;
    (void)hipMemsetAsync((char*)d_ws + WS_CTL, 0, CTL_ZERO_BYTES, stream);
    Args a{};
    for (int i = 0; i < 31; ++i) a.in[i] = (const float*)d_in[i];
    a.out = (float*)d_out; a.ws = (unsigned char*)d_ws;
#if N_LAUNCH_MODE == 1
    a.ph_lo = 0; a.ph_hi = NPHASE;
    hipLaunchKernelGGL(fwd_kernel, dim3(grid), dim3(NTHR), LDS_BYTES, stream, a);
#else
    for (int k = 0; k < NPHASE; ++k) { a.ph_lo = k; a.ph_hi = k + 1; hipLaunchKernelGGL(fwd_kernel, dim3(grid), dim3(NTHR), LDS_BYTES, stream, a); }
#endif
}
```

```cpp
#include <hip/hip_runtime.h>
#include <cstdio>
#include <cstdint>
#include <hip/hip_bf16.h>
#include <cmath>
namespace pg8 {
#define PG8_LAS __attribute__((address_space(3)))
typedef unsigned short bf16_t;
typedef short bf16x8 __attribute__((ext_vector_type(8)));
typedef float f32x4 __attribute__((ext_vector_type(4)));
typedef unsigned u32x4 __attribute__((ext_vector_type(4)));
constexpr int BM = 256, BK = 64, HALF = 128, HTB = HALF * BK * 2  , STAGE_BYTES = 8 * HTB, NXCD = 8, WGM = 8;

__host__ __device__ __forceinline__ int lds_byte(int r, int c) { const int st = (r >> 4) * 2 + (c >> 5), rr = r & 15, cc = c & 31, ob = rr * 64 + cc * 2; return st * 1024 + (ob ^ (((ob >> 9) & 1) << 5)); }
__host__ __device__ __forceinline__ void stage_rc(int b, int& R, int& C) { const int st = b / 1024, sb = b % 1024, swz = sb ^ (((sb >> 9) & 1) << 5); R = (st >> 1) * 16 + swz / 64; C = (st & 1) * 32 + (swz % 64) / 2; }
__host__ __device__ __forceinline__ int perm32(int rho) { const int n = rho >> 4, i = rho & 15; return 8 * (i >> 2) + 4 * n + (i & 3); }

struct Unit { int pm, pn; };
struct Gemm { const bf16_t* A; const bf16_t* Bt; int M, N, K; };

struct StaticOrder {
    int nM, nN, nwg, G, c;
    __host__ __device__ void init(int M, int N, int G_, int c_) { nM = M / BM; nN = N / BM; nwg = nM * nN; G = G_; c = c_; }
    __host__ __device__ bool next(int i, Unit& u) const {
        const long L = (long)i * G + c; if (L >= nwg) return false;
        int wgid = (int)L; { const int q = nwg / NXCD, r = nwg % NXCD, xcd = wgid % NXCD, off = wgid / NXCD; wgid = (xcd < r ? xcd * (q + 1) : r * (q + 1) + (xcd - r) * q) + off; }
        const int nig = WGM * nN, gid = wgid / nig, fm = gid * WGM, gsz = (nM - fm) < WGM ? (nM - fm) : WGM;
        u.pm = fm + ((wgid % nig) % gsz); u.pn = (wgid % nig) / gsz; return true;
    }
    __device__ __forceinline__ void a_ready(const Unit&) const {}
    __device__ __forceinline__ void done(const Unit&) const {}
};
__device__ __forceinline__ unsigned cvt_pk_bf16(float lo, float hi) { unsigned r; asm volatile("v_cvt_pk_bf16_f32 %0, %1, %2" : "=v"(r) : "v"(lo), "v"(hi)); return r; }

template <class Epi, class Sched, bool ALIGN_EPI = false, bool SP2 = false>
__device__ __forceinline__ void gemm_phase(PG8_LAS unsigned char* lds, const Gemm g, const Sched& S, const Epi& E) {
    const int tid = threadIdx.x, wid = __builtin_amdgcn_readfirstlane(tid >> 6), lane = tid & 63, wr = wid >> 2, wc = wid & 3, fr = lane & 15, fq = lane >> 4;
    const int K = g.K, nt = K / BK;
    unsigned voffA[2], voffB[2];
#pragma unroll
    for (int i = 0; i < 2; ++i) { int R, C; stage_rc(tid * 16 + i * 8192, R, C); const int Rb = Epi::PERM ? ((R & ~31) + perm32(R & 31)) : R;
        voffA[i] = (unsigned)(R * K + C) * 2u; voffB[i] = (unsigned)(Rb * K + C) * 2u; }
    const size_t kstep = (size_t)(BK * 2);
    const size_t hstep = (size_t)HALF * K * 2;
    const size_t tstep = 2 * hstep;
    const unsigned ldsw = (unsigned)wid * 1024u;
    const int aoff = lds_byte(wr * 64 + fr, fq * 8), boff = lds_byte(wc * 32 + fr, fq * 8);
#define PG8_SA(b, h) (((b) * 2 + (h)) * HTB)
#define PG8_SB(b, h) ((4 + (b) * 2 + (h)) * HTB)
#define PG8_STAGE(bufoff, gbase, voff) do { _Pragma("unroll") for (int _i = 0; _i < 2; ++_i) \
        __builtin_amdgcn_global_load_lds((const unsigned*)((const char*)(gbase) + (voff)[_i]), (PG8_LAS unsigned*)(lds + (bufoff) + ldsw + _i * 8192), 16, 0, 0); } while (0)
#define PG8_LDA(dst, b, h) do { _Pragma("unroll") for (int m = 0; m < 4; ++m) _Pragma("unroll") for (int k = 0; k < 2; ++k) dst[m][k] = *(const PG8_LAS bf16x8*)(lds + PG8_SA(b, h) + aoff + m * 2048 + k * 1024); } while (0)
#define PG8_LDB(dst, b, h) do { _Pragma("unroll") for (int n = 0; n < 2; ++n) _Pragma("unroll") for (int k = 0; k < 2; ++k) dst[n][k] = *(const PG8_LAS bf16x8*)(lds + PG8_SB(b, h) + boff + n * 2048 + k * 1024); } while (0)
#define PG8_MMA(ai, bj, At, Bt) do { __builtin_amdgcn_s_setprio(1); _Pragma("unroll") for (int m = 0; m < 4; ++m) _Pragma("unroll") for (int n = 0; n < 2; ++n) _Pragma("unroll") for (int k = 0; k < 2; ++k) \
        acc[ai][bj][m][n] = __builtin_amdgcn_mfma_f32_16x16x32_bf16(Bt[n][k], At[m][k], acc[ai][bj][m][n], 0, 0, 0); __builtin_amdgcn_s_setprio(0); } while (0)
#define PG8_WAIT_V(n) asm volatile("s_waitcnt vmcnt(" #n ")" ::: "memory")
#define PG8_WAIT_L(n) asm volatile("s_waitcnt lgkmcnt(" #n ")" ::: "memory")
#define PG8_BAR __builtin_amdgcn_s_barrier()
#define PG8_SCHED __builtin_amdgcn_sched_barrier(0)
    Unit cur, nxt; int ui = 0;
    if (!S.next(0, cur)) return;
    f32x4 acc[2][2][4][2];
#pragma unroll
    for (int a = 0; a < 2; ++a)
#pragma unroll
        for (int b = 0; b < 2; ++b)
#pragma unroll
            for (int m = 0; m < 4; ++m)
#pragma unroll
                for (int n = 0; n < 2; ++n) acc[a][b][m][n] = (f32x4){0.f, 0.f, 0.f, 0.f};
    bf16x8 At[4][2], B0[2][2], B1[2][2];
    const char* cA = (const char*)g.A + (size_t)cur.pm * tstep; const char* cB = (const char*)g.Bt + (size_t)cur.pn * tstep;
    S.a_ready(cur);
    if constexpr (SP2) {
        PG8_STAGE(PG8_SB(0, 0), cB, voffB); PG8_STAGE(PG8_SB(0, 1), cB + hstep, voffB); PG8_STAGE(PG8_SA(0, 0), cA, voffA); PG8_STAGE(PG8_SA(0, 1), cA + hstep, voffA);
        if (wr == 1) PG8_BAR;
        PG8_WAIT_V(2); PG8_BAR;
        PG8_STAGE(PG8_SB(1, 0), cB + kstep, voffB); PG8_STAGE(PG8_SA(1, 0), cA + kstep, voffA); PG8_STAGE(PG8_SB(1, 1), cB + hstep + kstep, voffB);
        PG8_WAIT_V(6); PG8_BAR;
    } else {
        PG8_STAGE(PG8_SB(0, 0), cB, voffB); PG8_STAGE(PG8_SA(0, 0), cA, voffA); PG8_STAGE(PG8_SB(0, 1), cB + hstep, voffB); PG8_STAGE(PG8_SA(0, 1), cA + hstep, voffA);
        if (wr == 1) PG8_BAR;
        PG8_WAIT_V(4); PG8_BAR;
        PG8_STAGE(PG8_SB(1, 0), cB + kstep, voffB); PG8_STAGE(PG8_SA(1, 0), cA + kstep, voffA); PG8_STAGE(PG8_SB(1, 1), cB + hstep + kstep, voffB);
        PG8_WAIT_V(6); PG8_BAR;
    }
    for (;;) {
        const bool has_next = S.next(ui + 1, nxt);
        const char* nA = has_next ? (const char*)g.A + (size_t)nxt.pm * tstep : cA; const char* nB = has_next ? (const char*)g.Bt + (size_t)nxt.pn * tstep : cB;
        for (int t = 0; t < nt; t += 2) {
            const bool last = (t == nt - 2);
            const char* a1 = cA + (size_t)(t + 1) * kstep;
            const char* a2 = last ? nA : cA + (size_t)(t + 2) * kstep; const char* b2 = last ? nB : cB + (size_t)(t + 2) * kstep;
            const char* a3 = a2 + kstep; const char* b3 = b2 + kstep;
            if (last && has_next) S.a_ready(nxt);
            if constexpr (SP2) {
            PG8_LDB(B0, 0, 0); PG8_LDB(B1, 0, 1); PG8_SCHED; PG8_LDA(At, 0, 0); PG8_STAGE(PG8_SA(1, 1), a1 + hstep, voffA);
            PG8_WAIT_V(8); PG8_WAIT_L(0); PG8_BAR; PG8_MMA(0, 0, At, B0); PG8_MMA(0, 1, At, B1); PG8_BAR; PG8_SCHED;
            PG8_LDA(At, 0, 1); PG8_STAGE(PG8_SB(0, 0), b2, voffB); PG8_STAGE(PG8_SB(0, 1), b2 + hstep, voffB); PG8_STAGE(PG8_SA(0, 0), a2, voffA);
            PG8_WAIT_V(8); PG8_WAIT_L(0); PG8_BAR; PG8_MMA(1, 0, At, B0); PG8_MMA(1, 1, At, B1); PG8_BAR; PG8_SCHED;
            PG8_LDB(B0, 1, 0); PG8_LDB(B1, 1, 1); PG8_SCHED; PG8_LDA(At, 1, 0); PG8_STAGE(PG8_SA(0, 1), a2 + hstep, voffA);
            PG8_WAIT_V(8); PG8_WAIT_L(0); PG8_BAR; PG8_MMA(0, 0, At, B0); PG8_MMA(0, 1, At, B1); PG8_BAR; PG8_SCHED;
            PG8_LDA(At, 1, 1); PG8_STAGE(PG8_SB(1, 0), b3, voffB); PG8_STAGE(PG8_SB(1, 1), b3 + hstep, voffB); PG8_STAGE(PG8_SA(1, 0), a3, voffA);
            PG8_WAIT_V(8); PG8_WAIT_L(0); PG8_BAR; PG8_MMA(1, 0, At, B0); PG8_MMA(1, 1, At, B1); PG8_BAR; PG8_SCHED;
            } else {
            PG8_LDB(B0, 0, 0); PG8_SCHED; PG8_LDA(At, 0, 0); PG8_STAGE(PG8_SA(1, 1), a1 + hstep, voffA);
            PG8_WAIT_L(8); PG8_BAR; PG8_WAIT_L(0); PG8_MMA(0, 0, At, B0); PG8_BAR; PG8_SCHED;
            PG8_LDB(B1, 0, 1); PG8_STAGE(PG8_SB(0, 0), b2, voffB);
            PG8_BAR; PG8_WAIT_L(0); PG8_MMA(0, 1, At, B1); PG8_BAR;
            PG8_LDA(At, 0, 1); PG8_STAGE(PG8_SA(0, 0), a2, voffA);
            PG8_BAR; PG8_WAIT_L(0); PG8_MMA(1, 0, At, B0); PG8_BAR; PG8_SCHED;
            PG8_STAGE(PG8_SB(0, 1), b2 + hstep, voffB);
            PG8_WAIT_V(6); PG8_BAR; PG8_MMA(1, 1, At, B1); PG8_BAR;
            PG8_LDB(B0, 1, 0); PG8_SCHED; PG8_LDA(At, 1, 0); PG8_STAGE(PG8_SA(0, 1), a2 + hstep, voffA);
            PG8_WAIT_L(8); PG8_BAR; PG8_WAIT_L(0); PG8_MMA(0, 0, At, B0); PG8_BAR; PG8_SCHED;
            PG8_LDB(B1, 1, 1); PG8_STAGE(PG8_SB(1, 0), b3, voffB);
            PG8_BAR; PG8_WAIT_L(0); PG8_MMA(0, 1, At, B1); PG8_BAR;
            PG8_LDA(At, 1, 1); PG8_STAGE(PG8_SA(1, 0), a3, voffA);
            PG8_BAR; PG8_WAIT_L(0); PG8_MMA(1, 0, At, B0); PG8_BAR; PG8_SCHED;
            PG8_STAGE(PG8_SB(1, 1), b3 + hstep, voffB);
            PG8_WAIT_V(6); PG8_BAR; PG8_MMA(1, 1, At, B1); PG8_BAR;
            }
        }
        if constexpr (ALIGN_EPI) { if (wr == 0) PG8_BAR; }
        if constexpr (!Epi::AFTER_DRAIN) { E(acc, cur, wr, wc, fr, fq); S.done(cur); }
        if (!has_next) break;
#pragma unroll
        for (int a = 0; a < 2; ++a)
#pragma unroll
            for (int b = 0; b < 2; ++b)
#pragma unroll
                for (int m = 0; m < 4; ++m)
#pragma unroll
                    for (int n = 0; n < 2; ++n) acc[a][b][m][n] = (f32x4){0.f, 0.f, 0.f, 0.f};
        cur = nxt; cA = nA; cB = nB; ++ui;
        if constexpr (ALIGN_EPI) { if (wr == 1) PG8_BAR; }
    }
    PG8_WAIT_V(0);
    if constexpr (!ALIGN_EPI) { if (wr == 0) PG8_BAR; }
    PG8_BAR;
    if constexpr (Epi::AFTER_DRAIN) { E.fused(acc, cur, wr, wc, fr, fq, lds, wid, lane); S.done(cur); }
#undef PG8_SA
#undef PG8_SB
#undef PG8_STAGE
#undef PG8_LDA
#undef PG8_LDB
#undef PG8_MMA
#undef PG8_WAIT_V
#undef PG8_WAIT_L
#undef PG8_BAR
#undef PG8_SCHED
}
}
constexpr int NWAVES = 8, NTHR = 512;
constexpr int DM = 1024, SEQ = 4096, NBP = 4, NBS = 128, TS4 = 4;
constexpr int TP = NBP * SEQ, TS = NBS * TS4, MR = TP + TS;
constexpr int NE = 3584, NO = 3080, NOP = 3328;
constexpr int ZQA = 0, ZKA = 512, ZVA = 1024, ZGA = 1536, ZQB = 2048, ZKB = 2304, ZVB = 2560, ZGB = 3072;
constexpr int YU = 0, YV = 512, YGC = 1024, YZG = 1536, YXBC = 2048, YDT = 3072;
constexpr int NPHYS = 2560, PAGE = 128, NPAGES = 16, PAST = 2048;
constexpr float EPS = 1e-6f;
constexpr size_t O_YP = 0, O_YS = O_YP + (size_t)TP * DM, O_KP = O_YS + (size_t)TS * DM, O_VP = O_KP + (size_t)TP * 512, O_KS = O_VP + (size_t)TP * 512,
    O_VS = O_KS + (size_t)TS * 512, O_RSP = O_VS + (size_t)TS * 512, O_RSS = O_RSP + (size_t)NBP * 4 * 8192, O_SGV = O_RSS + (size_t)NBS * 4 * 8192,
    O_SSP = O_SGV + (size_t)TS * 512, O_SSS = O_SSP + (size_t)NBP * 8 * 8192, O_CSP = O_SSS + (size_t)NBS * 8 * 8192, O_CSS = O_CSP + (size_t)NBP * 3 * 1024,
    O_END = O_CSS + (size_t)NBS * 3 * 1024;
static_assert(O_END == 48246784, "output size");
constexpr size_t MiB = 1u << 20;
constexpr size_t WS_CTL = 0, CTL_ZERO_BYTES = 32768;
constexpr size_t WS_WINE = 2 * MiB, WS_WOUTE = 10 * MiB, WS_WINO = 12 * MiB, WS_WOUTO = 19 * MiB;
constexpr size_t WS_MODE = 21 * MiB, WS_MODO = 23 * MiB;
constexpr size_t WS_ROPE = 25 * MiB;
constexpr size_t WS_KMEAN = 26 * MiB;
constexpr size_t WS_KPART = 26 * MiB;
constexpr size_t WS_DTRAW = 27 * MiB, WS_DTH = 28 * MiB, WS_CUM = 29 * MiB, WS_CDEC = 30 * MiB;
constexpr size_t WS_H = 32 * MiB;
constexpr size_t WS_Z = 66 * MiB;
constexpr size_t WS_MIX = 182 * MiB;
constexpr size_t WS_X1 = 216 * MiB;
constexpr size_t WS_SLR = 282 * MiB;
constexpr size_t WS_SLS = 298 * MiB;
constexpr size_t WS_XC = 330 * MiB;
constexpr size_t WS_SC = 364 * MiB;
constexpr size_t WS_KMS = 396 * MiB;
constexpr size_t WS_PBR = 400 * MiB;
constexpr size_t WS_PBS = 410 * MiB;
constexpr size_t WS_END = 432 * MiB;
constexpr int CW_BAR = 4096;
constexpr int XCH_OFF = 131072;
constexpr int SCR_BYTES = 155648;
constexpr int MISC_OFF = SCR_BYTES;
constexpr int LDS_BYTES = SCR_BYTES + 256;

#define GAS __attribute__((address_space(1)))
#define LAS __attribute__((address_space(3)))
typedef unsigned short bf16;
typedef unsigned v4u __attribute__((ext_vector_type(4)));
typedef unsigned v2u __attribute__((ext_vector_type(2)));
typedef float f32x4 __attribute__((ext_vector_type(4)));
typedef float f32x2 __attribute__((ext_vector_type(2)));
typedef GAS unsigned gu32;
#define RLX_AGENT __ATOMIC_RELAXED, __HIP_MEMORY_SCOPE_AGENT
__device__ __forceinline__ float bf2f(unsigned v16) { return __uint_as_float(v16 << 16); }
__device__ __forceinline__ unsigned f2bf(float f) { unsigned u = __float_as_uint(f); return (u + 0x7fffu + ((u >> 16) & 1u)) >> 16; }
__device__ __forceinline__ unsigned pk2(float lo, float hi) { return f2bf(lo) | (f2bf(hi) << 16); }
__device__ __forceinline__ void unpack8(v4u w, float* f) {
    f[0] = __uint_as_float(w.x << 16); f[1] = __uint_as_float(w.x & 0xffff0000u); f[2] = __uint_as_float(w.y << 16); f[3] = __uint_as_float(w.y & 0xffff0000u);
    f[4] = __uint_as_float(w.z << 16); f[5] = __uint_as_float(w.z & 0xffff0000u); f[6] = __uint_as_float(w.w << 16); f[7] = __uint_as_float(w.w & 0xffff0000u); }
__device__ __forceinline__ v4u pack8(const float* f) { v4u w; w.x = pk2(f[0], f[1]); w.y = pk2(f[2], f[3]); w.z = pk2(f[4], f[5]); w.w = pk2(f[6], f[7]); return w; }
__device__ __forceinline__ float silu_f(float x) { return x / (1.f + __expf(-x)); }
__device__ __forceinline__ float gelu_f(float x) { const float y = 0.7978845608028654f * (x + 0.044715f * x * x * x); const float t = 1.f - 2.f / (__expf(2.f * y) + 1.f); return 0.5f * x * (1.f + t); }
__device__ __forceinline__ float softplus_f(float x) { return x > 20.f ? x : log1pf(__expf(x)); }
__device__ __forceinline__ float wave_sum(float v) {
#pragma unroll
    for (int o = 1; o < 64; o <<= 1) v += __shfl_xor(v, o);
    return v;
}
__device__ __forceinline__ float red8_dpp(float s) {
    s += __int_as_float(__builtin_amdgcn_update_dpp(0, __float_as_int(s), 0xB1, 0xF, 0xF, true));
    s += __int_as_float(__builtin_amdgcn_update_dpp(0, __float_as_int(s), 0x4E, 0xF, 0xF, true));
    s += __int_as_float(__builtin_amdgcn_update_dpp(0, __float_as_int(s), 0x141, 0xF, 0xF, true));
    return s;
}
__device__ __forceinline__ float red16_dpp(float s) {
    s = red8_dpp(s);
    s += __int_as_float(__builtin_amdgcn_update_dpp(0, __float_as_int(s), 0x140, 0xF, 0xF, true));
    return s;
}
__device__ __forceinline__ float wave_max(float v) {
#pragma unroll
    for (int o = 1; o < 64; o <<= 1) v = fmaxf(v, __shfl_xor(v, o));
    return v;
}
__device__ __forceinline__ int t5_bucket(int n) { if (n < 16) return n; const int l = 16 + (int)(logf((float)n * 0.0625f) / 2.0794415416798357f * 16.f); return l < 31 ? l : 31; }
__device__ __forceinline__ int mod_row(int r) { return r < TP ? (r >> 12) : 4 + ((r - TP) >> 2); }
__device__ __forceinline__ int pos_of(int r) { return r < TP ? (r & (SEQ - 1)) : PAST + (r & 3); }
template <int I> __device__ __forceinline__ const float* inp_ptr() {
    const unsigned long long kp = (unsigned long long)__builtin_amdgcn_kernarg_segment_ptr(); unsigned long long v;
    asm volatile("s_load_dwordx2 %0, %1, %2\n\ts_waitcnt lgkmcnt(0)" : "=s"(v) : "s"(kp), "i"(I * 8));
    return (const float*)(const GAS float*)v;
}
#define INP(i) inp_ptr<i>()
namespace attn_body {
using bf16=__hip_bfloat16;
using bf16x8=__attribute__((ext_vector_type(8)))short;
using s16x4=__attribute__((ext_vector_type(4)))short;
using f32x16=__attribute__((ext_vector_type(16)))float;
using u32x4=__attribute__((ext_vector_type(4)))unsigned;
constexpr int BATCH=4,NHEAD=8,SEQ=4096,D=64,DM=3584;
constexpr int NW=8,QBLK=32,QB=QBLK*NW,KVBLK=64,NQB=SEQ/QB;
constexpr int ATTN_PITCH=DM, ATTN_UNIT_ROWS=QB;
__device__ __forceinline__ int crow(int r,int hi){return (r&3)+8*(r>>2)+4*hi;}
#define SBAR() __builtin_amdgcn_sched_barrier(0)
__device__ __forceinline__ void cmask(f32x16&p0,f32x16&p1,int jb,int qrel,int hi){
  const float NEG=-INFINITY; int kb=64*jb+4*hi;
  #pragma unroll
  for(int r=0;r<16;++r){int kv=kb+(r&3)+8*(r>>2); if(kv>qrel)p0[r]=NEG; if(kv+32>qrel)p1[r]=NEG;}
}

__device__ __forceinline__ void cinit(f32x16&c0,f32x16&c1,int t,int NT,int qb,int qrel,int hi,unsigned selm,const float*lut,float mhat){
  const float NEG=-INFINITY; const bool band=t<4; const int pt=band?4*qb+t:t-4;
  const bool keep=(((selm>>((pt>>2)&15))&1u)!=0u);
  if(t>=4&&t<NT-2){ const float v=keep?-mhat:NEG;
    #pragma unroll
    for(int r=0;r<16;++r){c0[r]=v;c1[r]=v;} }
  else { const int lim=band?(qrel-64*t-4*hi):(keep?4096:-4096); const float*lp=lut+256+(256*qb+qrel-64*pt)-4*hi;
    #pragma unroll
    for(int r=0;r<16;++r){ const int c=(r&3)+8*(r>>2); const float b0=lp[-c], b1=lp[-c-32]; c0[r]=(c>lim)?NEG:b0-mhat; c1[r]=(c+32>lim)?NEG:b1-mhat; } }
}
constexpr int NSLOT=3, SLOTB=8192;
constexpr int LDS_K=0, LDS_V=NSLOT*SLOTB, LDS_WS=2*NSLOT*SLOTB, LDS_OST=LDS_WS+NW*64*4, LDS_BYTES=LDS_OST+NW*4096;
constexpr int LUTN=4352;
constexpr int LDS_KM=LDS_BYTES, LDS_LUT=LDS_KM+4096, LDS_TOTAL=LDS_LUT+LUTN*4;
constexpr float C2=0.125f*1.4426950408889634f;
__device__ __forceinline__ void glds16(const void*gsrc,unsigned lds_dst){unsigned keep;
  asm volatile("s_mov_b32 %0, m0\n\ts_mov_b32 m0, %2\n\ts_nop 0\n\tglobal_load_lds_dwordx4 %1, off\n\ts_mov_b32 m0, %0":"=&s"(keep):"v"(gsrc),"s"(lds_dst):"memory");}
__device__ __forceinline__ float max3f(float a,float b,float c){float r;asm("v_max3_f32 %0, %1, %2, %3":"=v"(r):"v"(a),"v"(b),"v"(c));return r;}
__device__ __forceinline__ float max2f(float a,float b){float r;asm("v_max_f32_e32 %0, %1, %2":"=v"(r):"v"(a),"v"(b));return r;}
__device__ __forceinline__ float fadd_s(float a,float b){float r;asm("v_add_f32_e32 %0, %1, %2":"=v"(r):"v"(a),"v"(b));return r;}
__device__ __forceinline__ float fsub_s(float a,float b){float r;asm("v_sub_f32_e32 %0, %1, %2":"=v"(r):"v"(a),"v"(b));return r;}
typedef float f32x2_t __attribute__((ext_vector_type(2))); typedef __bf16 bf16x2_t __attribute__((ext_vector_type(2)));
__device__ __forceinline__ unsigned cvtpk_s(float lo,float hi){f32x2_t v={lo,hi};bf16x2_t b=__builtin_convertvector(v,bf16x2_t);return __builtin_bit_cast(unsigned,b);}
#define WAIT_BAR(N) asm volatile("s_waitcnt vmcnt(" #N ") lgkmcnt(0)\n\ts_barrier":::"memory")

__device__ __forceinline__ void qkt(f32x16&p0,f32x16&p1,const char*Kslot,const bf16x8*qr,int r32,int hi){
  const char*kb=Kslot+hi*1024+r32*16;
  #pragma unroll
  for(int d0=0;d0<4;++d0){
    const bf16x8 b0=*reinterpret_cast<const bf16x8*>(kb+d0*2048);
    const bf16x8 b1=*reinterpret_cast<const bf16x8*>(kb+d0*2048+512);
    p0=__builtin_amdgcn_mfma_f32_32x32x16_bf16(b0,qr[d0],p0,0,0,0);p1=__builtin_amdgcn_mfma_f32_32x32x16_bf16(b1,qr[d0],p1,0,0,0);}
}
typedef __attribute__((address_space(3))) const char* lds_cptr;
typedef short v4i16_t __attribute__((ext_vector_type(4)));
__device__ __forceinline__ void kload8(bf16x8*kf,lds_cptr kp){
  kf[0]=*(const __attribute__((address_space(3))) bf16x8*)(kp);      kf[1]=*(const __attribute__((address_space(3))) bf16x8*)(kp+512);
  kf[2]=*(const __attribute__((address_space(3))) bf16x8*)(kp+2048); kf[3]=*(const __attribute__((address_space(3))) bf16x8*)(kp+2560);
  kf[4]=*(const __attribute__((address_space(3))) bf16x8*)(kp+4096); kf[5]=*(const __attribute__((address_space(3))) bf16x8*)(kp+4608);
  kf[6]=*(const __attribute__((address_space(3))) bf16x8*)(kp+6144); kf[7]=*(const __attribute__((address_space(3))) bf16x8*)(kp+6656);
}
__device__ __forceinline__ void kload2(bf16x8*kf,lds_cptr kp,int j){ kf[2*j]=*(const __attribute__((address_space(3))) bf16x8*)(kp+j*2048); kf[2*j+1]=*(const __attribute__((address_space(3))) bf16x8*)(kp+j*2048+512); }
__device__ __forceinline__ s16x4 vtr(lds_cptr p){ return __builtin_bit_cast(s16x4,__builtin_amdgcn_ds_read_tr16_b64_v4i16((__attribute__((address_space(3))) v4i16_t*)p)); }
__device__ __forceinline__ float rowmax(const f32x16&p0,const f32x16&p1){
  float a=max3f(p0[0],p0[1],p1[0]),b=max3f(p0[2],p0[3],p1[1]);a=max3f(a,p1[2],p1[3]);
  #pragma unroll
  for(int r=4;r<16;r+=4){a=max3f(a,p0[r],p0[r+1]);b=max3f(b,p0[r+2],p0[r+3]);a=max3f(a,p1[r],p1[r+1]);b=max3f(b,p1[r+2],p1[r+3]);}
  const float m=max2f(a,b);
  auto rr=__builtin_amdgcn_permlane32_swap(__float_as_uint(m),__float_as_uint(m),false,false);
  return max2f(__uint_as_float(rr[0]),__uint_as_float(rr[1]));
}
__device__ __forceinline__ void pv(f32x16*o,int vb,bf16x8 pa0,bf16x8 pa1,bf16x8 pa2,bf16x8 pa3){
  #pragma unroll
  for(int d0=0;d0<2;++d0){s16x4 lo[4],hi[4];
    #pragma unroll
    for(int ks=0;ks<4;++ks){
      asm volatile("ds_read_b64_tr_b16 %0,%1 offset:%c2":"=&v"(lo[ks]):"v"(vb),"i"(d0*4096+ks*1024):"memory");
      asm volatile("ds_read_b64_tr_b16 %0,%1 offset:%c2":"=&v"(hi[ks]):"v"(vb),"i"(d0*4096+ks*1024+512):"memory");}
    asm volatile("s_waitcnt lgkmcnt(0)":::"memory");SBAR();
    #define PK(k) (bf16x8){lo[k][0],lo[k][1],lo[k][2],lo[k][3],hi[k][0],hi[k][1],hi[k][2],hi[k][3]}
    o[d0]=__builtin_amdgcn_mfma_f32_32x32x16_bf16(pa0,PK(0),o[d0],0,0,0);
    o[d0]=__builtin_amdgcn_mfma_f32_32x32x16_bf16(pa1,PK(1),o[d0],0,0,0);
    o[d0]=__builtin_amdgcn_mfma_f32_32x32x16_bf16(pa2,PK(2),o[d0],0,0,0);
    o[d0]=__builtin_amdgcn_mfma_f32_32x32x16_bf16(pa3,PK(3),o[d0],0,0,0);
    #undef PK
  }
}

#ifndef ATTN_STORE16
#define ATTN_STORE16(p,v) (*(u32x4*)(p)=(v))
#endif
template<int THRL> __device__ __forceinline__ void attn_unit(int b,int h,int qb,const bf16*Q,const bf16*__restrict__ K,const bf16*__restrict__ V,const bf16*__restrict__ GA,bf16*O,const float*__restrict__ kpart,const float*__restrict__ relb,char*shm,bool setup){
  const int tid=threadIdx.x,lane=tid&63,r32=lane&31,hi=lane>>5; const int wid=__builtin_amdgcn_readfirstlane(tid>>6);
  const long rowbase=(long)b*SEQ; const int q0=qb*QB;
  const bf16*Qw=Q+(rowbase+q0+wid*QBLK)*DM+h*D;
  const bf16*Kh=K+rowbase*DM+h*D,*Vh=V+rowbase*DM+h*D;
  const unsigned lds0=(unsigned)(uintptr_t)shm;
  float*wsf=(float*)(shm+LDS_WS)+wid*64;
  const bf16*ksrc=Kh+(long)lane*DM+wid*8;
  const bf16*vsrc=Vh+(long)(16*(wid&3)+(lane>>2))*DM+(wid>>2)*32+(lane&3)*8;
  const unsigned kdst=lds0+LDS_K+wid*1024, vdst=lds0+LDS_V+wid*1024;
  #define PHYS(t) (((t)<4)?(4*qb+(t)):((t)-4))
  #define DMA_K(t,slot) glds16(ksrc+(long)(PHYS(t))*KVBLK*DM,(unsigned)__builtin_amdgcn_readfirstlane(kdst+(slot)))
  #define DMA_V(t,slot) glds16(vsrc+(long)(PHYS(t))*KVBLK*DM,(unsigned)__builtin_amdgcn_readfirstlane(vdst+(slot)))
  const int vb0=(int)(lds0+LDS_V)+((lane>>4)&1)*32+(lane&3)*8+(4*hi+((lane&15)>>2))*64;
  const char*Kbase=shm+LDS_K; bf16x8 kf[8];
  const lds_cptr shm3=(lds_cptr)shm; const lds_cptr kp0=shm3+LDS_K+hi*1024+r32*16; const lds_cptr vp0=shm3+LDS_V+((lane>>4)&1)*32+(lane&3)*8+(4*hi+((lane&15)>>2))*64;
  const int NT=(q0+QB)/KVBLK;
  bf16x8 qr[4];
  #pragma unroll
  for(int d0=0;d0<4;++d0)qr[d0]=*reinterpret_cast<const bf16x8*>(&Qw[(long)r32*DM+d0*16+hi*8]);
  unsigned selm=0u; const float*lut=(const float*)(shm+LDS_LUT);
  { float*kmn=(float*)(shm+LDS_KM); float*lw=(float*)(shm+LDS_LUT);
    if(setup){
    for(int e=tid;e<qb*64;e+=512){ const int n=e>>6,d=e&63; kmn[e]=kpart[(size_t)(b*16+n)*512+h*64+d]; }
    for(int e=tid;e<LUTN;e+=512){ float v=0.f; if(e>=256&&e<384){ const int dd=e-256; int bk=dd; if(dd>=16){ bk=16+(int)(logf((float)dd*0.0625f)/2.0794415416798357f*16.f); bk=bk<31?bk:31; } v=(relb[bk*8+h]-relb[31*8+h])*1.4426950408889634f; } lw[e]=v; }
    __syncthreads(); }
    float v1=-3e38f,v2=-3e38f,v3=-3e38f; int i1=-1,i2=-1,i3=-1;
    for(int n=0;n<qb;++n){ float s=0.f;
      #pragma unroll
      for(int d0=0;d0<4;++d0){ const float*kp=kmn+n*64+16*d0+8*hi;
        #pragma unroll
        for(int jj=0;jj<8;++jj)s+=__uint_as_float(((unsigned)(unsigned short)qr[d0][jj])<<16)*kp[jj]; }
      s+=__shfl_xor(s,32);
      if(s>v1){v3=v2;i3=i2;v2=v1;i2=i1;v1=s;i1=n;} else if(s>v2){v3=v2;i3=i2;v2=s;i2=n;} else if(s>v3){v3=s;i3=n;} }
    if(i1>=0)selm|=1u<<i1; if(i2>=0)selm|=1u<<i2; if(i3>=0)selm|=1u<<i3; }
  DMA_K(0,0);DMA_V(0,0);DMA_K(1,SLOTB);
  float mhat=0.f,l_reg=0.f;f32x16 o[2];o[0]=f32x16{};o[1]=f32x16{};
  const int qrel=wid*QBLK+r32;
  #define CINIT(P0,P1,t) cinit(P0,P1,(t),NT,qb,qrel,hi,selm,lut,mhat)
  bool resc=false;
  #define START(P0,P1) do{ const float rm=rowmax(P0,P1); resc=false; \
    { const float dl=rm; mhat=fadd_s(mhat,dl); \
      _Pragma("unroll") for(int r=0;r<16;++r){P0[r]=fsub_s(P0[r],dl);P1[r]=fsub_s(P1[r],dl);} \
      } \
    _Pragma("unroll") for(int r=0;r<16;++r)P0[r]=__builtin_amdgcn_exp2f(P0[r]); }while(0)
  #define RESC() do{ if(resc){ asm volatile("s_waitcnt lgkmcnt(0)":::"memory"); \
      _Pragma("unroll") for(int d_=0;d_<2;++d_) _Pragma("unroll") for(int r=0;r<16;++r)o[d_][r]*=wsf[crow(r,hi)]; } }while(0)
  f32x16 pA0,pA1,pB0,pB1;
  int sl_prev=0,sl_cur=0,sl_next=SLOTB;
  #define ROT() do{sl_prev=sl_cur;sl_cur=sl_next;sl_next=(sl_next==(NSLOT-1)*SLOTB)?0:sl_next+SLOTB;}while(0)
  DMA_K(2,2*SLOTB);
  WAIT_BAR(3);
  CINIT(pA0,pA1,0); qkt(pA0,pA1,Kbase,qr,r32,hi);asm volatile("s_nop 15\n\ts_nop 7":"+v"(pA0),"+v"(pA1));
  START(pA0,pA1);
  _Pragma("unroll") for(int r=0;r<16;++r)pA1[r]=__builtin_amdgcn_exp2f(pA1[r]);
  WAIT_BAR(0);
  DMA_K(3,0);DMA_V(1,SLOTB);
  ROT();
  kload8(kf,kp0+sl_cur);
  WAIT_BAR(2);
  s16x4 vlo[8],vhi[8]; u32x4 pw0,pw1,pw2,pw3;
  #define PKW(P,B) cvtpk_s(P[B],P[B+1])
  #define PAF(k) __builtin_bit_cast(bf16x8,pw##k)
  #define VFR(i) (bf16x8){vlo[i][0],vlo[i][1],vlo[i][2],vlo[i][3],vhi[i][0],vhi[i][1],vhi[i][2],vhi[i][3]}
  #define PIN(x) asm volatile("":"+v"(x))
  #define MX3(a,b,c) __builtin_fmaxf(__builtin_fmaxf((a),(b)),(c))
  #define GAPA(MF,A0,A1,A2,A3,W0,W1,PW) do{ MF; sacc+=A0; sacc+=A1; sacc+=A2; sacc+=A3; PIN(sacc); W0; W1; PIN(PW); SBAR(); }while(0)
  #define EX(v) __builtin_amdgcn_exp2f(v)
  #define GAPB(MF,X,B) do{ MF; X[B]=EX(X[B]); X[B+1]=EX(X[B+1]); X[B+2]=EX(X[B+2]); X[B+3]=EX(X[B+3]); PIN(X); SBAR(); }while(0)
  #define VRD(i) do{ vlo[i]=vtr(vp_+(((i)>>2)*4096+((i)&3)*1024)); vhi[i]=vtr(vp_+(((i)>>2)*4096+((i)&3)*1024+512)); }while(0)
  #define KRD(G,j) do{ if(G){ kload2(kf,kp0+sl_next,j); SBAR(); } }while(0)
  #define STEP(C0,C1,P0,P1,t,GK,GV,GL) do{ CINIT(C0,C1,t); SBAR(); \
    const lds_cptr vp_=vp0+sl_prev; \
    VRD(0); SBAR(); float sacc=(P0[0]+P0[1]); \
    GAPA(C0=__builtin_amdgcn_mfma_f32_32x32x16_bf16(kf[0],qr[0],C0,0,0,0), P0[2],P0[3],P0[4],P0[5],     pw0[0]=PKW(P0,0), pw0[1]=PKW(P0,2), pw0); \
    VRD(4); SBAR(); GAPA(C1=__builtin_amdgcn_mfma_f32_32x32x16_bf16(kf[1],qr[0],C1,0,0,0), P0[6],P0[7],P0[8],P0[9],     pw0[2]=PKW(P0,4), pw0[3]=PKW(P0,6), pw0); \
    VRD(1); SBAR(); GAPA(C0=__builtin_amdgcn_mfma_f32_32x32x16_bf16(kf[2],qr[1],C0,0,0,0),   P0[10],P0[11],P0[12],P0[13], pw1[0]=PKW(P0,8), pw1[1]=PKW(P0,10), pw1); \
    VRD(5); SBAR(); GAPA(C1=__builtin_amdgcn_mfma_f32_32x32x16_bf16(kf[3],qr[1],C1,0,0,0),   P0[14],P0[15],P1[0],P1[1],   pw1[2]=PKW(P0,12),pw1[3]=PKW(P0,14), pw1); \
    VRD(2); SBAR(); GAPA(C0=__builtin_amdgcn_mfma_f32_32x32x16_bf16(kf[4],qr[2],C0,0,0,0),   P1[2],P1[3],P1[4],P1[5],     pw2[0]=PKW(P1,0), pw2[1]=PKW(P1,2), pw2); \
    VRD(6); SBAR(); GAPA(C1=__builtin_amdgcn_mfma_f32_32x32x16_bf16(kf[5],qr[2],C1,0,0,0),   P1[6],P1[7],P1[8],P1[9],     pw2[2]=PKW(P1,4), pw2[3]=PKW(P1,6), pw2); \
    VRD(3); SBAR(); GAPA(C0=__builtin_amdgcn_mfma_f32_32x32x16_bf16(kf[6],qr[3],C0,0,0,0),   P1[10],P1[11],P1[12],P1[13], pw3[0]=PKW(P1,8), pw3[1]=PKW(P1,10), pw3); \
    VRD(7); SBAR(); GAPA(C1=__builtin_amdgcn_mfma_f32_32x32x16_bf16(kf[7],qr[3],C1,0,0,0),   P1[14],P1[15],0.f,0.f,       pw3[2]=PKW(P1,12),pw3[3]=PKW(P1,14), pw3); \
    l_reg+=sacc; \
    if(GK){DMA_K((t)+3,sl_cur);} if(GV){DMA_V((t)+1,sl_next);} \
    { float a=MX3(C0[0],C0[1],C1[0]),b=MX3(C0[2],C0[3],C1[1]); a=MX3(a,C1[2],C1[3]); \
      _Pragma("unroll") for(int r=4;r<16;r+=4){a=MX3(a,C0[r],C0[r+1]);b=MX3(b,C0[r+2],C0[r+3]);a=MX3(a,C1[r],C1[r+1]);b=MX3(b,C1[r+2],C1[r+3]);} \
      float rm=__builtin_fmaxf(a,b); { auto rr=__builtin_amdgcn_permlane32_swap(__float_as_uint(rm),__float_as_uint(rm),false,false); rm=__builtin_fmaxf(__uint_as_float(rr[0]),__uint_as_float(rr[1])); } \
      resc=false; \
      if(__builtin_expect(__any(rm>(float)THRL),0)){ const float dl=__builtin_fmaxf(rm,0.f); mhat+=dl; \
        _Pragma("unroll") for(int r=0;r<16;++r){C0[r]-=dl;C1[r]-=dl;} \
        const float f=__builtin_amdgcn_exp2f(-dl); l_reg*=f; if(hi==0)wsf[r32]=f; resc=true; } } \
    SBAR(); \
    GAPB(o[0]=__builtin_amdgcn_mfma_f32_32x32x16_bf16(PAF(0),VFR(0),o[0],0,0,0), C0,0); \
    GAPB(o[1]=__builtin_amdgcn_mfma_f32_32x32x16_bf16(PAF(0),VFR(4),o[1],0,0,0), C0,4); \
    KRD(GL,0); GAPB(o[0]=__builtin_amdgcn_mfma_f32_32x32x16_bf16(PAF(1),VFR(1),o[0],0,0,0), C0,8); \
    KRD(GL,1); GAPB(o[1]=__builtin_amdgcn_mfma_f32_32x32x16_bf16(PAF(1),VFR(5),o[1],0,0,0), C0,12); \
    KRD(GL,2); GAPB(o[0]=__builtin_amdgcn_mfma_f32_32x32x16_bf16(PAF(2),VFR(2),o[0],0,0,0), C1,0); \
    KRD(GL,3); GAPB(o[1]=__builtin_amdgcn_mfma_f32_32x32x16_bf16(PAF(2),VFR(6),o[1],0,0,0), C1,4); \
    GAPB(o[0]=__builtin_amdgcn_mfma_f32_32x32x16_bf16(PAF(3),VFR(3),o[0],0,0,0), C1,8); \
    GAPB(o[1]=__builtin_amdgcn_mfma_f32_32x32x16_bf16(PAF(3),VFR(7),o[1],0,0,0), C1,12); \
    }while(0)
  int t=1;
  for(;t+5<NT;t+=2){
    STEP(pB0,pB1,pA0,pA1,t,true,true,true);     WAIT_BAR(2); RESC(); ROT();
    STEP(pA0,pA1,pB0,pB1,t+1,true,true,true);   WAIT_BAR(2); RESC(); ROT();
  }
  #define ENDW(tt) do{ if((tt)+3<NT){WAIT_BAR(2);} else if((tt)+2<NT){WAIT_BAR(1);} else {WAIT_BAR(0);} }while(0)
  for(;t+1<NT;t+=2){
    STEP(pB0,pB1,pA0,pA1,t,(t+3<NT),(t+1<NT),(t+1<NT));       ENDW(t);   RESC(); ROT();
    STEP(pA0,pA1,pB0,pB1,t+1,(t+4<NT),(t+2<NT),(t+2<NT));     ENDW(t+1); RESC(); ROT();
  }
  STEP(pB0,pB1,pA0,pA1,NT-1,false,false,false); RESC();
  { float sacc=pB0[0]+pB0[1]; _Pragma("unroll") for(int r=2;r<16;++r)sacc+=pB0[r]; _Pragma("unroll") for(int r=0;r<16;++r)sacc+=pB1[r]; l_reg+=sacc;
    pw0=(u32x4){PKW(pB0,0),PKW(pB0,2),PKW(pB0,4),PKW(pB0,6)};pw1=(u32x4){PKW(pB0,8),PKW(pB0,10),PKW(pB0,12),PKW(pB0,14)};pw2=(u32x4){PKW(pB1,0),PKW(pB1,2),PKW(pB1,4),PKW(pB1,6)};pw3=(u32x4){PKW(pB1,8),PKW(pB1,10),PKW(pB1,12),PKW(pB1,14)};
    SBAR(); pv(o,vb0+sl_cur,PAF(0),PAF(1),PAF(2),PAF(3)); }
  #undef PKW
  #undef PAF
  #undef VFR
  #undef PIN
  #undef MX3
  #undef GAPA
  #undef GAPB
  #undef EX
  #undef VRD
  #undef KRD
  #undef STEP
  #undef ENDW
  {auto rr=__builtin_amdgcn_permlane32_swap(__float_as_uint(l_reg),__float_as_uint(l_reg),false,false);l_reg=__uint_as_float(rr[0])+__uint_as_float(rr[1]);}
  if(hi==0)wsf[32+r32]=l_reg;asm volatile("s_waitcnt lgkmcnt(0)":::"memory");
  float rli[16];
  #pragma unroll
  for(int r=0;r<16;++r)rli[r]=__builtin_amdgcn_rcpf(wsf[32+crow(r,hi)]);
  bf16*Ow=O+(rowbase+q0+wid*QBLK)*1024+h*D; const bf16*Gw=GA+(rowbase+q0+wid*QBLK)*DM+h*D;
  { bf16*stg=(bf16*)(shm+LDS_OST)+wid*2048;
    #pragma unroll
    for(int r=0;r<16;++r){const int orow=crow(r,hi);
      #pragma unroll
      for(int d0=0;d0<2;++d0)stg[orow*64+d0*32+r32]=__float2bfloat16(o[d0][r]*rli[r]);}
    asm volatile("s_waitcnt lgkmcnt(0)":::"memory");
    #pragma unroll
    for(int i=0;i<4;++i){const int row=i*8+(lane>>3),ch=lane&7; const u32x4 v=*(const u32x4*)(stg+row*64+ch*8); const u32x4 g=*(const u32x4*)(Gw+(long)row*DM+ch*8); u32x4 w;
      #pragma unroll
      for(int k=0;k<4;++k){ const float lo=__uint_as_float(v[k]<<16)*__uint_as_float(g[k]<<16), hh=__uint_as_float(v[k]&0xffff0000u)*__uint_as_float(g[k]&0xffff0000u); w[k]=cvtpk_s(lo,hh); }
      ATTN_STORE16(Ow+(long)row*1024+ch*8,w);} }
  asm volatile("s_waitcnt lgkmcnt(0)\n\ts_barrier":::"memory");
  #undef DMA_K
  #undef PHYS
  #undef DMA_V
  #undef CINIT
  #undef START
  #undef RESC
  #undef ROT
}
constexpr int ATTN_LDS_BYTES=LDS_TOTAL;
#undef SBAR
#undef WAIT_BAR
}
#define XB_TMO      128
#define XB_XCNT(j)  (256  + 64 * (j))
#define XB_XSUB(j)  (1280 + 64 * (j))
#define XB_XGEN(j)  (2304 + 64 * (j))
#define XB_TOP      3328
#define XB_TOPGEN   3392
#define XCD_BAR_WORDS 3456
#define XB_SPIN_CAP (1u << 18)

__device__ __forceinline__ unsigned xb_ld(unsigned* p)              { return __hip_atomic_load(p, __ATOMIC_RELAXED, __HIP_MEMORY_SCOPE_AGENT); }
__device__ __forceinline__ unsigned xb_add(unsigned* p, unsigned v) { return __hip_atomic_fetch_add(p, v, __ATOMIC_RELAXED, __HIP_MEMORY_SCOPE_AGENT); }
__device__ __forceinline__ unsigned xb_xcc_id() { return (unsigned)__builtin_amdgcn_s_getreg((3 << 11) | 20) & 0xFu; }
#define XB_SPIN(cond, bar) do { unsigned _sp = 0; while (cond) { __builtin_amdgcn_s_sleep(1); \
    if ((++_sp & 255u) == 0u) { if (xb_ld(&(bar)[XB_TMO])) break; if (_sp > XB_SPIN_CAP) { atomicAdd(&(bar)[XB_TMO], 1u); break; } } } } while (0)

struct XcdBarrier {
    unsigned* bar; unsigned x;
    volatile LAS unsigned* st;
};

__device__ __forceinline__ XcdBarrier xcd_barrier_post(unsigned* bar, volatile LAS unsigned* st) {
    XcdBarrier b; b.bar = bar; b.x = xb_xcc_id(); b.st = st;
    if (threadIdx.x == 0) (void)xb_add(&bar[XB_XCNT(b.x)], 1u);
    return b;
}
__device__ __forceinline__ void xcd_barrier_complete(unsigned* bar, unsigned x, unsigned& nloc, unsigned& nx) {
    const unsigned G = gridDim.x * gridDim.y * gridDim.z;
    unsigned sum, cnt, mine, sp = 0u;
    for (;;) {
        sum = 0u; cnt = 0u; mine = 0u;
#pragma unroll
        for (unsigned j = 0; j < 16; ++j) { const unsigned c = xb_ld(&bar[XB_XCNT(j)]); sum += c; cnt += (c > 0u) ? 1u : 0u; mine = (j == x) ? c : mine; }
        if (sum == G) break;
        __builtin_amdgcn_s_sleep(1);
        if ((++sp & 255u) == 0u) { if (xb_ld(&bar[XB_TMO])) break; if (sp > XB_SPIN_CAP) { atomicAdd(&bar[XB_TMO], 1u); break; } }
    }
    nloc = mine > 0u ? mine : 1u; nx = cnt > 0u ? cnt : 1u;
}

__device__ __forceinline__ void xcd_barrier(const XcdBarrier& b) {
    asm volatile("s_waitcnt vmcnt(0)" ::: "memory");
    __syncthreads();
    if (threadIdx.x == 0) {
        unsigned* bar = b.bar;
        __builtin_amdgcn_s_waitcnt(0);
        unsigned nloc = b.st[0], nx = b.st[1];
        if (nloc == 0u) { xcd_barrier_complete(bar, b.x, nloc, nx); b.st[0] = nloc; b.st[1] = nx; }
        const unsigned old = xb_add(&bar[XB_XSUB(b.x)], 1u);
        const unsigned gen = old / nloc;
        if (old + 1u == (gen + 1u) * nloc) {
            __builtin_amdgcn_fence(__ATOMIC_RELEASE, "agent");
            asm volatile("s_waitcnt vmcnt(0)" ::: "memory");
            const unsigned og = xb_add(&bar[XB_TOP], 1u);
            const unsigned tg = og / nx;
            if (og + 1u == (tg + 1u) * nx) xb_add(&bar[XB_TOPGEN], 1u);
            else XB_SPIN(xb_ld(&bar[XB_TOPGEN]) == tg, bar);
            __builtin_amdgcn_fence(__ATOMIC_ACQUIRE, "agent");
            asm volatile("s_waitcnt vmcnt(0)" ::: "memory");
        } else {
            XB_SPIN(xb_ld(&bar[XB_TOPGEN]) == gen, bar);
            __builtin_amdgcn_fence(__ATOMIC_ACQUIRE, "agent");
            asm volatile("s_waitcnt vmcnt(0)" ::: "memory");
        }
    }
    __syncthreads();
}

struct Frame {
    unsigned char* lds;
    int tid, lane, wave, G;
    float* out; unsigned char* ws;
};
#define WSP(T, off) ((T*)(F.ws + (off)))

struct EpiZ {
    static constexpr bool PERM = true, AFTER_DRAIN = false;
    bf16* O; int ldc; float* dt;
    __device__ __forceinline__ void operator()(const pg8::f32x4 (&acc)[2][2][4][2], const pg8::Unit& u, int wr_, int wc_, int fr_, int fq_) const {
        int tz_ = threadIdx.x; asm volatile("" : "+v"(tz_));
        const int fr = tz_ & 15, fq = (tz_ & 63) >> 4, wid_ = __builtin_amdgcn_readfirstlane(tz_ >> 6), wr = wid_ >> 2, wc = wid_ & 3; (void)wr_; (void)wc_; (void)fr_; (void)fq_;
        const int row0 = u.pm * 256 + wr * 64 + fr, col0 = u.pn * 256 + wc * 32 + 8 * fq;
#pragma unroll
        for (int ai = 0; ai < 2; ++ai)
#pragma unroll
            for (int m = 0; m < 4; ++m) { const int row = row0 + ai * 128 + m * 16; bf16* rp = O + (size_t)row * ldc + col0;
#pragma unroll
                for (int bj = 0; bj < 2; ++bj) { const pg8::f32x4 v0 = acc[ai][bj][m][0], v1 = acc[ai][bj][m][1];
                    v4u w; w.x = pg8::cvt_pk_bf16(v0[0], v0[1]); w.y = pg8::cvt_pk_bf16(v0[2], v0[3]); w.z = pg8::cvt_pk_bf16(v1[0], v1[1]); w.w = pg8::cvt_pk_bf16(v1[2], v1[3]);
                    *(v4u*)(rp + bj * 128) = w;
                    if (dt != nullptr && bj == 0 && col0 == YDT) { *(f32x4*)(dt + (size_t)row * 8) = v0; *(f32x4*)(dt + (size_t)row * 8 + 4) = v1; } } }
    }
};
template <bool XB16, bool OB16> struct EpiRes {
    static constexpr bool PERM = true, AFTER_DRAIN = false;
    const void* xp; const void* xs; const float* mod; void* out;
    __device__ __forceinline__ void operator()(const pg8::f32x4 (&acc)[2][2][4][2], const pg8::Unit& u, int wr_, int wc_, int fr_, int fq_) const {
        int tz_ = threadIdx.x; asm volatile("" : "+v"(tz_));
        const int fr = tz_ & 15, fq = (tz_ & 63) >> 4, wid_ = __builtin_amdgcn_readfirstlane(tz_ >> 6), wr = wid_ >> 2, wc = wid_ & 3; (void)wr_; (void)wc_; (void)fr_; (void)fq_;
        const int row0 = u.pm * 256 + wr * 64 + fr, col0 = u.pn * 256 + wc * 32 + 8 * fq;
#pragma unroll
        for (int ai = 0; ai < 2; ++ai)
#pragma unroll
            for (int m = 0; m < 4; ++m) { const int row = row0 + ai * 128 + m * 16;
                const size_t xo = (row < TP) ? (size_t)row * DM : (size_t)(row - TP) * DM; const void* xb = (row < TP) ? xp : xs; const float* gr = mod + (size_t)mod_row(row) * 3072 + 2048;
#pragma unroll
                for (int bj = 0; bj < 2; ++bj) { const int c = col0 + bj * 128; float x8[8];
                    if (XB16) unpack8(*(const v4u*)((const bf16*)xb + xo + c), x8);
                    else { const f32x4 x0 = *(const f32x4*)((const float*)xb + xo + c), x1 = *(const f32x4*)((const float*)xb + xo + c + 4); x8[0] = x0.x; x8[1] = x0.y; x8[2] = x0.z; x8[3] = x0.w; x8[4] = x1.x; x8[5] = x1.y; x8[6] = x1.z; x8[7] = x1.w; }
                    const f32x4 g0 = *(const f32x4*)(gr + c), g1 = *(const f32x4*)(gr + c + 4); const pg8::f32x4 a0 = acc[ai][bj][m][0], a1 = acc[ai][bj][m][1];
                    float o[8] = {x8[0] + g0.x * a0[0], x8[1] + g0.y * a0[1], x8[2] + g0.z * a0[2], x8[3] + g0.w * a0[3], x8[4] + g1.x * a1[0], x8[5] + g1.y * a1[1], x8[6] + g1.z * a1[2], x8[7] + g1.w * a1[3]};
                    if (OB16) *(v4u*)((bf16*)out + (size_t)row * DM + c) = pack8(o);
                    else { float* op = (float*)out + (size_t)row * DM + c; *(f32x4*)(op) = (f32x4){o[0], o[1], o[2], o[3]}; *(f32x4*)((op + 4)) = (f32x4){o[4], o[5], o[6], o[7]}; } } }
    }
};

template <bool PERMQK> __device__ __forceinline__ void transpose_item(const float* W, int K, int N, int Npad, bf16* WT, float* scr, int item, int lane) {
    const int nblk = Npad / 32, kb = item / nblk, nb = item % nblk, k0 = 64 * kb, n0 = 32 * nb;
    int nn = n0 + (lane & 31);
    if (PERMQK && nn >= ZQB && nn < ZVB) { const int p = nn & 63; nn = (nn & ~63) + (p >> 1) + 32 * (p & 1); }
#pragma unroll 8
    for (int i = 0; i < 32; ++i) { const int kk = 2 * i + (lane >> 5); scr[kk * 33 + (lane & 31)] = (nn < N) ? W[(size_t)(k0 + kk) * N + nn] : 0.f; }
    asm volatile("s_waitcnt lgkmcnt(0)" ::: "memory");
    const int c = lane & 7;
#pragma unroll
    for (int j = 0; j < 4; ++j) { const int n = (lane >> 3) + 8 * j; const float* s = scr + (8 * c) * 33 + n;
        v4u o; o.x = pk2(s[0 * 33], s[1 * 33]); o.y = pk2(s[2 * 33], s[3 * 33]); o.z = pk2(s[4 * 33], s[5 * 33]); o.w = pk2(s[6 * 33], s[7 * 33]);
        *(v4u*)(WT + (size_t)(n0 + n) * K + k0 + 8 * c) = o; }
    asm volatile("s_waitcnt lgkmcnt(0)" ::: "memory");
}
__device__ __forceinline__ void weights_phase(Frame& F, int nwg) {
    if ((int)blockIdx.x >= nwg) return;
    const int gw = blockIdx.x * NWAVES + F.wave, NGW = nwg * NWAVES;
    float* scr = (float*)(F.lds + F.wave * 8704);
    constexpr int I_EIN = 16 * (NE / 32), I_EOUT = 16 * 32, I_OIN = 16 * (NOP / 32), I_OOUT = 16 * 32;
    for (int it = gw; it < I_EIN + I_EOUT + I_OIN + I_OOUT; it += NGW) {
        int r = it;
        if (r < I_EIN) { transpose_item<true>(INP(14), DM, NE, NE, WSP(bf16, WS_WINE), scr, r, F.lane); continue; } r -= I_EIN;
        if (r < I_EOUT) { transpose_item<false>(INP(17), DM, DM, DM, WSP(bf16, WS_WOUTE), scr, r, F.lane); continue; } r -= I_EOUT;
        if (r < I_OIN) { transpose_item<false>(INP(21), DM, NO, NOP, WSP(bf16, WS_WINO), scr, r, F.lane); continue; } r -= I_OIN;
        transpose_item<false>(INP(30), DM, DM, DM, WSP(bf16, WS_WOUTO), scr, r, F.lane);
    }
}
__device__ __forceinline__ void rope_phase(Frame& F) {
    f32x2* rope = WSP(f32x2, WS_ROPE);
    for (int e = blockIdx.x * NTHR + F.tid; e < 4096 * 32; e += F.G * NTHR) { const int pos = e >> 5, i = e & 31;
        const float inv = exp2f(-(float)i * (13.287712379549449f / 32.f));
        const double turns = (double)((float)pos * inv) * 0.15915494309189535;
        const float fr = (float)(turns - floor(turns));
        f32x2 cs; cs.x = __builtin_amdgcn_cosf(fr); cs.y = __builtin_amdgcn_sinf(fr); rope[e] = cs; }
}
template <bool XB16> __device__ __forceinline__ void normmod_phase(Frame& F, const void* xp, const void* xs, const float* nw, const float* mod) {
    const int gw = blockIdx.x * NWAVES + F.wave, NGW = F.G * NWAVES; bf16* H = WSP(bf16, WS_H);
    f32x4 w4[4];
#pragma unroll
    for (int j = 0; j < 4; ++j) w4[j] = *(const f32x4*)(nw + 4 * F.lane + 256 * j);
    for (int r = gw; r < MR; r += NGW) {
        const size_t xo = (r < TP) ? (size_t)r * DM : (size_t)(r - TP) * DM; const void* xb = (r < TP) ? xp : xs; const float* mr = mod + (size_t)mod_row(r) * 3072;
        f32x4 v[4], sh[4], scl[4]; float s = 0.f;
#pragma unroll
        for (int j = 0; j < 4; ++j) { const int c = 4 * F.lane + 256 * j;
            if (XB16) { const v2u w = *(const v2u*)((const bf16*)xb + xo + c); v[j] = (f32x4){bf2f(w.x & 0xffffu), __uint_as_float(w.x & 0xffff0000u), bf2f(w.y & 0xffffu), __uint_as_float(w.y & 0xffff0000u)}; }
            else v[j] = *(const f32x4*)((const float*)xb + xo + c);
            sh[j] = *(const f32x4*)(mr + c); scl[j] = *(const f32x4*)(mr + 1024 + c); }
#pragma unroll
        for (int j = 0; j < 4; ++j) s += (v[j].x * v[j].x + v[j].y * v[j].y) + (v[j].z * v[j].z + v[j].w * v[j].w);
        const float rstd = rsqrtf(wave_sum(s) * (1.f / DM) + EPS);
#pragma unroll
        for (int j = 0; j < 4; ++j) { const int c = 4 * F.lane + 256 * j; const f32x4 w = w4[j];
            const float a = v[j].x * rstd * w.x * (1.f + scl[j].x) + sh[j].x, b = v[j].y * rstd * w.y * (1.f + scl[j].y) + sh[j].y, cc = v[j].z * rstd * w.z * (1.f + scl[j].z) + sh[j].z, d = v[j].w * rstd * w.w * (1.f + scl[j].w) + sh[j].w;
            v2u o; o.x = pk2(a, b); o.y = pk2(cc, d); *(v2u*)(H + (size_t)r * DM + c) = o; }
    }
}
struct EpiL0 {
    static constexpr bool PERM = true, AFTER_DRAIN = false;
    bf16* Z; float* out; const float* qw; const float* kw; const f32x2* rope; float* kmean; float* xs;
    __device__ __forceinline__ void store8(bf16* p, const float* f) const { v4u w; w.x = pg8::cvt_pk_bf16(f[0], f[1]); w.y = pg8::cvt_pk_bf16(f[2], f[3]); w.z = pg8::cvt_pk_bf16(f[4], f[5]); w.w = pg8::cvt_pk_bf16(f[6], f[7]); *(v4u*)p = w; }
    __device__ __forceinline__ void operator()(const pg8::f32x4 (&acc)[2][2][4][2], const pg8::Unit& u, int wr_, int wc_, int fr_, int fq_) const {
        int tz_ = threadIdx.x; asm volatile("" : "+v"(tz_));
        const int fr = tz_ & 15, fq = (tz_ & 63) >> 4, wid_ = __builtin_amdgcn_readfirstlane(tz_ >> 6), wr = wid_ >> 2, wc = wid_ & 3; (void)wr_; (void)wc_; (void)fr_; (void)fq_;
        const int pn = u.pn, rl0 = wr * 64 + fr, cw = wc * 32 + 8 * fq, col0 = pn * 256 + cw;
        if (pn < 4) {
            const bool isk = pn >= 2; const float* nw = isk ? kw : qw; const int ch = cw & 63;
            float w8[8];
#pragma unroll
            for (int j = 0; j < 8; ++j) w8[j] = nw[ch + j];
#pragma unroll
            for (int ai = 0; ai < 2; ++ai)
#pragma unroll
                for (int bj = 0; bj < 2; ++bj)
#pragma unroll
                    for (int m = 0; m < 4; ++m) { const pg8::f32x4 v0 = acc[ai][bj][m][0], v1 = acc[ai][bj][m][1];
                        float s = (v0[0] * v0[0] + v0[1] * v0[1]) + (v0[2] * v0[2] + v0[3] * v0[3]) + (v1[0] * v1[0] + v1[1] * v1[1]) + (v1[2] * v1[2] + v1[3] * v1[3]);
                        s += __shfl_xor(s, 16); s += __shfl_xor(s, 32);
                        if (fq == 0) xs[(ai * 128 + rl0 + m * 16) * 8 + bj * 4 + wc] = s; }
            asm volatile("s_waitcnt lgkmcnt(0)" ::: "memory"); __builtin_amdgcn_s_barrier(); asm volatile("" ::: "memory");
            float cs[2][8];
#pragma unroll
            for (int bj = 0; bj < 2; ++bj)
#pragma unroll
                for (int j = 0; j < 8; ++j) cs[bj][j] = 0.f;
#pragma unroll
            for (int ai = 0; ai < 2; ++ai)
#pragma unroll
                for (int m = 0; m < 4; ++m) { const int rl = ai * 128 + rl0 + m * 16, row = u.pm * 256 + rl;
#pragma unroll
                    for (int bj = 0; bj < 2; ++bj) { const float tot = xs[rl * 8 + bj * 4 + wc] + xs[rl * 8 + bj * 4 + (wc ^ 1)];
                        float rs = rsqrtf(tot * (1.f / 64.f) + EPS); if (!isk && row < TP) rs *= attn_body::C2;
                        const pg8::f32x4 v0 = acc[ai][bj][m][0], v1 = acc[ai][bj][m][1];
                        float f[8] = {v0[0] * rs * w8[0], v0[1] * rs * w8[1], v0[2] * rs * w8[2], v0[3] * rs * w8[3], v1[0] * rs * w8[4], v1[1] * rs * w8[5], v1[2] * rs * w8[6], v1[3] * rs * w8[7]};
                        store8(Z + (size_t)row * NE + col0 + bj * 128, f);
                        if (isk) { float* ko = ((row < TP) ? out + O_KP + (size_t)row * 512 : out + O_KS + (size_t)(row - TP) * 512) + (pn - 2) * 256 + bj * 128 + cw;
                            *(f32x4*)(ko) = (f32x4){f[0], f[1], f[2], f[3]}; *(f32x4*)((ko + 4)) = (f32x4){f[4], f[5], f[6], f[7]};
#pragma unroll
                            for (int j = 0; j < 8; ++j) cs[bj][j] += f[j]; } } }
            if (isk && u.pm < TP / 256) { float* ks = xs + 2048;
#pragma unroll
                for (int bj = 0; bj < 2; ++bj)
#pragma unroll
                    for (int j = 0; j < 8; ++j) { float v = cs[bj][j]; v += __shfl_xor(v, 1); v += __shfl_xor(v, 2); v += __shfl_xor(v, 4); v += __shfl_xor(v, 8); cs[bj][j] = v;
                        if (wr == 1 && fr == 0) ks[bj * 128 + cw + j] = v; }
                asm volatile("s_waitcnt lgkmcnt(0)" ::: "memory"); __builtin_amdgcn_s_barrier(); asm volatile("" ::: "memory");
                if (wr == 0 && fr == 0) {
#pragma unroll
                    for (int bj = 0; bj < 2; ++bj)
#pragma unroll
                        for (int j = 0; j < 8; ++j) kmean[(size_t)u.pm * 512 + (pn - 2) * 256 + bj * 128 + cw + j] = (cs[bj][j] + ks[bj * 128 + cw + j]) * (1.f / 256.f); } }
        } else if (pn == 8 || pn == 9) {
            const float sc = (pn == 9) ? 0.125f : 1.f; const int i0 = (cw & 63) >> 1;
#pragma unroll
            for (int ai = 0; ai < 2; ++ai)
#pragma unroll
                for (int m = 0; m < 4; ++m) { const int row = u.pm * 256 + ai * 128 + rl0 + m * 16; const f32x2* rp = rope + pos_of(row) * 32 + i0;
                    const f32x4 r01 = *(const f32x4*)rp, r23 = *(const f32x4*)(rp + 2);
#pragma unroll
                    for (int bj = 0; bj < 2; ++bj) { const pg8::f32x4 v0 = acc[ai][bj][m][0], v1 = acc[ai][bj][m][1];
                        float f[8] = {(v0[0] * r01.x - v0[1] * r01.y) * sc, (v0[0] * r01.y + v0[1] * r01.x) * sc, (v0[2] * r01.z - v0[3] * r01.w) * sc, (v0[2] * r01.w + v0[3] * r01.z) * sc,
                                      (v1[0] * r23.x - v1[1] * r23.y) * sc, (v1[0] * r23.y + v1[1] * r23.x) * sc, (v1[2] * r23.z - v1[3] * r23.w) * sc, (v1[2] * r23.w + v1[3] * r23.z) * sc};
                        store8(Z + (size_t)row * NE + col0 + bj * 128, f); } }
        } else {
            const bool act = (pn == 6 || pn == 7 || pn >= 12), isv = (pn == 4 || pn == 5);
#pragma unroll
            for (int ai = 0; ai < 2; ++ai)
#pragma unroll
                for (int m = 0; m < 4; ++m) { const int row = u.pm * 256 + ai * 128 + rl0 + m * 16;
#pragma unroll
                    for (int bj = 0; bj < 2; ++bj) { const pg8::f32x4 v0 = acc[ai][bj][m][0], v1 = acc[ai][bj][m][1];
                        float f[8] = {v0[0], v0[1], v0[2], v0[3], v1[0], v1[1], v1[2], v1[3]};
                        if (act) {
#pragma unroll
                            for (int j = 0; j < 8; ++j) f[j] = silu_f(f[j]); }
                        store8(Z + (size_t)row * NE + col0 + bj * 128, f);
                        if (isv) { float* vo = ((row < TP) ? out + O_VP + (size_t)row * 512 : out + O_VS + (size_t)(row - TP) * 512) + (pn - 4) * 256 + bj * 128 + cw;
                            *(f32x4*)(vo) = (f32x4){f[0], f[1], f[2], f[3]}; *(f32x4*)((vo + 4)) = (f32x4){f[4], f[5], f[6], f[7]}; } } }
        }
    }
};
__device__ __forceinline__ float ret_log2g(int h) { return log2f(1.f - exp2f(-5.f - (float)h)); }
__device__ __forceinline__ void smp_pass1_item(Frame& F, int item) {
    const int n = item & 7, b = item >> 3; const bf16* Z = WSP(bf16, WS_Z); const float* ck = INP(2); const int* pt = (const int*)INP(7);
    float* scs = (float*)F.lds;
    float* red = scs + 32 * 256;
    int tz_ = threadIdx.x; asm volatile("" : "+v"(tz_));
    const int tid_ = tz_, lane = tz_ & 63, wave_ = __builtin_amdgcn_readfirstlane(tz_ >> 6), c4 = lane * 4;
    float q[4][8];
#pragma unroll
    for (int t = 0; t < 4; ++t) { const bf16* qr = Z + (size_t)(TP + b * 4 + t) * NE + ZQA + c4; const uint2 lo = *(const uint2*)qr, hi = *(const uint2*)(qr + 256);
        q[t][0] = __uint_as_float(lo.x << 16); q[t][1] = __uint_as_float(lo.x & 0xffff0000u); q[t][2] = __uint_as_float(lo.y << 16); q[t][3] = __uint_as_float(lo.y & 0xffff0000u);
        q[t][4] = __uint_as_float(hi.x << 16); q[t][5] = __uint_as_float(hi.x & 0xffff0000u); q[t][6] = __uint_as_float(hi.y << 16); q[t][7] = __uint_as_float(hi.y & 0xffff0000u); }
    float ks[8];
#pragma unroll
    for (int i = 0; i < 8; ++i) ks[i] = 0.f;
    const int pg0 = pt[b * NPAGES + 2 * n], pg1 = pt[b * NPAGES + 2 * n + 1];
    __syncthreads();
    f32x4 ka0[4], kb0[4], ka1[4], kb1[4], ka2[4], kb2[4];
    const __amdgpu_buffer_rsrc_t krs = __builtin_amdgcn_make_buffer_rsrc((void*)ck, (short)0, (int)((size_t)NPHYS * PAGE * 512 * 4), 0x00020000);
    const int kvo = lane * 16, pgu0 = __builtin_amdgcn_readfirstlane(pg0), pgu1 = __builtin_amdgcn_readfirstlane(pg1);
#define P1_LOAD(KA, KB, bt) do { const int so_ = ((((bt) < 4) ? pgu0 : pgu1) * PAGE + wave_ + 32 * ((bt) & 3)) * 2048; \
        _Pragma("unroll") for (int u = 0; u < 4; ++u) { KA[u] = __builtin_bit_cast(f32x4, __builtin_amdgcn_raw_buffer_load_b128(krs, kvo, so_ + u * 16384, 2)); \
                                                         KB[u] = __builtin_bit_cast(f32x4, __builtin_amdgcn_raw_buffer_load_b128(krs, kvo + 1024, so_ + u * 16384, 2)); } } while (0)
#define P1_COMP(KA, KB, bt) do { _Pragma("unroll") for (int u = 0; u < 4; ++u) { const int r = wave_ + 8 * (4 * (bt) + u); \
        const float k[8] = {KA[u].x, KA[u].y, KA[u].z, KA[u].w, KB[u].x, KB[u].y, KB[u].z, KB[u].w}; \
        _Pragma("unroll") for (int i = 0; i < 8; ++i) ks[i] += k[i]; \
        _Pragma("unroll") for (int t = 0; t < 4; ++t) { float s0 = (q[t][0] * k[0] + q[t][1] * k[1]) + (q[t][2] * k[2] + q[t][3] * k[3]), s1 = (q[t][4] * k[4] + q[t][5] * k[5]) + (q[t][6] * k[6] + q[t][7] * k[7]); \
            s0 = red16_dpp(s0); s1 = red16_dpp(s1); \
            if ((lane & 15) == 0) { scs[((lane >> 4) * 4 + t) * 256 + r] = s0; scs[((4 + (lane >> 4)) * 4 + t) * 256 + r] = s1; } } } } while (0)
#define P1_SB __builtin_amdgcn_sched_barrier(0)
    P1_LOAD(ka0, kb0, 0); P1_LOAD(ka1, kb1, 1); P1_SB;
#pragma unroll 1
    for (int bt = 0; bt < 6; bt += 3) {
        P1_LOAD(ka2, kb2, bt + 2); P1_SB; P1_COMP(ka0, kb0, bt);     P1_SB;
        P1_LOAD(ka0, kb0, bt + 3); P1_SB; P1_COMP(ka1, kb1, bt + 1); P1_SB;
        P1_LOAD(ka1, kb1, bt + 4); P1_SB; P1_COMP(ka2, kb2, bt + 2); P1_SB;
    }
    P1_COMP(ka0, kb0, 6); P1_SB; P1_COMP(ka1, kb1, 7); P1_SB;
#undef P1_SB
#undef P1_LOAD
#undef P1_COMP
#pragma unroll
    for (int i = 0; i < 8; ++i) red[wave_ * 512 + (i >> 2) * 256 + c4 + (i & 3)] = ks[i];
    __syncthreads();
    { float s = 0.f;
#pragma unroll
      for (int w = 0; w < 8; ++w) s += red[w * 512 + tid_];
      WSP(float, WS_KMS)[(size_t)(b * 8 + n) * 512 + tid_] = s * (1.f / 256.f); }
    float* SC = WSP(float, WS_SC);
    for (int e = tid_; e < 32 * 256; e += NTHR) { const int ht = e >> 8, r = e & 255; SC[((size_t)(b * 8 + (ht >> 2)) * 4 + (ht & 3)) * 2048 + n * 256 + r] = scs[e]; }
}
__device__ __forceinline__ void smp_ret_item(Frame& F, int item) {
    const int h = item & 3, b = item >> 2; const bf16* Z = WSP(bf16, WS_Z); bf16* MIX = WSP(bf16, WS_MIX);
    float* qs = (float*)F.lds;
    float* ks = qs + 256;
    float* vs = ks + 256;
    float* po = vs + 512;
    float* qk = po + 2048;
    float* red = qk + 16;
    const int tid = F.tid, e = tid & 127, dq = tid >> 7; const int rs0 = TP + b * 4; const float lg = ret_log2g(h);
    const float* stp = INP(4) + (size_t)((b * 4 + h) * 64 + dq * 16) * 128 + e; float* nsp = F.out + O_RSS + (size_t)((b * 4 + h) * 64 + dq * 16) * 128 + e;
    float st[16];
#pragma unroll
    for (int dd = 0; dd < 16; ++dd) st[dd] = __builtin_nontemporal_load(stp + dd * 128);
    const float gb = bf2f(Z[(size_t)(rs0 + dq) * NE + ZGB + h * 128 + e]);
    __syncthreads();
    if (tid < 256) { const int i = tid >> 6, d = tid & 63, pd = 2 * (d & 31) + (d >> 5);
        qs[tid] = bf2f(Z[(size_t)(rs0 + i) * NE + ZQB + h * 64 + pd]); ks[tid] = bf2f(Z[(size_t)(rs0 + i) * NE + ZKB + h * 64 + pd]); }
    { const int i = tid >> 7; vs[tid] = bf2f(Z[(size_t)(rs0 + i) * NE + ZVB + h * 128 + e]); }
    __syncthreads();
    if (tid < 16) { const int i = tid >> 2, jj = tid & 3; float s = 0.f; for (int d = 0; d < 64; ++d) s += qs[i * 64 + d] * ks[jj * 64 + d]; qk[tid] = (jj <= i) ? s * exp2f((float)(i - jj) * lg) : 0.f; }
    float pa[4] = {0.f, 0.f, 0.f, 0.f};
    const float g4 = exp2f(4.f * lg), g3 = exp2f(3.f * lg), g2 = exp2f(2.f * lg), g1 = exp2f(lg);
#pragma unroll
    for (int dd = 0; dd < 16; ++dd) { const int d = dq * 16 + dd;
        const float ns = st[dd] * g4 + g3 * ks[d] * vs[e] + g2 * ks[64 + d] * vs[128 + e] + g1 * ks[128 + d] * vs[256 + e] + ks[192 + d] * vs[384 + e];
        __builtin_nontemporal_store(ns, nsp + dd * 128);
#pragma unroll
        for (int i = 0; i < 4; ++i) pa[i] += qs[i * 64 + d] * st[dd]; }
#pragma unroll
    for (int i = 0; i < 4; ++i) po[(dq * 4 + i) * 128 + e] = pa[i];
    __syncthreads();
    { const int i = dq; float inter = po[(0 * 4 + i) * 128 + e] + po[(1 * 4 + i) * 128 + e] + po[(2 * 4 + i) * 128 + e] + po[(3 * 4 + i) * 128 + e];
      inter *= exp2f((float)(i + 1) * lg); float intra = 0.f;
      for (int jj = 0; jj <= i; ++jj) intra += qk[i * 4 + jj] * vs[jj * 128 + e];
      const float ov = intra + inter; const float ss = wave_sum(ov * ov);
      if (F.lane == 0) red[F.wave] = ss;
      __syncthreads();
      const float rstd = rsqrtf((red[2 * i] + red[2 * i + 1]) * (1.f / 128.f) + EPS);
      MIX[(size_t)(rs0 + i) * DM + 512 + h * 128 + e] = (bf16)f2bf(ov * rstd * gb); }
}
__device__ __forceinline__ void ret_scan_phase(Frame& F) {
    const float* S = WSP(float, WS_SLR); bf16* PB = WSP(bf16, WS_PBR);
    for (int idx = blockIdx.x * NTHR + F.tid; idx < 16 * 4096; idx += F.G * NTHR) { const int bh = idx >> 12, e = (idx & 4095) * 2; const float g128 = exp2f(128.f * ret_log2g(bh & 3));
        const float* p = S + (size_t)bh * 32 * 8192 + e; bf16* q = PB + (size_t)bh * 32 * 8192 + e; f32x2 st = (f32x2){0.f, 0.f};
        f32x2 loc[32];
#pragma unroll
        for (int c = 0; c < 32; ++c) loc[c] = *(const f32x2*)(p + (size_t)c * 8192);
#pragma unroll
        for (int c = 0; c < 32; ++c) { *(unsigned*)(q + (size_t)c * 8192) = pk2(st.x, st.y); st = st * g128 + loc[c]; }
        { const int dp = e >> 7, dorig = (dp >> 1) + 32 * (dp & 1); *(f32x2*)(F.out + O_RSP + (size_t)bh * 8192 + dorig * 128 + (e & 127)) = st; } }
}
__device__ __forceinline__ void smp_pass2_item(Frame& F, int item) {
    const int h = item & 7, b = item >> 3; const bf16* Z = WSP(bf16, WS_Z); bf16* MIX = WSP(bf16, WS_MIX); const float* cv = INP(3); const int* pt = (const int*)INP(7);
    float* P = (float*)F.lds;
    float* km = P + 4 * 2056;
    float* qs = km + 512;
    float* gts = qs + 256;
    float* biasT = gts + 32;
    float* red = biasT + 264;
    float* stat = red + 2304;
    unsigned* selm = (unsigned*)(stat + 8);
    int* pgl = (int*)(selm + 8);
    int tz_ = threadIdx.x; asm volatile("" : "+v"(tz_));
    const int tid = tz_, lane_ = tz_ & 63, rs0 = TP + b * 4;
    float scv[16];
    { const float* SC = WSP(float, WS_SC) + (size_t)(b * 8 + h) * 4 * 2048;
#pragma unroll
      for (int k = 0; k < 16; ++k) scv[k] = SC[tid + NTHR * k]; }
    __syncthreads();
    if (tid < 16) pgl[tid] = pt[b * NPAGES + tid];
    { const int n = tid >> 6, d = tid & 63; km[tid] = WSP(float, WS_KMS)[(size_t)(b * 8 + n) * 512 + h * 64 + d]; }
    if (tid < 256) qs[tid] = bf2f(Z[(size_t)(rs0 + (tid >> 6)) * NE + ZQA + h * 64 + (tid & 63)]);
    { const float* rb = INP(10); for (int e = tid; e < 264; e += NTHR) biasT[e] = rb[t5_bucket(e) * 8 + h]; }
    __syncthreads();
    if (tid < 32) { const int t = tid >> 3, n = tid & 7; float s = 0.f; for (int d = 0; d < 64; ++d) s += qs[t * 64 + d] * km[n * 64 + d]; gts[tid] = s; }
    __syncthreads();
    if (tid < 4) { unsigned mk = 0u;
        for (int r = 0; r < 3; ++r) { float best = -3e38f; int bi = 0; for (int n = 0; n < 8; ++n) if (!((mk >> n) & 1u) && gts[tid * 8 + n] > best) { best = gts[tid * 8 + n]; bi = n; } mk |= 1u << bi; }
        selm[tid] = mk; }
    __syncthreads();
    const unsigned un = selm[0] | selm[1] | selm[2] | selm[3]; const int rsub = lane_ >> 4, d4 = (lane_ & 15) * 4;
    f32x4 va[8], vb[8];
    const __amdgpu_buffer_rsrc_t vrs = __builtin_amdgcn_make_buffer_rsrc((void*)cv, (short)0, (int)((size_t)NPHYS * PAGE * 512 * 4), 0x00020000);
    const int vvo = rsub * 2048 + h * 256 + d4 * 4;
#define P2_LOAD(V, n) do { const int pg0_ = __builtin_amdgcn_readfirstlane(pgl[2 * (n)]), pg1_ = __builtin_amdgcn_readfirstlane(pgl[2 * (n) + 1]); \
        _Pragma("unroll") for (int it = 0; it < 8; ++it) { const int so_ = (((it < 4) ? pg0_ : pg1_) * PAGE + (it & 3) * 32 + F.wave * 4) * 2048; \
            V[it] = __builtin_bit_cast(f32x4, __builtin_amdgcn_raw_buffer_load_b128(vrs, vvo, so_, 2)); } } while (0)
    unsigned rem = un; int nA = __ffs(rem) - 1; rem &= rem - 1u; P2_LOAD(va, nA);
#pragma unroll
    for (int k = 0; k < 16; ++k) { const int e = tid + NTHR * k, t = e >> 11, idx = e & 2047, n = idx >> 8; const int dist = PAST + t - idx;
        P[t * 2056 + idx] = ((selm[t] >> n) & 1u) ? scv[k] * 0.125f + biasT[dist > 263 ? 263 : dist] : -1e30f; }
    if (tid < 16) { const int t = tid >> 2, t2 = tid & 3; float s = -1e30f;
        if (t2 <= t) { float a = 0.f; for (int d = 0; d < 64; ++d) a += qs[t * 64 + d] * bf2f(Z[(size_t)(rs0 + t2) * NE + ZKA + h * 64 + d]); s = a * 0.125f + biasT[t - t2]; }
        P[t * 2056 + 2048 + t2] = s; }
    __syncthreads();
    { const int t = F.wave >> 1, hf = F.wave & 1; float mx = -1e30f;
      for (int i = lane_ + 64 * hf; i < 2052; i += 128) mx = fmaxf(mx, P[t * 2056 + i]);
      mx = wave_max(mx); if (lane_ == 0) red[F.wave] = mx;
      __syncthreads();
      const float M = fmaxf(red[2 * t], red[2 * t + 1]); float sm = 0.f;
      for (int i = lane_ + 64 * hf; i < 2052; i += 128) { const float x = P[t * 2056 + i]; const float p = (x > -1e29f) ? __expf(x - M) : 0.f; P[t * 2056 + i] = p; sm += p; }
      sm = wave_sum(sm); if (lane_ == 0) red[8 + F.wave] = sm;
      __syncthreads();
      if (tid < 4) stat[4 + tid] = 1.f / (red[8 + 2 * tid] + red[8 + 2 * tid + 1]); }
    __syncthreads();
    float acc[4][4];
#pragma unroll
    for (int t = 0; t < 4; ++t)
#pragma unroll
        for (int k = 0; k < 4; ++k) acc[t][k] = 0.f;
#define P2_COMP(V, n) do { _Pragma("unroll") for (int it = 0; it < 8; ++it) { const int r = (it * 8 + F.wave) * 4 + rsub; \
        _Pragma("unroll") for (int t = 0; t < 4; ++t) { const float p = P[t * 2056 + (n) * 256 + r]; acc[t][0] += p * V[it].x; acc[t][1] += p * V[it].y; acc[t][2] += p * V[it].z; acc[t][3] += p * V[it].w; } } } while (0)
    f32x4 vc[8];
    int nB = __ffs(rem) - 1; rem &= rem - 1u; P2_LOAD(vb, nB);
    int nC = __ffs(rem) - 1; rem &= rem - 1u; P2_LOAD(vc, nC);
    for (;;) {
        P2_COMP(va, nA); nA = -1; if (rem) { nA = __ffs(rem) - 1; rem &= rem - 1u; P2_LOAD(va, nA); }
        if (nB < 0) break;
        P2_COMP(vb, nB); nB = -1; if (rem) { nB = __ffs(rem) - 1; rem &= rem - 1u; P2_LOAD(vb, nB); }
        if (nC < 0) break;
        P2_COMP(vc, nC); nC = -1; if (rem) { nC = __ffs(rem) - 1; rem &= rem - 1u; P2_LOAD(vc, nC); }
        if (nA < 0) break; }
#undef P2_LOAD
#undef P2_COMP
    if (F.wave == 0 && rsub == 0) { for (int t2 = 0; t2 < 4; ++t2) { float vf[4];
#pragma unroll
            for (int k = 0; k < 4; ++k) vf[k] = bf2f(Z[(size_t)(rs0 + t2) * NE + ZVA + h * 64 + d4 + k]);
#pragma unroll
            for (int t = 0; t < 4; ++t) { const float p = P[t * 2056 + 2048 + t2];
#pragma unroll
                for (int k = 0; k < 4; ++k) acc[t][k] += p * vf[k]; } } }
#pragma unroll
    for (int t = 0; t < 4; ++t)
#pragma unroll
        for (int k = 0; k < 4; ++k) { float v = acc[t][k]; v += __shfl_xor(v, 16); v += __shfl_xor(v, 32); acc[t][k] = v; }
    if (rsub == 0) {
#pragma unroll
        for (int t = 0; t < 4; ++t)
#pragma unroll
            for (int k = 0; k < 4; ++k) red[256 + (F.wave * 4 + t) * 64 + d4 + k] = acc[t][k]; }
    __syncthreads();
    if (tid < 256) { const int t = tid >> 6, d = tid & 63; float s = 0.f;
#pragma unroll
        for (int w = 0; w < 8; ++w) s += red[256 + (w * 4 + t) * 64 + d];
        const float g = bf2f(Z[(size_t)(rs0 + t) * NE + ZGA + h * 64 + d]);
        MIX[(size_t)(rs0 + t) * DM + h * 64 + d] = (bf16)f2bf(s * stat[4 + t] * g); }
}
__device__ __forceinline__ void post1_phase(Frame& F) {
    bf16* Z = WSP(bf16, WS_Z); bf16* XC = WSP(bf16, WS_XC); const float* cw = INP(24); const float* cb = INP(25); const float* scv = INP(6); const float* dtb = INP(26);
    const int gw = blockIdx.x * NWAVES + F.wave, NGW = F.G * NWAVES, lane = F.lane, c8 = lane * 8;
    float wgt[2][4][8], bia[2][8];
#pragma unroll
    for (int hf = 0; hf < 2; ++hf) { const int cc = hf * 512 + c8;
#pragma unroll
        for (int i = 0; i < 8; ++i) { bia[hf][i] = cb[cc + i];
#pragma unroll
            for (int w = 0; w < 4; ++w) wgt[hf][w][i] = cw[w * 1024 + cc + i]; } }
    const float dtbl = (lane < 8) ? dtb[lane] : 0.f;
    auto tap = [&](int r, int w, int cc) -> v4u { const int t = (r < TP) ? (r & (SEQ - 1)) : (r & 3), tt = t - 3 + w;
        if (tt >= 0) return *(const v4u*)(Z + (size_t)(r - 3 + w) * NOP + YXBC + cc);
        if (r >= TP) { const float* sp = scv + (size_t)(((r - TP) >> 2) * 3 + (tt + 3)) * 1024 + cc; const f32x4 a = *(const f32x4*)sp, b = *(const f32x4*)(sp + 4);
            v4u o; o.x = pk2(a.x, a.y); o.y = pk2(a.z, a.w); o.z = pk2(b.x, b.y); o.w = pk2(b.z, b.w); return o; }
        return (v4u){0u, 0u, 0u, 0u}; };
    for (int r0 = gw; r0 < MR; r0 += 2 * NGW) {
        const int r1 = (r0 + NGW < MR) ? r0 + NGW : r0;
        v4u vraw[2], xt[2][2][4]; float dtr[2];
#pragma unroll
        for (int q = 0; q < 2; ++q) { const int r = q ? r1 : r0; vraw[q] = *(const v4u*)(Z + (size_t)r * NOP + YV + c8); dtr[q] = (lane < 8) ? WSP(float, WS_DTRAW)[(size_t)r * 8 + lane] : 0.f;
#pragma unroll
            for (int hf = 0; hf < 2; ++hf)
#pragma unroll
                for (int w = 0; w < 4; ++w) xt[q][hf][w] = tap(r, w, hf * 512 + c8); }
#pragma unroll
        for (int q = 0; q < 2; ++q) { const int r = q ? r1 : r0; bf16* zr = Z + (size_t)r * NOP; float f[8];
            unpack8(vraw[q], f); float s = 0.f;
#pragma unroll
            for (int i = 0; i < 8; ++i) { f[i] = gelu_f(f[i]); s += f[i]; }
            const float mu = wave_sum(s) * (1.f / 512.f); float s2 = 0.f;
#pragma unroll
            for (int i = 0; i < 8; ++i) { f[i] -= mu; s2 += f[i] * f[i]; }
            const float rstd = rsqrtf(wave_sum(s2) * (1.f / 512.f) + EPS);
#pragma unroll
            for (int i = 0; i < 8; ++i) f[i] *= rstd;
            *(v4u*)(zr + YV + c8) = pack8(f);
            if (r >= TP) { float* o = F.out + O_SGV + (size_t)(r - TP) * 512 + c8; *(f32x4*)o = (f32x4){f[0], f[1], f[2], f[3]}; *(f32x4*)(o + 4) = (f32x4){f[4], f[5], f[6], f[7]}; }
            const int t = (r < TP) ? (r & (SEQ - 1)) : (r & 3); const int bs = (r - TP) >> 2;
#pragma unroll
            for (int hf = 0; hf < 2; ++hf) { const int cc = hf * 512 + c8; float a[8], x[8];
#pragma unroll
                for (int i = 0; i < 8; ++i) a[i] = bia[hf][i];
#pragma unroll
                for (int w = 0; w < 4; ++w) { unpack8(xt[q][hf][w], x);
#pragma unroll
                    for (int i = 0; i < 8; ++i) a[i] += x[i] * wgt[hf][w][i]; }
#pragma unroll
                for (int i = 0; i < 8; ++i) a[i] = silu_f(a[i]);
                *(v4u*)(XC + (size_t)r * 1024 + cc) = pack8(a);
                float* so = nullptr;
                if (r < TP) { if (t >= SEQ - 3) so = F.out + O_CSP + (size_t)((r >> 12) * 3 + (t - (SEQ - 3))) * 1024 + cc; }
                else if (t >= 1) so = F.out + O_CSS + (size_t)(bs * 3 + (t - 1)) * 1024 + cc;
                if (so) { *(f32x4*)so = (f32x4){x[0], x[1], x[2], x[3]}; *(f32x4*)(so + 4) = (f32x4){x[4], x[5], x[6], x[7]}; } }
            if (lane < 8) WSP(float, WS_DTH)[(size_t)r * 8 + lane] = softplus_f(dtr[q] + dtbl);
        }
    }
}
__device__ __forceinline__ void smp_l1_item(Frame& F, int item) {
    const int g = item & 1, b = item >> 1; const bf16* Z = WSP(bf16, WS_Z); const bf16* XC = WSP(bf16, WS_XC); bf16* MIX = WSP(bf16, WS_MIX); const float* DTH = WSP(float, WS_DTH);
    float* st = (float*)F.lds;
    float* xs = st + 64 * 129;
    float* bsm = xs + 1024;
    float* csm = bsm + 512;
    float* ygs = csm + 512;
    float* yp = ygs + 1024;
    float* cum = yp + 512;
    float* dts = cum + 16;
    float* cbs = dts + 16;
    const int tid = F.tid, rs0 = TP + b * 4;
    const float* sgw = INP(22); const float* sgb = INP(23); const float* alog = INP(27); const float* ssm_in = INP(5); const float* Dp = INP(28); const float* nw = INP(29);
    f32x4 sreg[4];
#pragma unroll
    for (int k = 0; k < 4; ++k) sreg[k] = __builtin_nontemporal_load((const f32x4*)(ssm_in + (size_t)(b * 8 + g * 4) * 8192 + tid * 4 + 2048 * k));
    __syncthreads();
    if (tid < 256) { const int col = g * 256 + tid, gc = col >> 7; float vn[4];
#pragma unroll
        for (int i = 0; i < 4; ++i) vn[i] = bf2f(Z[(size_t)(rs0 + i) * NOP + YV + col]);
#pragma unroll
        for (int i = 0; i < 4; ++i) { float a = sgb[gc * 128 + i];
#pragma unroll
            for (int jj = 0; jj < 4; ++jj) if (jj <= i) a += sgw[(size_t)gc * 16384 + i * 128 + jj] * vn[jj];
            const size_t zo = (size_t)(rs0 + i) * NOP + col;
            MIX[(size_t)(rs0 + i) * DM + col] = (bf16)f2bf(gelu_f(bf2f(Z[zo + YU])) * a * silu_f(bf2f(Z[zo + YGC]))); } }
    for (int e = tid; e < 1024; e += NTHR) { const int i = e >> 8, cc = e & 255; xs[e] = bf2f(XC[(size_t)(rs0 + i) * 1024 + g * 256 + cc]); }
    { const int i = tid >> 7, n = tid & 127; bsm[tid] = bf2f(XC[(size_t)(rs0 + i) * 1024 + 512 + g * 128 + n]); csm[tid] = bf2f(XC[(size_t)(rs0 + i) * 1024 + 768 + g * 128 + n]); }
    if (tid < 16) dts[tid] = DTH[(size_t)(rs0 + (tid >> 2)) * 8 + g * 4 + (tid & 3)];
    __syncthreads();
    if (tid < 4) { const float A = -__expf(alog[g * 4 + tid]); float s = 0.f; for (int i = 0; i < 4; ++i) { s += dts[i * 4 + tid] * A; cum[i * 4 + tid] = s; } }
    if (tid >= 64 && tid < 80) { const int i = (tid - 64) >> 2, jj = (tid - 64) & 3; float s = 0.f; for (int n = 0; n < 128; ++n) s += csm[i * 128 + n] * bsm[jj * 128 + n]; cbs[i * 4 + jj] = s; }
    __syncthreads();
    for (int hq = 0; hq < 4; ++hq) { const int h = g * 4 + hq; const float* sp = ssm_in + (size_t)(b * 8 + h) * 8192; float* so = F.out + O_SSS + (size_t)(b * 8 + h) * 8192;
#pragma unroll
        for (int k = 0; k < 4; ++k) { const int e = tid * 4 + 2048 * k; float* sd = st + (e >> 7) * 129 + (e & 127); sd[0] = sreg[k].x; sd[1] = sreg[k].y; sd[2] = sreg[k].z; sd[3] = sreg[k].w; }
        __syncthreads();
        if (hq < 3) {
#pragma unroll
            for (int k = 0; k < 4; ++k) sreg[k] = __builtin_nontemporal_load((const f32x4*)(sp + 8192 + tid * 4 + 2048 * k)); }
        const float c0 = cum[0 * 4 + hq], c1 = cum[1 * 4 + hq], c2 = cum[2 * 4 + hq], c3 = cum[3 * 4 + hq];
        { const int n = tid & 127, pq = tid >> 7; const float e3 = __expf(c3);
          const float w0 = __expf(c3 - c0) * dts[0 * 4 + hq] * bsm[n], w1 = __expf(c3 - c1) * dts[1 * 4 + hq] * bsm[128 + n], w2 = __expf(c3 - c2) * dts[2 * 4 + hq] * bsm[256 + n], w3 = dts[3 * 4 + hq] * bsm[384 + n];
#pragma unroll 4
          for (int pp = 0; pp < 16; ++pp) { const int p = pq * 16 + pp;
              __builtin_nontemporal_store(st[p * 129 + n] * e3 + w0 * xs[hq * 64 + p] + w1 * xs[256 + hq * 64 + p] + w2 * xs[512 + hq * 64 + p] + w3 * xs[768 + hq * 64 + p], so + p * 128 + n); } }
        { const int p = tid & 63, i = (tid >> 6) & 3, nh = tid >> 8; float s = 0.f;
          for (int n = nh * 64; n < nh * 64 + 64; ++n) s += csm[i * 128 + n] * st[p * 129 + n];
          yp[(nh * 4 + i) * 64 + p] = s; }
        __syncthreads();
        if (tid < 256) { const int p = tid & 63, i = tid >> 6; const float ci = cum[i * 4 + hq]; float y = __expf(ci) * (yp[i * 64 + p] + yp[(4 + i) * 64 + p]);
            for (int jj = 0; jj <= i; ++jj) y += cbs[i * 4 + jj] * __expf(ci - cum[jj * 4 + hq]) * dts[jj * 4 + hq] * xs[jj * 256 + hq * 64 + p];
            y += Dp[h] * xs[i * 256 + hq * 64 + p];
            ygs[i * 256 + hq * 64 + p] = y * silu_f(bf2f(Z[(size_t)(rs0 + i) * NOP + YZG + h * 64 + p])); }
        __syncthreads();
    }
    if (tid < 256) { const int i = tid >> 6; float v[4]; float ss = 0.f;
#pragma unroll
        for (int k = 0; k < 4; ++k) { v[k] = ygs[i * 256 + F.lane + 64 * k]; ss += v[k] * v[k]; }
        const float rstd = rsqrtf(wave_sum(ss) * (1.f / 256.f) + EPS);
#pragma unroll
        for (int k = 0; k < 4; ++k) { const int col = g * 256 + F.lane + 64 * k; MIX[(size_t)(rs0 + i) * DM + 512 + col] = (bf16)f2bf(v[k] * rstd * nw[col]); } }
}
__device__ __forceinline__ void ssd_scan_phase(Frame& F) {
    const float* S = WSP(float, WS_SLS); bf16* PB = WSP(bf16, WS_PBS); const float* cdec = WSP(float, WS_CDEC);
    for (int idx = blockIdx.x * NTHR + F.tid; idx < 32 * 4096; idx += F.G * NTHR) { const int bh = idx >> 12, e = (idx & 4095) * 2, b = bh >> 3, h = bh & 7; f32x2 st = (f32x2){0.f, 0.f};
        f32x2 loc[32];
#pragma unroll
        for (int c = 0; c < 32; ++c) loc[c] = *(const f32x2*)(S + (size_t)((b * 32 + c) * 8 + h) * 8192 + e);
#pragma unroll
        for (int c = 0; c < 32; ++c) { const size_t o = (size_t)((b * 32 + c) * 8 + h) * 8192 + e; *(unsigned*)(PB + o) = pk2(st.x, st.y); st = st * cdec[(b * 32 + c) * 8 + h] + loc[c]; }
        *(f32x2*)(F.out + O_SSP + (size_t)bh * 8192 + e) = st; }
}
namespace mm {
typedef short bf16x8 __attribute__((ext_vector_type(8)));
typedef short s16x4 __attribute__((ext_vector_type(4)));
#define MM_LAS __attribute__((address_space(3)))
__device__ __forceinline__ f32x4 mfma16(bf16x8 a, bf16x8 b, f32x4 c) { return __builtin_amdgcn_mfma_f32_16x16x32_bf16(a, b, c, 0, 0, 0); }
__device__ __forceinline__ bf16x8 frag_kc(const bf16* X, int pitch, int r0, int k0, int lane) { return *(const bf16x8*)(X + (r0 + (lane & 15)) * pitch + k0 + 8 * (lane >> 4)); }
__device__ __forceinline__ s16x4 trd(const bf16* p) { return __builtin_bit_cast(s16x4, __builtin_amdgcn_ds_read_tr16_b64_v4i16((MM_LAS s16x4*)p)); }
__device__ __forceinline__ bf16x8 frag_tr(const bf16* Y, int pitch, int ka, int kb, int n0, int lane) {
    const int m = lane & 15; const bf16* pa = Y + (ka + (m >> 2)) * pitch + n0 + 4 * (m & 3); const bf16* pb = Y + (kb + (m >> 2)) * pitch + n0 + 4 * (m & 3);
    const s16x4 lo = trd(pa), hi = trd(pb); return (bf16x8){lo[0], lo[1], lo[2], lo[3], hi[0], hi[1], hi[2], hi[3]};
}
__device__ __forceinline__ bf16x8 frag_tr_std(const bf16* Y, int pitch, int k0, int n0, int lane) { const int g = lane >> 4; return frag_tr(Y, pitch, k0 + 8 * g, k0 + 8 * g + 4, n0, lane); }
__device__ __forceinline__ bf16x8 frag_tr_acc(const bf16* Y, int pitch, int k0, int n0, int lane) { const int g = lane >> 4; return frag_tr(Y, pitch, k0 + 4 * g, k0 + 16 + 4 * g, n0, lane); }
__device__ __forceinline__ bf16x8 pack_acc(const float* l0, const float* l1) { v4u w; w.x = pk2(l0[0], l0[1]); w.y = pk2(l0[2], l0[3]); w.z = pk2(l1[0], l1[1]); w.w = pk2(l1[2], l1[3]); return __builtin_bit_cast(bf16x8, w); }
}

template <bool SSD> __device__ __forceinline__ void kv_local_item(Frame& F, int item) {
    bf16* As = (bf16*)F.lds;
    bf16* Bs = As + 128 * 72;
    float* wj = (float*)(Bs + 128 * 144);
    float* cum = wj + 128;
    const int tid = F.tid; int b, c, h; float* S;
    if (SSD) { h = item & 7; c = (item >> 3) & 31; b = item >> 8; S = WSP(float, WS_SLS) + (size_t)((b * 32 + c) * 8 + h) * 8192; }
    else { c = item & 31; h = (item >> 5) & 3; b = item >> 7; S = WSP(float, WS_SLR) + (size_t)((b * 4 + h) * 32 + c) * 8192; }
    const int r0 = b * SEQ + c * 128;
    const bf16* srcA = SSD ? WSP(bf16, WS_XC) + (size_t)r0 * 1024 + h * 64 : WSP(bf16, WS_Z) + (size_t)r0 * NE + ZKB + h * 64;
    const bf16* srcB = SSD ? WSP(bf16, WS_XC) + (size_t)r0 * 1024 + 512 + (h >> 2) * 128 : WSP(bf16, WS_Z) + (size_t)r0 * NE + ZVB + h * 128;
    const int pitch = SSD ? 1024 : NE;
    v4u ra[2], rb[4];
#pragma unroll
    for (int k = 0; k < 2; ++k) { const int e = tid + NTHR * k; ra[k] = *(const v4u*)(srcA + (size_t)(e >> 3) * pitch + (e & 7) * 8); }
#pragma unroll
    for (int k = 0; k < 4; ++k) { const int e = tid + NTHR * k; rb[k] = *(const v4u*)(srcB + (size_t)(e >> 4) * pitch + (e & 15) * 8); }
    float dthv = 0.f, Aneg = 0.f;
    if (SSD) { if (tid < 128) dthv = WSP(float, WS_DTH)[(size_t)(r0 + tid) * 8 + h]; Aneg = -__expf(INP(27)[h]); }
    __syncthreads();
    if (SSD) { float* dts = cum + 128;
        if (tid < 128) dts[tid] = dthv;
        __syncthreads();
        if (tid < 64) { const float a0 = dts[2 * tid] * Aneg, a1 = dts[2 * tid + 1] * Aneg; float s = a0 + a1;
#pragma unroll
            for (int o = 1; o < 64; o <<= 1) { const float t = __shfl_up(s, o); if (F.lane >= o) s += t; }
            cum[2 * tid] = s - a1; cum[2 * tid + 1] = s; }
        __syncthreads();
        if (tid < 128) { const float cj = cum[tid], cl = cum[127]; WSP(float, WS_CUM)[(size_t)(r0 + tid) * 8 + h] = cj; wj[tid] = __expf(cl - cj) * dthv;
            if (tid == 0) WSP(float, WS_CDEC)[(b * 32 + c) * 8 + h] = __expf(cl); }
    } else { if (tid < 128) wj[tid] = exp2f((float)(127 - tid) * ret_log2g(h)); }
    __syncthreads();
#pragma unroll
    for (int k = 0; k < 2; ++k) { const int e = tid + NTHR * k, j = e >> 3, cc = (e & 7) * 8; float f[8]; unpack8(ra[k], f); const float w = wj[j];
#pragma unroll
        for (int q = 0; q < 8; ++q) f[q] *= w;
        *(v4u*)(As + j * 72 + cc) = pack8(f); }
#pragma unroll
    for (int k = 0; k < 4; ++k) { const int e = tid + NTHR * k; *(v4u*)(Bs + (e >> 4) * 144 + (e & 15) * 8) = rb[k]; }
    __syncthreads();
    const int lane = F.lane, dt = F.wave & 3, et0 = (F.wave >> 2) * 4;
    f32x4 acc[4];
#pragma unroll
    for (int q = 0; q < 4; ++q) acc[q] = (f32x4){0.f, 0.f, 0.f, 0.f};
#pragma unroll
    for (int ks = 0; ks < 4; ++ks) { const mm::bf16x8 af = mm::frag_tr_std(As, 72, 32 * ks, 16 * dt, lane);
#pragma unroll
        for (int q = 0; q < 4; ++q) acc[q] = mm::mfma16(af, mm::frag_tr_std(Bs, 144, 32 * ks, 16 * (et0 + q), lane), acc[q]); }
    const int gq = lane >> 4, cl = lane & 15;
#pragma unroll
    for (int q = 0; q < 4; ++q)
#pragma unroll
        for (int r = 0; r < 4; ++r) S[(16 * dt + 4 * gq + r) * 128 + 16 * (et0 + q) + cl] = acc[q][r];
}
__device__ __forceinline__ void ret_out_mfma(Frame& F, int item) {
    const int c = item & 31, h = (item >> 5) & 3, b = item >> 7; const bf16* Z = WSP(bf16, WS_Z); bf16* MIX = WSP(bf16, WS_MIX);
    bf16* Qs = (bf16*)F.lds;
    bf16* Ks = Qs + 128 * 72;
    bf16* Vs = Ks + 128 * 72;
    bf16* Ps = Vs + 128 * 144;
    const int tid = F.tid, r0 = b * SEQ + c * 128; const float lg = ret_log2g(h);
    __syncthreads();
    for (int e = tid; e < 128 * 8; e += NTHR) { const int j = e >> 3, cc = (e & 7) * 8; const size_t zo = (size_t)(r0 + j) * NE + h * 64 + cc;
        *(v4u*)(Qs + j * 72 + cc) = *(const v4u*)(Z + zo + ZQB); *(v4u*)(Ks + j * 72 + cc) = *(const v4u*)(Z + zo + ZKB); }
    for (int e = tid; e < 128 * 16; e += NTHR) { const int j = e >> 4, cc = (e & 15) * 8; *(v4u*)(Vs + j * 144 + cc) = *(const v4u*)(Z + (size_t)(r0 + j) * NE + ZVB + h * 128 + cc); }
    { const bf16* Pp = WSP(bf16, WS_PBR) + (size_t)((b * 4 + h) * 32 + c) * 8192;
      for (int e = tid; e < 64 * 16; e += NTHR) { const int d = e >> 4, cc = (e & 15) * 8; *(v4u*)(Ps + d * 144 + cc) = *(const v4u*)(Pp + d * 128 + cc); } }
    __syncthreads();
    v4u gbr[4];
#pragma unroll
    for (int k = 0; k < 4; ++k) { const int e = tid + NTHR * k; gbr[k] = *(const v4u*)(Z + (size_t)(r0 + (e >> 4)) * NE + ZGB + h * 128 + (e & 15) * 8); }
    const int w = F.wave, lane = F.lane, gq = lane >> 4, cl = lane & 15;
    f32x4 sT[8];
#pragma unroll
    for (int a = 0; a < 8; ++a) { sT[a] = (f32x4){0.f, 0.f, 0.f, 0.f};
        if (a <= w) {
#pragma unroll
            for (int ks = 0; ks < 2; ++ks) sT[a] = mm::mfma16(mm::frag_kc(Ks, 72, 16 * a, 32 * ks, lane), mm::frag_kc(Qs, 72, 16 * w, 32 * ks, lane), sT[a]); } }
    f32x4 ain[8], aix[8];
#pragma unroll
    for (int et = 0; et < 8; ++et) { ain[et] = (f32x4){0.f, 0.f, 0.f, 0.f}; aix[et] = (f32x4){0.f, 0.f, 0.f, 0.f}; }
#pragma unroll
    for (int ks = 0; ks < 2; ++ks) { const mm::bf16x8 af = mm::frag_kc(Qs, 72, 16 * w, 32 * ks, lane);
#pragma unroll
        for (int et = 0; et < 8; ++et) ain[et] = mm::mfma16(af, mm::frag_tr_std(Ps, 144, 32 * ks, 16 * et, lane), ain[et]); }
    const int ii = 16 * w + cl;
#pragma unroll
    for (int m = 0; m < 4; ++m) { if (2 * m <= w) { float l0[4], l1[4];
#pragma unroll
            for (int r = 0; r < 4; ++r) { const int j0 = 32 * m + 4 * gq + r, j1 = j0 + 16;
                l0[r] = (j0 <= ii) ? sT[2 * m][r] * exp2f((float)(ii - j0) * lg) : 0.f; l1[r] = (j1 <= ii) ? sT[2 * m + 1][r] * exp2f((float)(ii - j1) * lg) : 0.f; }
            const mm::bf16x8 af = mm::pack_acc(l0, l1);
#pragma unroll
            for (int et = 0; et < 8; ++et) aix[et] = mm::mfma16(af, mm::frag_tr_acc(Vs, 144, 32 * m, 16 * et, lane), aix[et]); } }
    float ssq[4], qd[4];
#pragma unroll
    for (int r = 0; r < 4; ++r) { ssq[r] = 0.f; qd[r] = exp2f((float)(16 * w + 4 * gq + r + 1) * lg); }
#pragma unroll
    for (int et = 0; et < 8; ++et)
#pragma unroll
        for (int r = 0; r < 4; ++r) { const float o = aix[et][r] + qd[r] * ain[et][r]; aix[et][r] = o; ssq[r] += o * o; }
#pragma unroll
    for (int r = 0; r < 4; ++r) { float s = ssq[r]; s += __shfl_xor(s, 1); s += __shfl_xor(s, 2); s += __shfl_xor(s, 4); s += __shfl_xor(s, 8); ssq[r] = rsqrtf(s * (1.f / 128.f) + EPS); }
    __syncthreads();
    bf16* Ot = Vs;
#pragma unroll
    for (int et = 0; et < 8; ++et)
#pragma unroll
        for (int r = 0; r < 4; ++r) Ot[(16 * w + 4 * gq + r) * 144 + 16 * et + cl] = (bf16)f2bf(aix[et][r] * ssq[r]);
    __syncthreads();
#pragma unroll
    for (int k = 0; k < 4; ++k) { const int e = tid + NTHR * k, i = e >> 4, cc = (e & 15) * 8; float o[8], g8[8];
        unpack8(*(const v4u*)(Ot + i * 144 + cc), o); unpack8(gbr[k], g8);
#pragma unroll
        for (int k = 0; k < 8; ++k) o[k] *= g8[k];
        *(v4u*)(MIX + (size_t)(r0 + i) * DM + 512 + h * 128 + cc) = pack8(o); }
}
__device__ __forceinline__ void sgu_mfma(Frame& F, int item) {
    const int g = item & 3, c = (item >> 2) & 31, b = item >> 7; const bf16* Z = WSP(bf16, WS_Z); bf16* MIX = WSP(bf16, WS_MIX);
    bf16* Ws = (bf16*)F.lds;
    bf16* Vs = Ws + 128 * 136;
    const int tid = F.tid, r0 = b * SEQ + c * 128; const float* W = INP(22) + (size_t)g * 16384; const float* sgb = INP(23);
    __syncthreads();
    for (int e = tid; e < 128 * 16; e += NTHR) { const int i = e >> 4, cc = (e & 15) * 8; const f32x4 a = *(const f32x4*)(W + i * 128 + cc), bb = *(const f32x4*)(W + i * 128 + cc + 4);
        float f[8] = {a.x, a.y, a.z, a.w, bb.x, bb.y, bb.z, bb.w};
#pragma unroll
        for (int k = 0; k < 8; ++k) if (cc + k > i) f[k] = 0.f;
        *(v4u*)(Ws + i * 136 + cc) = pack8(f);
        *(v4u*)(Vs + i * 144 + cc) = *(const v4u*)(Z + (size_t)(r0 + i) * NOP + YV + g * 128 + cc); }
    __syncthreads();
    v4u ur[4], gr[4];
#pragma unroll
    for (int k = 0; k < 4; ++k) { const int e = tid + NTHR * k; const size_t zo = (size_t)(r0 + (e >> 4)) * NOP + g * 128 + (e & 15) * 8; ur[k] = *(const v4u*)(Z + zo + YU); gr[k] = *(const v4u*)(Z + zo + YGC); }
    const int w = F.wave, lane = F.lane, gq = lane >> 4, cl = lane & 15;
    float sbv[4];
#pragma unroll
    for (int r = 0; r < 4; ++r) sbv[r] = sgb[g * 128 + 16 * w + 4 * gq + r];
    f32x4 acc[8];
#pragma unroll
    for (int dt = 0; dt < 8; ++dt) acc[dt] = (f32x4){0.f, 0.f, 0.f, 0.f};
#pragma unroll
    for (int ks = 0; ks < 4; ++ks) { if (ks <= (w >> 1)) { const mm::bf16x8 af = mm::frag_kc(Ws, 136, 16 * w, 32 * ks, lane);
#pragma unroll
            for (int dt = 0; dt < 8; ++dt) acc[dt] = mm::mfma16(af, mm::frag_tr_std(Vs, 144, 32 * ks, 16 * dt, lane), acc[dt]); } }
    __syncthreads();
    bf16* St = Ws;
#pragma unroll
    for (int r = 0; r < 4; ++r) { const int i = 16 * w + 4 * gq + r; const float sb = sbv[r];
#pragma unroll
        for (int dt = 0; dt < 8; ++dt) St[i * 136 + 16 * dt + cl] = (bf16)f2bf(acc[dt][r] + sb); }
    __syncthreads();
#pragma unroll
    for (int k = 0; k < 4; ++k) { const int e = tid + NTHR * k, i = e >> 4, cc = (e & 15) * 8; float s8[8], u8[8], g8[8];
        unpack8(*(const v4u*)(St + i * 136 + cc), s8); unpack8(ur[k], u8); unpack8(gr[k], g8);
#pragma unroll
        for (int k = 0; k < 8; ++k) s8[k] = gelu_f(u8[k]) * s8[k] * silu_f(g8[k]);
        *(v4u*)(MIX + (size_t)(r0 + i) * DM + g * 128 + cc) = pack8(s8); }
}
__device__ __forceinline__ void ssd_out_mfma(Frame& F, int item) {
    const int g = item & 1, c = (item >> 1) & 31, b = item >> 6; const bf16* Z = WSP(bf16, WS_Z); const bf16* XC = WSP(bf16, WS_XC); bf16* MIX = WSP(bf16, WS_MIX);
    bf16* Xs = (bf16*)F.lds;
    bf16* Cs = Xs + 128 * 272;
    bf16* Bs = Cs + 128 * 144;
    float* cums = (float*)(Bs + 128 * 144);
    float* dths = cums + 512;
    const int tid = F.tid, r0 = b * SEQ + c * 128; const float* Dp = INP(28); const float* nw = INP(29);
    const f32x4 n0 = *(const f32x4*)(nw + g * 256 + (tid & 31) * 8), n1 = *(const f32x4*)(nw + g * 256 + (tid & 31) * 8 + 4);
    __syncthreads();
    for (int e = tid; e < 128 * 32; e += NTHR) { const int j = e >> 5, cc = (e & 31) * 8; *(v4u*)(Xs + j * 272 + cc) = *(const v4u*)(XC + (size_t)(r0 + j) * 1024 + g * 256 + cc); }
    for (int e = tid; e < 128 * 16; e += NTHR) { const int j = e >> 4, cc = (e & 15) * 8; *(v4u*)(Bs + j * 144 + cc) = *(const v4u*)(XC + (size_t)(r0 + j) * 1024 + 512 + g * 128 + cc);
        *(v4u*)(Cs + j * 144 + cc) = *(const v4u*)(XC + (size_t)(r0 + j) * 1024 + 768 + g * 128 + cc); }
    { const int hq = tid >> 7, j = tid & 127; cums[tid] = WSP(float, WS_CUM)[(size_t)(r0 + j) * 8 + g * 4 + hq]; dths[tid] = WSP(float, WS_DTH)[(size_t)(r0 + j) * 8 + g * 4 + hq]; }
    v4u pra[2];
    { const bf16* Pn = WSP(bf16, WS_PBS) + (size_t)((b * 32 + c) * 8 + g * 4) * 8192;
#pragma unroll
      for (int k = 0; k < 2; ++k) { const int e = tid + NTHR * k, p = e >> 4, cc = (e & 15) * 8; pra[k] = *(const v4u*)(Pn + p * 128 + cc); } }
    __syncthreads();
    const int w = F.wave, lane = F.lane, gq = lane >> 4, cl = lane & 15;
    f32x4 cb[8];
#pragma unroll
    for (int a = 0; a < 8; ++a) { cb[a] = (f32x4){0.f, 0.f, 0.f, 0.f};
        if (a <= w) {
#pragma unroll
            for (int ks = 0; ks < 4; ++ks) cb[a] = mm::mfma16(mm::frag_kc(Bs, 144, 16 * a, 32 * ks, lane), mm::frag_kc(Cs, 144, 16 * w, 32 * ks, lane), cb[a]); } }
    __syncthreads();
    bf16* Ps = Bs;
    float* ssqs = dths + 512;
    if (tid < 128) ssqs[tid] = 0.f;
    const int ii = 16 * w + cl;
#pragma unroll 1
    for (int hq = 0; hq < 4; ++hq) { const int h = g * 4 + hq;
#pragma unroll
        for (int k = 0; k < 2; ++k) { const int e = tid + NTHR * k, p = e >> 4, cc = (e & 15) * 8; *(v4u*)(Ps + p * 144 + cc) = pra[k]; }
        __syncthreads();
        if (hq < 3) { const bf16* Pn = WSP(bf16, WS_PBS) + (size_t)((b * 32 + c) * 8 + h + 1) * 8192;
#pragma unroll
            for (int k = 0; k < 2; ++k) { const int e = tid + NTHR * k, p = e >> 4, cc = (e & 15) * 8; pra[k] = *(const v4u*)(Pn + p * 128 + cc); } }
        v4u zgr[2];
#pragma unroll
        for (int k = 0; k < 2; ++k) { const int e = tid + NTHR * k, i = e >> 3, cc = (e & 7) * 8; zgr[k] = *(const v4u*)(Z + (size_t)(r0 + i) * NOP + YZG + h * 64 + cc); }
        f32x4 ain[4], aix[4];
#pragma unroll
        for (int pt = 0; pt < 4; ++pt) { ain[pt] = (f32x4){0.f, 0.f, 0.f, 0.f}; aix[pt] = (f32x4){0.f, 0.f, 0.f, 0.f}; }
#pragma unroll
        for (int ks = 0; ks < 4; ++ks) { const mm::bf16x8 af = mm::frag_kc(Cs, 144, 16 * w, 32 * ks, lane);
#pragma unroll
            for (int pt = 0; pt < 4; ++pt) ain[pt] = mm::mfma16(af, mm::frag_kc(Ps, 144, 16 * pt, 32 * ks, lane), ain[pt]); }
        const float ci = cums[hq * 128 + ii];
#pragma unroll
        for (int m = 0; m < 4; ++m) { if (2 * m <= w) { float l0[4], l1[4];
#pragma unroll
                for (int r = 0; r < 4; ++r) { const int j0 = 32 * m + 4 * gq + r, j1 = j0 + 16;
                    l0[r] = (j0 <= ii) ? cb[2 * m][r] * __expf(ci - cums[hq * 128 + j0]) * dths[hq * 128 + j0] : 0.f;
                    l1[r] = (j1 <= ii) ? cb[2 * m + 1][r] * __expf(ci - cums[hq * 128 + j1]) * dths[hq * 128 + j1] : 0.f; }
                const mm::bf16x8 af = mm::pack_acc(l0, l1);
#pragma unroll
                for (int pt = 0; pt < 4; ++pt) aix[pt] = mm::mfma16(af, mm::frag_tr_acc(Xs, 272, 32 * m, hq * 64 + 16 * pt, lane), aix[pt]); } }
        const float Dh = Dp[h];
        bf16* Yt = Bs + 64 * 144;
#pragma unroll
        for (int r = 0; r < 4; ++r) { const int i = 16 * w + 4 * gq + r; const float ei = __expf(cums[hq * 128 + i]);
#pragma unroll
            for (int pt = 0; pt < 4; ++pt) Yt[i * 72 + 16 * pt + cl] = (bf16)f2bf(aix[pt][r] + ei * ain[pt][r]); }
        __syncthreads();
#pragma unroll
        for (int k = 0; k < 2; ++k) { const int e = tid + NTHR * k, i = e >> 3, cc = (e & 7) * 8; float y8[8], x8[8], z8[8];
            unpack8(*(const v4u*)(Yt + i * 72 + cc), y8); unpack8(*(const v4u*)(Xs + i * 272 + hq * 64 + cc), x8); unpack8(zgr[k], z8);
            float s = 0.f;
#pragma unroll
            for (int k = 0; k < 8; ++k) { y8[k] = (y8[k] + Dh * x8[k]) * silu_f(z8[k]); s += y8[k] * y8[k]; }
            s = red8_dpp(s); if ((e & 7) == 0) ssqs[i] += s;
            *(v4u*)(Xs + i * 272 + hq * 64 + cc) = pack8(y8); }
        __syncthreads();
    }
    for (int e = tid; e < 128 * 32; e += NTHR) { const int i = e >> 5, cc = (e & 31) * 8; const float rstd = rsqrtf(ssqs[i] * (1.f / 256.f) + EPS); float v8[8]; unpack8(*(const v4u*)(Xs + i * 272 + cc), v8);
        v8[0] *= rstd * n0.x; v8[1] *= rstd * n0.y; v8[2] *= rstd * n0.z; v8[3] *= rstd * n0.w; v8[4] *= rstd * n1.x; v8[5] *= rstd * n1.y; v8[6] *= rstd * n1.z; v8[7] *= rstd * n1.w;
        *(v4u*)(MIX + (size_t)(r0 + i) * DM + 512 + g * 256 + cc) = pack8(v8); }
}
__device__ __forceinline__ void mod_item_mfma(Frame& F, int item) {
    const int l = item / 48, nb = item % 48;
    const float* We = INP(12); const float* Wo = INP(19); const float* be = INP(13); const float* bo = INP(20); const float* cpp = INP(8); const float* csp = INP(9);
    const float* W = (l ? Wo : We) + nb * 64; const float* bias = (l ? bo : be) + nb * 64; float* mod = WSP(float, l ? WS_MODO : WS_MODE) + nb * 64;
    bf16* As = (bf16*)F.lds;
    bf16* Ws = As + 144 * 136;
    const int tid = F.tid, lane = F.lane, w = F.wave, nt = w & 3, m0 = w >> 2, gq = lane >> 4, cl = lane & 15;
    f32x4 acc[5];
#pragma unroll
    for (int q = 0; q < 5; ++q) acc[q] = (f32x4){0.f, 0.f, 0.f, 0.f};
    f32x4 ca[5], cbv[5], wa[2], wb[2];
#define MOD_LOAD(k0) do { _Pragma("unroll") for (int k = 0; k < 5; ++k) { const int e = tid + NTHR * k, m = e >> 4, cc = (e & 15) * 8; ca[k] = (f32x4){0.f, 0.f, 0.f, 0.f}; cbv[k] = ca[k]; \
            if (e < 144 * 16 && m < 132) { const float* cr = (m < 4) ? cpp + (size_t)m * DM : csp + (size_t)(m - 4) * DM; ca[k] = *(const f32x4*)(cr + (k0) + cc); cbv[k] = *(const f32x4*)(cr + (k0) + cc + 4); } } \
        _Pragma("unroll") for (int k = 0; k < 2; ++k) { const int e = tid + NTHR * k, kk = e >> 3, cc = (e & 7) * 8; wa[k] = *(const f32x4*)(W + (size_t)((k0) + kk) * 3072 + cc); wb[k] = *(const f32x4*)(W + (size_t)((k0) + kk) * 3072 + cc + 4); } } while (0)
    MOD_LOAD(0);
    for (int k0 = 0; k0 < DM; k0 += 128) {
        __syncthreads();
#pragma unroll
        for (int k = 0; k < 5; ++k) { const int e = tid + NTHR * k, m = e >> 4, cc = (e & 15) * 8;
            if (e < 144 * 16) { float f[8] = {silu_f(ca[k].x), silu_f(ca[k].y), silu_f(ca[k].z), silu_f(ca[k].w), silu_f(cbv[k].x), silu_f(cbv[k].y), silu_f(cbv[k].z), silu_f(cbv[k].w)};
                *(v4u*)(As + m * 136 + cc) = pack8(f); } }
#pragma unroll
        for (int k = 0; k < 2; ++k) { const int e = tid + NTHR * k, kk = e >> 3, cc = (e & 7) * 8; v4u wv; wv.x = pk2(wa[k].x, wa[k].y); wv.y = pk2(wa[k].z, wa[k].w); wv.z = pk2(wb[k].x, wb[k].y); wv.w = pk2(wb[k].z, wb[k].w);
            *(v4u*)(Ws + kk * 72 + cc) = wv; }
        __syncthreads();
        if (k0 + 128 < DM) MOD_LOAD(k0 + 128);
#pragma unroll
        for (int ks = 0; ks < 4; ++ks) { const mm::bf16x8 bfr = mm::frag_tr_std(Ws, 72, 32 * ks, 16 * nt, lane);
#pragma unroll
            for (int q = 0; q < 5; ++q) { const int mt = m0 + 2 * q; if (mt < 9) acc[q] = mm::mfma16(mm::frag_kc(As, 136, 16 * mt, 32 * ks, lane), bfr, acc[q]); } }
    }
#undef MOD_LOAD
    const float bn = bias[16 * nt + cl];
#pragma unroll
    for (int q = 0; q < 5; ++q) { const int mt = m0 + 2 * q;
#pragma unroll
        for (int r = 0; r < 4; ++r) { const int m = 16 * mt + 4 * gq + r; if (mt < 9 && m < 132) mod[(size_t)m * 3072 + 16 * nt + cl] = acc[q][r] + bn; } }
    __syncthreads();
}

template <bool XB16, bool OB16> __device__ __forceinline__ void smp_outproj_item(Frame& F, int item, const bf16* Wt, const void* xsrc, const float* mod, void* out) {
    const int rt = item >> 4, ct = item & 15, row0 = TP + rt * 32, col0 = ct * 64; const bf16* MIX = WSP(bf16, WS_MIX);
    bf16* As = (bf16*)F.lds;
    bf16* Bs = As + 32 * 264;
    const int tid = F.tid, lane = F.lane, w = F.wave, mt = w >> 2, nt = w & 3, gq = lane >> 4, cl = lane & 15;
    f32x4 acc = (f32x4){0.f, 0.f, 0.f, 0.f};
    v4u pa[2], pb[4];
#define SO_LOAD(k0) do { _Pragma("unroll") for (int k = 0; k < 2; ++k) { const int e = tid + NTHR * k; pa[k] = *(const v4u*)(MIX + (size_t)(row0 + (e >> 5)) * DM + (k0) + (e & 31) * 8); } \
        _Pragma("unroll") for (int k = 0; k < 4; ++k) { const int e = tid + NTHR * k; pb[k] = *(const v4u*)(Wt + (size_t)(col0 + (e >> 5)) * DM + (k0) + (e & 31) * 8); } } while (0)
    SO_LOAD(0);
    float xv4[4], gm4[4];
#pragma unroll
    for (int r = 0; r < 4; ++r) { const int rr = row0 + 16 * mt + 4 * gq + r, cc = col0 + 16 * nt + cl; const size_t o = (size_t)(rr - TP) * DM + cc;
        xv4[r] = XB16 ? bf2f(((const bf16*)xsrc)[o]) : ((const float*)xsrc)[o]; gm4[r] = mod[(size_t)mod_row(rr) * 3072 + 2048 + cc]; }
    for (int k0 = 0; k0 < DM; k0 += 256) {
        __syncthreads();
#pragma unroll
        for (int k = 0; k < 2; ++k) { const int e = tid + NTHR * k; *(v4u*)(As + (e >> 5) * 264 + (e & 31) * 8) = pa[k]; }
#pragma unroll
        for (int k = 0; k < 4; ++k) { const int e = tid + NTHR * k; *(v4u*)(Bs + (e >> 5) * 264 + (e & 31) * 8) = pb[k]; }
        __syncthreads();
        if (k0 + 256 < DM) SO_LOAD(k0 + 256);
#pragma unroll
        for (int ks = 0; ks < 8; ++ks) acc = mm::mfma16(mm::frag_kc(As, 264, 16 * mt, 32 * ks, lane), mm::frag_kc(Bs, 264, 16 * nt, 32 * ks, lane), acc);
    }
#undef SO_LOAD
#pragma unroll
    for (int r = 0; r < 4; ++r) { const int rr = row0 + 16 * mt + 4 * gq + r, cc = col0 + 16 * nt + cl; const size_t o = (size_t)(rr - TP) * DM + cc;
        const float ov = xv4[r] + gm4[r] * acc[r];
        if (OB16) ((bf16*)out)[o] = (bf16)f2bf(ov); else ((float*)out)[o] = ov; }
    __syncthreads();
}
constexpr int NPHASE = 14;
struct Args { const float* in[31]; float* out; unsigned char* ws; int ph_lo, ph_hi; };
__global__ void __launch_bounds__(NTHR, 2) fwd_kernel(Args args) {
    extern __shared__ __attribute__((aligned(16))) unsigned char lds[];
    Frame F;
    F.lds = lds; F.tid = threadIdx.x; F.lane = F.tid & 63; F.wave = __builtin_amdgcn_readfirstlane(F.tid >> 6); F.G = gridDim.x;
    F.out = args.out; F.ws = args.ws;
    volatile LAS unsigned* MISC = (volatile LAS unsigned*)((LAS unsigned char*)lds + MISC_OFF);
    if (F.tid < 64) MISC[F.tid] = 0u;
    __syncthreads();
    const int lo = args.ph_lo, hi = args.ph_hi;
    XcdBarrier bar; bar.bar = (unsigned*)(F.ws + WS_CTL) + CW_BAR; bar.x = 0; bar.st = MISC + 8;
    if (hi - lo > 1) bar = xcd_barrier_post((unsigned*)(F.ws + WS_CTL) + CW_BAR, MISC + 8);
#ifndef DBL
#define DBL 0
#endif
#ifndef PH_MASK
#define PH_MASK 0xffff
#endif
#define IN(k) (((PH_MASK >> (k)) & 1) && lo <= (k) && (k) < hi)
#define SEAM(k) do { if (IN(k) && IN((k) + 1)) xcd_barrier(bar); } while (0)
#define REFRESH() do { int tz_ = threadIdx.x; asm volatile("" : "+v"(tz_)); F.tid = tz_; F.lane = tz_ & 63; } while (0)
    LAS unsigned char* ldsl = (LAS unsigned char*)lds;
    const int bx = blockIdx.x, G = F.G;
    const int vx = (G % 8 == 0) ? (bx % 8) * (G / 8) + bx / 8 : bx;

    if (IN(0)) { REFRESH(); for (int it = G - 1 - bx; it < 96; it += G) mod_item_mfma(F, it);
        rope_phase(F); weights_phase(F, G > 96 ? G - 96 : G); } SEAM(0);
    if (IN(1)) { REFRESH(); normmod_phase<false>(F, INP(0), INP(1), INP(11), WSP(float, WS_MODE)); } SEAM(1);
    if (IN(2)) { REFRESH(); pg8::Gemm g{WSP(bf16, WS_H), WSP(bf16, WS_WINE), MR, NE, DM}; pg8::StaticOrder S; S.init(MR, NE, G, bx);
        EpiL0 E{WSP(bf16, WS_Z), F.out, INP(15), INP(16), WSP(f32x2, WS_ROPE), WSP(float, WS_KMEAN), (float*)(lds + XCH_OFF)}; pg8::gemm_phase<EpiL0, pg8::StaticOrder, true, true>(ldsl, g, S, E); } SEAM(2);
    if (IN(3)) { REFRESH();
        const bool attn_first = (vx & 1) == 0;
        if (!attn_first) { for (int it = bx; it < 1536; it += G) { if (it < 512) kv_local_item<false>(F, it); else { smp_pass1_item(F, it - 512); REFRESH(); } } __syncthreads(); }
        { typedef attn_body::bf16 abf; const abf* Zb = (const abf*)WSP(bf16, WS_Z); abf* MX = (abf*)WSP(bf16, WS_MIX); const float* kpart = WSP(float, WS_KPART); const float* relb = INP(10);
          for (int pi = vx; pi < 256; pi += G) { const int bh = pi >> 3, s = pi & 7;
              attn_body::attn_unit<8>(bh >> 3, bh & 7, 15 - s, Zb + ZQA, Zb + ZKA, Zb + ZVA, Zb + ZGA, MX, kpart, relb, (char*)lds, true);
              attn_body::attn_unit<8>(bh >> 3, bh & 7, s, Zb + ZQA, Zb + ZKA, Zb + ZVA, Zb + ZGA, MX, kpart, relb, (char*)lds, false); } }
        if (attn_first) { for (int it = bx; it < 1536; it += G) { if (it < 512) kv_local_item<false>(F, it); else { smp_pass1_item(F, it - 512); REFRESH(); } } }
    } SEAM(3);
    if (IN(4)) { REFRESH(); ret_scan_phase(F); for (int it = bx; it < 1024; it += G) smp_pass2_item(F, it); } SEAM(4);
    if (IN(5)) { REFRESH(); for (int rep_ = 0; rep_ <= ((DBL >> 0) & 1); ++rep_) for (int it = bx; it < 1024; it += G) { if (it < 512) ret_out_mfma(F, it); else smp_ret_item(F, it - 512); } } SEAM(5);
    if (IN(6)) { REFRESH(); pg8::Gemm g{WSP(bf16, WS_MIX), WSP(bf16, WS_WOUTE), TP, DM, DM}; pg8::StaticOrder S; S.init(TP, DM, G, bx);
        EpiRes<false, true> E{INP(0), INP(1), WSP(float, WS_MODE), WSP(bf16, WS_X1)}; pg8::gemm_phase<EpiRes<false, true>, pg8::StaticOrder, true, true>(ldsl, g, S, E);
        for (int it = bx; it < 256; it += G) smp_outproj_item<false, true>(F, it, WSP(bf16, WS_WOUTE), INP(1), WSP(float, WS_MODE), WSP(bf16, WS_X1) + (size_t)TP * DM); } SEAM(6);
    if (IN(7)) { REFRESH(); normmod_phase<true>(F, WSP(bf16, WS_X1), WSP(bf16, WS_X1) + (size_t)TP * DM, INP(18), WSP(float, WS_MODO)); } SEAM(7);
    if (IN(8)) { REFRESH(); pg8::Gemm g{WSP(bf16, WS_H), WSP(bf16, WS_WINO), MR, NOP, DM}; pg8::StaticOrder S; S.init(MR, NOP, G, bx);
        EpiZ E{WSP(bf16, WS_Z), NOP, WSP(float, WS_DTRAW)}; pg8::gemm_phase<EpiZ, pg8::StaticOrder, true, true>(ldsl, g, S, E); } SEAM(8);
    if (IN(9)) { REFRESH(); post1_phase(F); } SEAM(9);
    if (IN(10)) { REFRESH(); for (int rep_ = 0; rep_ <= ((DBL >> 1) & 1); ++rep_) for (int it = vx; it < 1536; it += G) { if (it < 1024) kv_local_item<true>(F, it); else sgu_mfma(F, it - 1024); } } SEAM(10);
    if (IN(11)) { REFRESH(); ssd_scan_phase(F); for (int rep_ = 0; rep_ <= ((DBL >> 2) & 1); ++rep_) for (int it = bx; it < 256; it += G) smp_l1_item(F, it); } SEAM(11);
    if (IN(12)) { REFRESH(); for (int rep_ = 0; rep_ <= ((DBL >> 3) & 1); ++rep_) for (int it = vx; it < 256; it += G) ssd_out_mfma(F, it); } SEAM(12);
    if (IN(13)) { REFRESH(); pg8::Gemm g{WSP(bf16, WS_MIX), WSP(bf16, WS_WOUTO), TP, DM, DM}; pg8::StaticOrder S; S.init(TP, DM, G, bx);
        EpiRes<true, false> E{WSP(bf16, WS_X1), WSP(bf16, WS_X1) + (size_t)TP * DM, WSP(float, WS_MODO), F.out + O_YP}; pg8::gemm_phase<EpiRes<true, false>, pg8::StaticOrder, true, true>(ldsl, g, S, E);
        for (int it = bx; it < 256; it += G) smp_outproj_item<true, false>(F, it, WSP(bf16, WS_WOUTO), WSP(bf16, WS_X1) + (size_t)TP * DM, WSP(float, WS_MODO), F.out + O_YS); }
#undef IN
#undef SEAM
}

#ifndef N_LAUNCH_MODE
#define N_LAUNCH_MODE 1
#endif
extern "C" void kernel_launch(void* const* d_in, const int* in_sizes, int n_in, void* d_out, int out_size, void* d_ws, size_t ws_size, hipStream_t stream) {
    static int grid = 0;
    if (grid == 0) {
        if (n_in != 31 || out_size != (int)O_END || ws_size < WS_END) { fprintf(stderr, "kernel_launch: unexpected problem shape (n_in %d, out %d, ws %zu)\n", n_in, out_size, ws_size); grid = -1; return; }
        int dev = 0, cus = 0, per_cu = 0;
        if (hipGetDevice(&dev) != hipSuccess || hipDeviceGetAttribute(&cus, hipDeviceAttributeMultiprocessorCount, dev) != hipSuccess) { grid = -1; return; }
        if (hipFuncSetAttribute((const void*)fwd_kernel, hipFuncAttributeMaxDynamicSharedMemorySize, LDS_BYTES) != hipSuccess) { fprintf(stderr, "kernel_launch: hipFuncSetAttribute failed\n"); grid = -1; return; }
        if (hipOccupancyMaxActiveBlocksPerMultiprocessor(&per_cu, (const void*)fwd_kernel, NTHR, LDS_BYTES) != hipSuccess || per_cu < 1) fprintf(stderr, "kernel_launch: occupancy query reports %d\n", per_cu);
        (void)hipGetLastError();
        grid = cus;
    }
    if (grid < 0) return;
    (void)hipMemsetAsync((char*)d_ws + WS_CTL, 0, CTL_ZERO_BYTES, stream);
    Args a{};
    for (int i = 0; i < 31; ++i) a.in[i] = (const float*)d_in[i];
    a.out = (float*)d_out; a.ws = (unsigned char*)d_ws;
#if N_LAUNCH_MODE == 1
    a.ph_lo = 0; a.ph_hi = NPHASE;
    hipLaunchKernelGGL(fwd_kernel, dim3(grid), dim3(NTHR), LDS_BYTES, stream, a);
#else
    for (int k = 0; k < NPHASE; ++k) { a.ph_lo = k; a.ph_hi = k + 1; hipLaunchKernelGGL(fwd_kernel, dim3(grid), dim3(NTHR), LDS_BYTES, stream, a); }
#endif
}
```

```cpp
#include <hip/hip_runtime.h>
#include <cstdio>
#include <cstdint>
#include <hip/hip_bf16.h>
#include <cmath>
namespace pg8 {
#define PG8_LAS __attribute__((address_space(3)))
typedef unsigned short bf16_t;
typedef short bf16x8 __attribute__((ext_vector_type(8)));
typedef float f32x4 __attribute__((ext_vector_type(4)));
typedef unsigned u32x4 __attribute__((ext_vector_type(4)));
constexpr int BM = 256, BK = 64, HALF = 128, HTB = HALF * BK * 2  , STAGE_BYTES = 8 * HTB, NXCD = 8, WGM = 8;

__host__ __device__ __forceinline__ int lds_byte(int r, int c) { const int st = (r >> 4) * 2 + (c >> 5), rr = r & 15, cc = c & 31, ob = rr * 64 + cc * 2; return st * 1024 + (ob ^ (((ob >> 9) & 1) << 5)); }
__host__ __device__ __forceinline__ void stage_rc(int b, int& R, int& C) { const int st = b / 1024, sb = b % 1024, swz = sb ^ (((sb >> 9) & 1) << 5); R = (st >> 1) * 16 + swz / 64; C = (st & 1) * 32 + (swz % 64) / 2; }
__host__ __device__ __forceinline__ int perm32(int rho) { const int n = rho >> 4, i = rho & 15; return 8 * (i >> 2) + 4 * n + (i & 3); }

struct Unit { int pm, pn; };
struct Gemm { const bf16_t* A; const bf16_t* Bt; int M, N, K; };

struct StaticOrder {
    int nM, nN, nwg, G, c;
    __host__ __device__ void init(int M, int N, int G_, int c_) { nM = M / BM; nN = N / BM; nwg = nM * nN; G = G_; c = c_; }
    __host__ __device__ bool next(int i, Unit& u) const {
        const long L = (long)i * G + c; if (L >= nwg) return false;
        int wgid = (int)L; { const int q = nwg / NXCD, r = nwg % NXCD, xcd = wgid % NXCD, off = wgid / NXCD; wgid = (xcd < r ? xcd * (q + 1) : r * (q + 1) + (xcd - r) * q) + off; }
        const int nig = WGM * nN, gid = wgid / nig, fm = gid * WGM, gsz = (nM - fm) < WGM ? (nM - fm) : WGM;
        u.pm = fm + ((wgid % nig) % gsz); u.pn = (wgid % nig) / gsz; return true;
    }
    __device__ __forceinline__ void a_ready(const Unit&) const {}
    __device__ __forceinline__ void done(const Unit&) const {}
};
__device__ __forceinline__ unsigned cvt_pk_bf16(float lo, float hi) { unsigned r; asm volatile("v_cvt_pk_bf16_f32 %0, %1, %2" : "=v"(r) : "v"(lo), "v"(hi)); return r; }

template <class Epi, class Sched, bool ALIGN_EPI = false, bool SP2 = false>
__device__ __forceinline__ void gemm_phase(PG8_LAS unsigned char* lds, const Gemm g, const Sched& S, const Epi& E) {
    const int tid = threadIdx.x, wid = __builtin_amdgcn_readfirstlane(tid >> 6), lane = tid & 63, wr = wid >> 2, wc = wid & 3, fr = lane & 15, fq = lane >> 4;
    const int K = g.K, nt = K / BK;
    unsigned voffA[2], voffB[2];
#pragma unroll
    for (int i = 0; i < 2; ++i) { int R, C; stage_rc(tid * 16 + i * 8192, R, C); const int Rb = Epi::PERM ? ((R & ~31) + perm32(R & 31)) : R;
        voffA[i] = (unsigned)(R * K + C) * 2u; voffB[i] = (unsigned)(Rb * K + C) * 2u; }
    const size_t kstep = (size_t)(BK * 2);
    const size_t hstep = (size_t)HALF * K * 2;
    const size_t tstep = 2 * hstep;
    const unsigned ldsw = (unsigned)wid * 1024u;
    const int aoff = lds_byte(wr * 64 + fr, fq * 8), boff = lds_byte(wc * 32 + fr, fq * 8);
#define PG8_SA(b, h) (((b) * 2 + (h)) * HTB)
#define PG8_SB(b, h) ((4 + (b) * 2 + (h)) * HTB)
#define PG8_STAGE(bufoff, gbase, voff) do { _Pragma("unroll") for (int _i = 0; _i < 2; ++_i) \
        __builtin_amdgcn_global_load_lds((const unsigned*)((const char*)(gbase) + (voff)[_i]), (PG8_LAS unsigned*)(lds + (bufoff) + ldsw + _i * 8192), 16, 0, 0); } while (0)
#define PG8_LDA(dst, b, h) do { _Pragma("unroll") for (int m = 0; m < 4; ++m) _Pragma("unroll") for (int k = 0; k < 2; ++k) dst[m][k] = *(const PG8_LAS bf16x8*)(lds + PG8_SA(b, h) + aoff + m * 2048 + k * 1024); } while (0)
#define PG8_LDB(dst, b, h) do { _Pragma("unroll") for (int n = 0; n < 2; ++n) _Pragma("unroll") for (int k = 0; k < 2; ++k) dst[n][k] = *(const PG8_LAS bf16x8*)(lds + PG8_SB(b, h) + boff + n * 2048 + k * 1024); } while (0)
#define PG8_MMA(ai, bj, At, Bt) do { __builtin_amdgcn_s_setprio(1); _Pragma("unroll") for (int m = 0; m < 4; ++m) _Pragma("unroll") for (int n = 0; n < 2; ++n) _Pragma("unroll") for (int k = 0; k < 2; ++k) \
        acc[ai][bj][m][n] = __builtin_amdgcn_mfma_f32_16x16x32_bf16(Bt[n][k], At[m][k], acc[ai][bj][m][n], 0, 0, 0); __builtin_amdgcn_s_setprio(0); } while (0)
#define PG8_WAIT_V(n) asm volatile("s_waitcnt vmcnt(" #n ")" ::: "memory")
#define PG8_WAIT_L(n) asm volatile("s_waitcnt lgkmcnt(" #n ")" ::: "memory")
#define PG8_BAR __builtin_amdgcn_s_barrier()
#define PG8_SCHED __builtin_amdgcn_sched_barrier(0)
    Unit cur, nxt; int ui = 0;
    if (!S.next(0, cur)) return;
    f32x4 acc[2][2][4][2];
#pragma unroll
    for (int a = 0; a < 2; ++a)
#pragma unroll
        for (int b = 0; b < 2; ++b)
#pragma unroll
            for (int m = 0; m < 4; ++m)
#pragma unroll
                for (int n = 0; n < 2; ++n) acc[a][b][m][n] = (f32x4){0.f, 0.f, 0.f, 0.f};
    bf16x8 At[4][2], B0[2][2], B1[2][2];
    const char* cA = (const char*)g.A + (size_t)cur.pm * tstep; const char* cB = (const char*)g.Bt + (size_t)cur.pn * tstep;
    S.a_ready(cur);
    if constexpr (SP2) {
        PG8_STAGE(PG8_SB(0, 0), cB, voffB); PG8_STAGE(PG8_SB(0, 1), cB + hstep, voffB); PG8_STAGE(PG8_SA(0, 0), cA, voffA); PG8_STAGE(PG8_SA(0, 1), cA + hstep, voffA);
        if (wr == 1) PG8_BAR;
        PG8_WAIT_V(2); PG8_BAR;
        PG8_STAGE(PG8_SB(1, 0), cB + kstep, voffB); PG8_STAGE(PG8_SA(1, 0), cA + kstep, voffA); PG8_STAGE(PG8_SB(1, 1), cB + hstep + kstep, voffB);
        PG8_WAIT_V(6); PG8_BAR;
    } else {
        PG8_STAGE(PG8_SB(0, 0), cB, voffB); PG8_STAGE(PG8_SA(0, 0), cA, voffA); PG8_STAGE(PG8_SB(0, 1), cB + hstep, voffB); PG8_STAGE(PG8_SA(0, 1), cA + hstep, voffA);
        if (wr == 1) PG8_BAR;
        PG8_WAIT_V(4); PG8_BAR;
        PG8_STAGE(PG8_SB(1, 0), cB + kstep, voffB); PG8_STAGE(PG8_SA(1, 0), cA + kstep, voffA); PG8_STAGE(PG8_SB(1, 1), cB + hstep + kstep, voffB);
        PG8_WAIT_V(6); PG8_BAR;
    }
    for (;;) {
        const bool has_next = S.next(ui + 1, nxt);
        const char* nA = has_next ? (const char*)g.A + (size_t)nxt.pm * tstep : cA; const char* nB = has_next ? (const char*)g.Bt + (size_t)nxt.pn * tstep : cB;
        for (int t = 0; t < nt; t += 2) {
            const bool last = (t == nt - 2);
            const char* a1 = cA + (size_t)(t + 1) * kstep;
            const char* a2 = last ? nA : cA + (size_t)(t + 2) * kstep; const char* b2 = last ? nB : cB + (size_t)(t + 2) * kstep;
            const char* a3 = a2 + kstep; const char* b3 = b2 + kstep;
            if (last && has_next) S.a_ready(nxt);
            if constexpr (SP2) {
            PG8_LDB(B0, 0, 0); PG8_LDB(B1, 0, 1); PG8_SCHED; PG8_LDA(At, 0, 0); PG8_STAGE(PG8_SA(1, 1), a1 + hstep, voffA);
            PG8_WAIT_V(8); PG8_WAIT_L(0); PG8_BAR; PG8_MMA(0, 0, At, B0); PG8_MMA(0, 1, At, B1); PG8_BAR; PG8_SCHED;
            PG8_LDA(At, 0, 1); PG8_STAGE(PG8_SB(0, 0), b2, voffB); PG8_STAGE(PG8_SB(0, 1), b2 + hstep, voffB); PG8_STAGE(PG8_SA(0, 0), a2, voffA);
            PG8_WAIT_V(8); PG8_WAIT_L(0); PG8_BAR; PG8_MMA(1, 0, At, B0); PG8_MMA(1, 1, At, B1); PG8_BAR; PG8_SCHED;
            PG8_LDB(B0, 1, 0); PG8_LDB(B1, 1, 1); PG8_SCHED; PG8_LDA(At, 1, 0); PG8_STAGE(PG8_SA(0, 1), a2 + hstep, voffA);
            PG8_WAIT_V(8); PG8_WAIT_L(0); PG8_BAR; PG8_MMA(0, 0, At, B0); PG8_MMA(0, 1, At, B1); PG8_BAR; PG8_SCHED;
            PG8_LDA(At, 1, 1); PG8_STAGE(PG8_SB(1, 0), b3, voffB); PG8_STAGE(PG8_SB(1, 1), b3 + hstep, voffB); PG8_STAGE(PG8_SA(1, 0), a3, voffA);
            PG8_WAIT_V(8); PG8_WAIT_L(0); PG8_BAR; PG8_MMA(1, 0, At, B0); PG8_MMA(1, 1, At, B1); PG8_BAR; PG8_SCHED;
            } else {
            PG8_LDB(B0, 0, 0); PG8_SCHED; PG8_LDA(At, 0, 0); PG8_STAGE(PG8_SA(1, 1), a1 + hstep, voffA);
            PG8_WAIT_L(8); PG8_BAR; PG8_WAIT_L(0); PG8_MMA(0, 0, At, B0); PG8_BAR; PG8_SCHED;
            PG8_LDB(B1, 0, 1); PG8_STAGE(PG8_SB(0, 0), b2, voffB);
            PG8_BAR; PG8_WAIT_L(0); PG8_MMA(0, 1, At, B1); PG8_BAR;
            PG8_LDA(At, 0, 1); PG8_STAGE(PG8_SA(0, 0), a2, voffA);
            PG8_BAR; PG8_WAIT_L(0); PG8_MMA(1, 0, At, B0); PG8_BAR; PG8_SCHED;
            PG8_STAGE(PG8_SB(0, 1), b2 + hstep, voffB);
            PG8_WAIT_V(6); PG8_BAR; PG8_MMA(1, 1, At, B1); PG8_BAR;
            PG8_LDB(B0, 1, 0); PG8_SCHED; PG8_LDA(At, 1, 0); PG8_STAGE(PG8_SA(0, 1), a2 + hstep, voffA);
            PG8_WAIT_L(8); PG8_BAR; PG8_WAIT_L(0); PG8_MMA(0, 0, At, B0); PG8_BAR; PG8_SCHED;
            PG8_LDB(B1, 1, 1); PG8_STAGE(PG8_SB(1, 0), b3, voffB);
            PG8_BAR; PG8_WAIT_L(0); PG8_MMA(0, 1, At, B1); PG8_BAR;
            PG8_LDA(At, 1, 1); PG8_STAGE(PG8_SA(1, 0), a3, voffA);
            PG8_BAR; PG8_WAIT_L(0); PG8_MMA(1, 0, At, B0); PG8_BAR; PG8_SCHED;
            PG8_STAGE(PG8_SB(1, 1), b3 + hstep, voffB);
            PG8_WAIT_V(6); PG8_BAR; PG8_MMA(1, 1, At, B1); PG8_BAR;
            }
        }
        if constexpr (ALIGN_EPI) { if (wr == 0) PG8_BAR; }
        if constexpr (!Epi::AFTER_DRAIN) { E(acc, cur, wr, wc, fr, fq); S.done(cur); }
        if (!has_next) break;
#pragma unroll
        for (int a = 0; a < 2; ++a)
#pragma unroll
            for (int b = 0; b < 2; ++b)
#pragma unroll
                for (int m = 0; m < 4; ++m)
#pragma unroll
                    for (int n = 0; n < 2; ++n) acc[a][b][m][n] = (f32x4){0.f, 0.f, 0.f, 0.f};
        cur = nxt; cA = nA; cB = nB; ++ui;
        if constexpr (ALIGN_EPI) { if (wr == 1) PG8_BAR; }
    }
    PG8_WAIT_V(0);
    if constexpr (!ALIGN_EPI) { if (wr == 0) PG8_BAR; }
    PG8_BAR;
    if constexpr (Epi::AFTER_DRAIN) { E.fused(acc, cur, wr, wc, fr, fq, lds, wid, lane); S.done(cur); }
#undef PG8_SA
#undef PG8_SB
#undef PG8_STAGE
#undef PG8_LDA
#undef PG8_LDB
#undef PG8_MMA
#undef PG8_WAIT_V
#undef PG8_WAIT_L
#undef PG8_BAR
#undef PG8_SCHED
}
}
constexpr int NWAVES = 8, NTHR = 512;
constexpr int DM = 1024, SEQ = 4096, NBP = 4, NBS = 128, TS4 = 4;
constexpr int TP = NBP * SEQ, TS = NBS * TS4, MR = TP + TS;
constexpr int NE = 3584, NO = 3080, NOP = 3328;
constexpr int ZQA = 0, ZKA = 512, ZVA = 1024, ZGA = 1536, ZQB = 2048, ZKB = 2304, ZVB = 2560, ZGB = 3072;
constexpr int YU = 0, YV = 512, YGC = 1024, YZG = 1536, YXBC = 2048, YDT = 3072;
constexpr int NPHYS = 2560, PAGE = 128, NPAGES = 16, PAST = 2048;
constexpr float EPS = 1e-6f;
constexpr size_t O_YP = 0, O_YS = O_YP + (size_t)TP * DM, O_KP = O_YS + (size_t)TS * DM, O_VP = O_KP + (size_t)TP * 512, O_KS = O_VP + (size_t)TP * 512,
    O_VS = O_KS + (size_t)TS * 512, O_RSP = O_VS + (size_t)TS * 512, O_RSS = O_RSP + (size_t)NBP * 4 * 8192, O_SGV = O_RSS + (size_t)NBS * 4 * 8192,
    O_SSP = O_SGV + (size_t)TS * 512, O_SSS = O_SSP + (size_t)NBP * 8 * 8192, O_CSP = O_SSS + (size_t)NBS * 8 * 8192, O_CSS = O_CSP + (size_t)NBP * 3 * 1024,
    O_END = O_CSS + (size_t)NBS * 3 * 1024;
static_assert(O_END == 48246784, "output size");
constexpr size_t MiB = 1u << 20;
constexpr size_t WS_CTL = 0, CTL_ZERO_BYTES = 32768;
constexpr size_t WS_WINE = 2 * MiB, WS_WOUTE = 10 * MiB, WS_WINO = 12 * MiB, WS_WOUTO = 19 * MiB;
constexpr size_t WS_MODE = 21 * MiB, WS_MODO = 23 * MiB;
constexpr size_t WS_ROPE = 25 * MiB;
constexpr size_t WS_KMEAN = 26 * MiB;
constexpr size_t WS_KPART = 26 * MiB;
constexpr size_t WS_DTRAW = 27 * MiB, WS_DTH = 28 * MiB, WS_CUM = 29 * MiB, WS_CDEC = 30 * MiB;
constexpr size_t WS_H = 32 * MiB;
constexpr size_t WS_Z = 66 * MiB;
constexpr size_t WS_MIX = 182 * MiB;
constexpr size_t WS_X1 = 216 * MiB;
constexpr size_t WS_SLR = 282 * MiB;
constexpr size_t WS_SLS = 298 * MiB;
constexpr size_t WS_XC = 330 * MiB;
constexpr size_t WS_SC = 364 * MiB;
constexpr size_t WS_KMS = 396 * MiB;
constexpr size_t WS_PBR = 400 * MiB;
constexpr size_t WS_PBS = 410 * MiB;
constexpr size_t WS_END = 432 * MiB;
constexpr int CW_BAR = 4096;
constexpr int XCH_OFF = 131072;
constexpr int SCR_BYTES = 155648;
constexpr int MISC_OFF = SCR_BYTES;
constexpr int LDS_BYTES = SCR_BYTES + 256;

#define GAS __attribute__((address_space(1)))
#define LAS __attribute__((address_space(3)))
typedef unsigned short bf16;
typedef unsigned v4u __attribute__((ext_vector_type(4)));
typedef unsigned v2u __attribute__((ext_vector_type(2)));
typedef float f32x4 __attribute__((ext_vector_type(4)));
typedef float f32x2 __attribute__((ext_vector_type(2)));
typedef GAS unsigned gu32;
#define RLX_AGENT __ATOMIC_RELAXED, __HIP_MEMORY_SCOPE_AGENT
__device__ __forceinline__ float bf2f(unsigned v16) { return __uint_as_float(v16 << 16); }
__device__ __forceinline__ unsigned f2bf(float f) { unsigned u = __float_as_uint(f); return (u + 0x7fffu + ((u >> 16) & 1u)) >> 16; }
__device__ __forceinline__ unsigned pk2(float lo, float hi) { return f2bf(lo) | (f2bf(hi) << 16); }
__device__ __forceinline__ void unpack8(v4u w, float* f) {
    f[0] = __uint_as_float(w.x << 16); f[1] = __uint_as_float(w.x & 0xffff0000u); f[2] = __uint_as_float(w.y << 16); f[3] = __uint_as_float(w.y & 0xffff0000u);
    f[4] = __uint_as_float(w.z << 16); f[5] = __uint_as_float(w.z & 0xffff0000u); f[6] = __uint_as_float(w.w << 16); f[7] = __uint_as_float(w.w & 0xffff0000u); }
__device__ __forceinline__ v4u pack8(const float* f) { v4u w; w.x = pk2(f[0], f[1]); w.y = pk2(f[2], f[3]); w.z = pk2(f[4], f[5]); w.w = pk2(f[6], f[7]); return w; }
__device__ __forceinline__ float silu_f(float x) { return x / (1.f + __expf(-x)); }
__device__ __forceinline__ float gelu_f(float x) { const float y = 0.7978845608028654f * (x + 0.044715f * x * x * x); const float t = 1.f - 2.f / (__expf(2.f * y) + 1.f); return 0.5f * x * (1.f + t); }
__device__ __forceinline__ float softplus_f(float x) { return x > 20.f ? x : log1pf(__expf(x)); }
__device__ __forceinline__ float wave_sum(float v) {
#pragma unroll
    for (int o = 1; o < 64; o <<= 1) v += __shfl_xor(v, o);
    return v;
}
__device__ __forceinline__ float red8_dpp(float s) {
    s += __int_as_float(__builtin_amdgcn_update_dpp(0, __float_as_int(s), 0xB1, 0xF, 0xF, true));
    s += __int_as_float(__builtin_amdgcn_update_dpp(0, __float_as_int(s), 0x4E, 0xF, 0xF, true));
    s += __int_as_float(__builtin_amdgcn_update_dpp(0, __float_as_int(s), 0x141, 0xF, 0xF, true));
    return s;
}
__device__ __forceinline__ float red16_dpp(float s) {
    s = red8_dpp(s);
    s += __int_as_float(__builtin_amdgcn_update_dpp(0, __float_as_int(s), 0x140, 0xF, 0xF, true));
    return s;
}
__device__ __forceinline__ float wave_max(float v) {
#pragma unroll
    for (int o = 1; o < 64; o <<= 1) v = fmaxf(v, __shfl_xor(v, o));
    return v;
}
__device__ __forceinline__ int t5_bucket(int n) { if (n < 16) return n; const int l = 16 + (int)(logf((float)n * 0.0625f) / 2.0794415416798357f * 16.f); return l < 31 ? l : 31; }
__device__ __forceinline__ int mod_row(int r) { return r < TP ? (r >> 12) : 4 + ((r - TP) >> 2); }
__device__ __forceinline__ int pos_of(int r) { return r < TP ? (r & (SEQ - 1)) : PAST + (r & 3); }
template <int I> __device__ __forceinline__ const float* inp_ptr() {
    const unsigned long long kp = (unsigned long long)__builtin_amdgcn_kernarg_segment_ptr(); unsigned long long v;
    asm volatile("s_load_dwordx2 %0, %1, %2\n\ts_waitcnt lgkmcnt(0)" : "=s"(v) : "s"(kp), "i"(I * 8));
    return (const float*)(const GAS float*)v;
}
#define INP(i) inp_ptr<i>()
namespace attn_body {
using bf16=__hip_bfloat16;
using bf16x8=__attribute__((ext_vector_type(8)))short;
using s16x4=__attribute__((ext_vector_type(4)))short;
using f32x16=__attribute__((ext_vector_type(16)))float;
using u32x4=__attribute__((ext_vector_type(4)))unsigned;
constexpr int BATCH=4,NHEAD=8,SEQ=4096,D=64,DM=3584;
constexpr int NW=8,QBLK=32,QB=QBLK*NW,KVBLK=64,NQB=SEQ/QB;
constexpr int ATTN_PITCH=DM, ATTN_UNIT_ROWS=QB;
__device__ __forceinline__ int crow(int r,int hi){return (r&3)+8*(r>>2)+4*hi;}
#define SBAR() __builtin_amdgcn_sched_barrier(0)
__device__ __forceinline__ void cmask(f32x16&p0,f32x16&p1,int jb,int qrel,int hi){
  const float NEG=-INFINITY; int kb=64*jb+4*hi;
  #pragma unroll
  for(int r=0;r<16;++r){int kv=kb+(r&3)+8*(r>>2); if(kv>qrel)p0[r]=NEG; if(kv+32>qrel)p1[r]=NEG;}
}

__device__ __forceinline__ void cinit(f32x16&c0,f32x16&c1,int t,int NT,int qb,int qrel,int hi,unsigned selm,const float*lut,float mhat){
  const float NEG=-INFINITY; const bool band=t<4; const int pt=band?4*qb+t:t-4;
  const bool keep=(((selm>>((pt>>2)&15))&1u)!=0u);
  if(t>=4&&t<NT-2){ const float v=keep?-mhat:NEG;
    #pragma unroll
    for(int r=0;r<16;++r){c0[r]=v;c1[r]=v;} }
  else { const int lim=band?(qrel-64*t-4*hi):(keep?4096:-4096); const float*lp=lut+256+(256*qb+qrel-64*pt)-4*hi;
    #pragma unroll
    for(int r=0;r<16;++r){ const int c=(r&3)+8*(r>>2); const float b0=lp[-c], b1=lp[-c-32]; c0[r]=(c>lim)?NEG:b0-mhat; c1[r]=(c+32>lim)?NEG:b1-mhat; } }
}
constexpr int NSLOT=3, SLOTB=8192;
constexpr int LDS_K=0, LDS_V=NSLOT*SLOTB, LDS_WS=2*NSLOT*SLOTB, LDS_OST=LDS_WS+NW*64*4, LDS_BYTES=LDS_OST+NW*4096;
constexpr int LUTN=4352;
constexpr int LDS_KM=LDS_BYTES, LDS_LUT=LDS_KM+4096, LDS_TOTAL=LDS_LUT+LUTN*4;
constexpr float C2=0.125f*1.4426950408889634f;
__device__ __forceinline__ void glds16(const void*gsrc,unsigned lds_dst){unsigned keep;
  asm volatile("s_mov_b32 %0, m0\n\ts_mov_b32 m0, %2\n\ts_nop 0\n\tglobal_load_lds_dwordx4 %1, off\n\ts_mov_b32 m0, %0":"=&s"(keep):"v"(gsrc),"s"(lds_dst):"memory");}
__device__ __forceinline__ float max3f(float a,float b,float c){float r;asm("v_max3_f32 %0, %1, %2, %3":"=v"(r):"v"(a),"v"(b),"v"(c));return r;}
__device__ __forceinline__ float max2f(float a,float b){float r;asm("v_max_f32_e32 %0, %1, %2":"=v"(r):"v"(a),"v"(b));return r;}
__device__ __forceinline__ float fadd_s(float a,float b){float r;asm("v_add_f32_e32 %0, %1, %2":"=v"(r):"v"(a),"v"(b));return r;}
__device__ __forceinline__ float fsub_s(float a,float b){float r;asm("v_sub_f32_e32 %0, %1, %2":"=v"(r):"v"(a),"v"(b));return r;}
typedef float f32x2_t __attribute__((ext_vector_type(2))); typedef __bf16 bf16x2_t __attribute__((ext_vector_type(2)));
__device__ __forceinline__ unsigned cvtpk_s(float lo,float hi){f32x2_t v={lo,hi};bf16x2_t b=__builtin_convertvector(v,bf16x2_t);return __builtin_bit_cast(unsigned,b);}
#define WAIT_BAR(N) asm volatile("s_waitcnt vmcnt(" #N ") lgkmcnt(0)\n\ts_barrier":::"memory")

__device__ __forceinline__ void qkt(f32x16&p0,f32x16&p1,const char*Kslot,const bf16x8*qr,int r32,int hi){
  const char*kb=Kslot+hi*1024+r32*16;
  #pragma unroll
  for(int d0=0;d0<4;++d0){
    const bf16x8 b0=*reinterpret_cast<const bf16x8*>(kb+d0*2048);
    const bf16x8 b1=*reinterpret_cast<const bf16x8*>(kb+d0*2048+512);
    p0=__builtin_amdgcn_mfma_f32_32x32x16_bf16(b0,qr[d0],p0,0,0,0);p1=__builtin_amdgcn_mfma_f32_32x32x16_bf16(b1,qr[d0],p1,0,0,0);}
}
typedef __attribute__((address_space(3))) const char* lds_cptr;
typedef short v4i16_t __attribute__((ext_vector_type(4)));
__device__ __forceinline__ void kload8(bf16x8*kf,lds_cptr kp){
  kf[0]=*(const __attribute__((address_space(3))) bf16x8*)(kp);      kf[1]=*(const __attribute__((address_space(3))) bf16x8*)(kp+512);
  kf[2]=*(const __attribute__((address_space(3))) bf16x8*)(kp+2048); kf[3]=*(const __attribute__((address_space(3))) bf16x8*)(kp+2560);
  kf[4]=*(const __attribute__((address_space(3))) bf16x8*)(kp+4096); kf[5]=*(const __attribute__((address_space(3))) bf16x8*)(kp+4608);
  kf[6]=*(const __attribute__((address_space(3))) bf16x8*)(kp+6144); kf[7]=*(const __attribute__((address_space(3))) bf16x8*)(kp+6656);
}
__device__ __forceinline__ void kload2(bf16x8*kf,lds_cptr kp,int j){ kf[2*j]=*(const __attribute__((address_space(3))) bf16x8*)(kp+j*2048); kf[2*j+1]=*(const __attribute__((address_space(3))) bf16x8*)(kp+j*2048+512); }
__device__ __forceinline__ s16x4 vtr(lds_cptr p){ return __builtin_bit_cast(s16x4,__builtin_amdgcn_ds_read_tr16_b64_v4i16((__attribute__((address_space(3))) v4i16_t*)p)); }
__device__ __forceinline__ float rowmax(const f32x16&p0,const f32x16&p1){
  float a=max3f(p0[0],p0[1],p1[0]),b=max3f(p0[2],p0[3],p1[1]);a=max3f(a,p1[2],p1[3]);
  #pragma unroll
  for(int r=4;r<16;r+=4){a=max3f(a,p0[r],p0[r+1]);b=max3f(b,p0[r+2],p0[r+3]);a=max3f(a,p1[r],p1[r+1]);b=max3f(b,p1[r+2],p1[r+3]);}
  const float m=max2f(a,b);
  auto rr=__builtin_amdgcn_permlane32_swap(__float_as_uint(m),__float_as_uint(m),false,false);
  return max2f(__uint_as_float(rr[0]),__uint_as_float(rr[1]));
}
__device__ __forceinline__ void pv(f32x16*o,int vb,bf16x8 pa0,bf16x8 pa1,bf16x8 pa2,bf16x8 pa3){
  #pragma unroll
  for(int d0=0;d0<2;++d0){s16x4 lo[4],hi[4];
    #pragma unroll
    for(int ks=0;ks<4;++ks){
      asm volatile("ds_read_b64_tr_b16 %0,%1 offset:%c2":"=&v"(lo[ks]):"v"(vb),"i"(d0*4096+ks*1024):"memory");
      asm volatile("ds_read_b64_tr_b16 %0,%1 offset:%c2":"=&v"(hi[ks]):"v"(vb),"i"(d0*4096+ks*1024+512):"memory");}
    asm volatile("s_waitcnt lgkmcnt(0)":::"memory");SBAR();
    #define PK(k) (bf16x8){lo[k][0],lo[k][1],lo[k][2],lo[k][3],hi[k][0],hi[k][1],hi[k][2],hi[k][3]}
    o[d0]=__builtin_amdgcn_mfma_f32_32x32x16_bf16(pa0,PK(0),o[d0],0,0,0);
    o[d0]=__builtin_amdgcn_mfma_f32_32x32x16_bf16(pa1,PK(1),o[d0],0,0,0);
    o[d0]=__builtin_amdgcn_mfma_f32_32x32x16_bf16(pa2,PK(2),o[d0],0,0,0);
    o[d0]=__builtin_amdgcn_mfma_f32_32x32x16_bf16(pa3,PK(3),o[d0],0,0,0);
    #undef PK
  }
}

#ifndef ATTN_STORE16
#define ATTN_STORE16(p,v) (*(u32x4*)(p)=(v))
#endif
template<int THRL> __device__ __forceinline__ void attn_unit(int b,int h,int qb,const bf16*Q,const bf16*__restrict__ K,const bf16*__restrict__ V,const bf16*__restrict__ GA,bf16*O,const float*__restrict__ kpart,const float*__restrict__ relb,char*shm,bool setup){
  const int tid=threadIdx.x,lane=tid&63,r32=lane&31,hi=lane>>5; const int wid=__builtin_amdgcn_readfirstlane(tid>>6);
  const long rowbase=(long)b*SEQ; const int q0=qb*QB;
  const bf16*Qw=Q+(rowbase+q0+wid*QBLK)*DM+h*D;
  const bf16*Kh=K+rowbase*DM+h*D,*Vh=V+rowbase*DM+h*D;
  const unsigned lds0=(unsigned)(uintptr_t)shm;
  float*wsf=(float*)(shm+LDS_WS)+wid*64;
  const bf16*ksrc=Kh+(long)lane*DM+wid*8;
  const bf16*vsrc=Vh+(long)(16*(wid&3)+(lane>>2))*DM+(wid>>2)*32+(lane&3)*8;
  const unsigned kdst=lds0+LDS_K+wid*1024, vdst=lds0+LDS_V+wid*1024;
  #define PHYS(t) (((t)<4)?(4*qb+(t)):((t)-4))
  #define DMA_K(t,slot) glds16(ksrc+(long)(PHYS(t))*KVBLK*DM,(unsigned)__builtin_amdgcn_readfirstlane(kdst+(slot)))
  #define DMA_V(t,slot) glds16(vsrc+(long)(PHYS(t))*KVBLK*DM,(unsigned)__builtin_amdgcn_readfirstlane(vdst+(slot)))
  const int vb0=(int)(lds0+LDS_V)+((lane>>4)&1)*32+(lane&3)*8+(4*hi+((lane&15)>>2))*64;
  const char*Kbase=shm+LDS_K; bf16x8 kf[8];
  const lds_cptr shm3=(lds_cptr)shm; const lds_cptr kp0=shm3+LDS_K+hi*1024+r32*16; const lds_cptr vp0=shm3+LDS_V+((lane>>4)&1)*32+(lane&3)*8+(4*hi+((lane&15)>>2))*64;
  const int NT=(q0+QB)/KVBLK;
  bf16x8 qr[4];
  #pragma unroll
  for(int d0=0;d0<4;++d0)qr[d0]=*reinterpret_cast<const bf16x8*>(&Qw[(long)r32*DM+d0*16+hi*8]);
  unsigned selm=0u; const float*lut=(const float*)(shm+LDS_LUT);
  { float*kmn=(float*)(shm+LDS_KM); float*lw=(float*)(shm+LDS_LUT);
    if(setup){
    for(int e=tid;e<qb*64;e+=512){ const int n=e>>6,d=e&63; kmn[e]=kpart[(size_t)(b*16+n)*512+h*64+d]; }
    for(int e=tid;e<LUTN;e+=512){ float v=0.f; if(e>=256&&e<384){ const int dd=e-256; int bk=dd; if(dd>=16){ bk=16+(int)(logf((float)dd*0.0625f)/2.0794415416798357f*16.f); bk=bk<31?bk:31; } v=(relb[bk*8+h]-relb[31*8+h])*1.4426950408889634f; } lw[e]=v; }
    __syncthreads(); }
    float v1=-3e38f,v2=-3e38f,v3=-3e38f; int i1=-1,i2=-1,i3=-1;
    for(int n=0;n<qb;++n){ float s=0.f;
      #pragma unroll
      for(int d0=0;d0<4;++d0){ const float*kp=kmn+n*64+16*d0+8*hi;
        #pragma unroll
        for(int jj=0;jj<8;++jj)s+=__uint_as_float(((unsigned)(unsigned short)qr[d0][jj])<<16)*kp[jj]; }
      s+=__shfl_xor(s,32);
      if(s>v1){v3=v2;i3=i2;v2=v1;i2=i1;v1=s;i1=n;} else if(s>v2){v3=v2;i3=i2;v2=s;i2=n;} else if(s>v3){v3=s;i3=n;} }
    if(i1>=0)selm|=1u<<i1; if(i2>=0)selm|=1u<<i2; if(i3>=0)selm|=1u<<i3; }
  DMA_K(0,0);DMA_V(0,0);DMA_K(1,SLOTB);
  float mhat=0.f,l_reg=0.f;f32x16 o[2];o[0]=f32x16{};o[1]=f32x16{};
  const int qrel=wid*QBLK+r32;
  #define CINIT(P0,P1,t) cinit(P0,P1,(t),NT,qb,qrel,hi,selm,lut,mhat)
  bool resc=false;
  #define START(P0,P1) do{ const float rm=rowmax(P0,P1); resc=false; \
    { const float dl=rm; mhat=fadd_s(mhat,dl); \
      _Pragma("unroll") for(int r=0;r<16;++r){P0[r]=fsub_s(P0[r],dl);P1[r]=fsub_s(P1[r],dl);} \
      } \
    _Pragma("unroll") for(int r=0;r<16;++r)P0[r]=__builtin_amdgcn_exp2f(P0[r]); }while(0)
  #define RESC() do{ if(resc){ asm volatile("s_waitcnt lgkmcnt(0)":::"memory"); \
      _Pragma("unroll") for(int d_=0;d_<2;++d_) _Pragma("unroll") for(int r=0;r<16;++r)o[d_][r]*=wsf[crow(r,hi)]; } }while(0)
  f32x16 pA0,pA1,pB0,pB1;
  int sl_prev=0,sl_cur=0,sl_next=SLOTB;
  #define ROT() do{sl_prev=sl_cur;sl_cur=sl_next;sl_next=(sl_next==(NSLOT-1)*SLOTB)?0:sl_next+SLOTB;}while(0)
  DMA_K(2,2*SLOTB);
  WAIT_BAR(3);
  CINIT(pA0,pA1,0); qkt(pA0,pA1,Kbase,qr,r32,hi);asm volatile("s_nop 15\n\ts_nop 7":"+v"(pA0),"+v"(pA1));
  START(pA0,pA1);
  _Pragma("unroll") for(int r=0;r<16;++r)pA1[r]=__builtin_amdgcn_exp2f(pA1[r]);
  WAIT_BAR(0);
  DMA_K(3,0);DMA_V(1,SLOTB);
  ROT();
  kload8(kf,kp0+sl_cur);
  WAIT_BAR(2);
  s16x4 vlo[8],vhi[8]; u32x4 pw0,pw1,pw2,pw3;
  #define PKW(P,B) cvtpk_s(P[B],P[B+1])
  #define PAF(k) __builtin_bit_cast(bf16x8,pw##k)
  #define VFR(i) (bf16x8){vlo[i][0],vlo[i][1],vlo[i][2],vlo[i][3],vhi[i][0],vhi[i][1],vhi[i][2],vhi[i][3]}
  #define PIN(x) asm volatile("":"+v"(x))
  #define MX3(a,b,c) __builtin_fmaxf(__builtin_fmaxf((a),(b)),(c))
  #define GAPA(MF,A0,A1,A2,A3,W0,W1,PW) do{ MF; sacc+=A0; sacc+=A1; sacc+=A2; sacc+=A3; PIN(sacc); W0; W1; PIN(PW); SBAR(); }while(0)
  #define EX(v) __builtin_amdgcn_exp2f(v)
  #define GAPB(MF,X,B) do{ MF; X[B]=EX(X[B]); X[B+1]=EX(X[B+1]); X[B+2]=EX(X[B+2]); X[B+3]=EX(X[B+3]); PIN(X); SBAR(); }while(0)
  #define VRD(i) do{ vlo[i]=vtr(vp_+(((i)>>2)*4096+((i)&3)*1024)); vhi[i]=vtr(vp_+(((i)>>2)*4096+((i)&3)*1024+512)); }while(0)
  #define KRD(G,j) do{ if(G){ kload2(kf,kp0+sl_next,j); SBAR(); } }while(0)
  #define STEP(C0,C1,P0,P1,t,GK,GV,GL) do{ CINIT(C0,C1,t); SBAR(); \
    const lds_cptr vp_=vp0+sl_prev; \
    VRD(0); SBAR(); float sacc=(P0[0]+P0[1]); \
    GAPA(C0=__builtin_amdgcn_mfma_f32_32x32x16_bf16(kf[0],qr[0],C0,0,0,0), P0[2],P0[3],P0[4],P0[5],     pw0[0]=PKW(P0,0), pw0[1]=PKW(P0,2), pw0); \
    VRD(4); SBAR(); GAPA(C1=__builtin_amdgcn_mfma_f32_32x32x16_bf16(kf[1],qr[0],C1,0,0,0), P0[6],P0[7],P0[8],P0[9],     pw0[2]=PKW(P0,4), pw0[3]=PKW(P0,6), pw0); \
    VRD(1); SBAR(); GAPA(C0=__builtin_amdgcn_mfma_f32_32x32x16_bf16(kf[2],qr[1],C0,0,0,0),   P0[10],P0[11],P0[12],P0[13], pw1[0]=PKW(P0,8), pw1[1]=PKW(P0,10), pw1); \
    VRD(5); SBAR(); GAPA(C1=__builtin_amdgcn_mfma_f32_32x32x16_bf16(kf[3],qr[1],C1,0,0,0),   P0[14],P0[15],P1[0],P1[1],   pw1[2]=PKW(P0,12),pw1[3]=PKW(P0,14), pw1); \
    VRD(2); SBAR(); GAPA(C0=__builtin_amdgcn_mfma_f32_32x32x16_bf16(kf[4],qr[2],C0,0,0,0),   P1[2],P1[3],P1[4],P1[5],     pw2[0]=PKW(P1,0), pw2[1]=PKW(P1,2), pw2); \
    VRD(6); SBAR(); GAPA(C1=__builtin_amdgcn_mfma_f32_32x32x16_bf16(kf[5],qr[2],C1,0,0,0),   P1[6],P1[7],P1[8],P1[9],     pw2[2]=PKW(P1,4), pw2[3]=PKW(P1,6), pw2); \
    VRD(3); SBAR(); GAPA(C0=__builtin_amdgcn_mfma_f32_32x32x16_bf16(kf[6],qr[3],C0,0,0,0),   P1[10],P1[11],P1[12],P1[13], pw3[0]=PKW(P1,8), pw3[1]=PKW(P1,10), pw3); \
    VRD(7); SBAR(); GAPA(C1=__builtin_amdgcn_mfma_f32_32x32x16_bf16(kf[7],qr[3],C1,0,0,0),   P1[14],P1[15],0.f,0.f,       pw3[2]=PKW(P1,12),pw3[3]=PKW(P1,14), pw3); \
    l_reg+=sacc; \
    if(GK){DMA_K((t)+3,sl_cur);} if(GV){DMA_V((t)+1,sl_next);} \
    { float a=MX3(C0[0],C0[1],C1[0]),b=MX3(C0[2],C0[3],C1[1]); a=MX3(a,C1[2],C1[3]); \
      _Pragma("unroll") for(int r=4;r<16;r+=4){a=MX3(a,C0[r],C0[r+1]);b=MX3(b,C0[r+2],C0[r+3]);a=MX3(a,C1[r],C1[r+1]);b=MX3(b,C1[r+2],C1[r+3]);} \
      float rm=__builtin_fmaxf(a,b); { auto rr=__builtin_amdgcn_permlane32_swap(__float_as_uint(rm),__float_as_uint(rm),false,false); rm=__builtin_fmaxf(__uint_as_float(rr[0]),__uint_as_float(rr[1])); } \
      resc=false; \
      if(__builtin_expect(__any(rm>(float)THRL),0)){ const float dl=__builtin_fmaxf(rm,0.f); mhat+=dl; \
        _Pragma("unroll") for(int r=0;r<16;++r){C0[r]-=dl;C1[r]-=dl;} \
        const float f=__builtin_amdgcn_exp2f(-dl); l_reg*=f; if(hi==0)wsf[r32]=f; resc=true; } } \
    SBAR(); \
    GAPB(o[0]=__builtin_amdgcn_mfma_f32_32x32x16_bf16(PAF(0),VFR(0),o[0],0,0,0), C0,0); \
    GAPB(o[1]=__builtin_amdgcn_mfma_f32_32x32x16_bf16(PAF(0),VFR(4),o[1],0,0,0), C0,4); \
    KRD(GL,0); GAPB(o[0]=__builtin_amdgcn_mfma_f32_32x32x16_bf16(PAF(1),VFR(1),o[0],0,0,0), C0,8); \
    KRD(GL,1); GAPB(o[1]=__builtin_amdgcn_mfma_f32_32x32x16_bf16(PAF(1),VFR(5),o[1],0,0,0), C0,12); \
    KRD(GL,2); GAPB(o[0]=__builtin_amdgcn_mfma_f32_32x32x16_bf16(PAF(2),VFR(2),o[0],0,0,0), C1,0); \
    KRD(GL,3); GAPB(o[1]=__builtin_amdgcn_mfma_f32_32x32x16_bf16(PAF(2),VFR(6),o[1],0,0,0), C1,4); \
    GAPB(o[0]=__builtin_amdgcn_mfma_f32_32x32x16_bf16(PAF(3),VFR(3),o[0],0,0,0), C1,8); \
    GAPB(o[1]=__builtin_amdgcn_mfma_f32_32x32x16_bf16(PAF(3),VFR(7),o[1],0,0,0), C1,12); \
    }while(0)
  int t=1;
  for(;t+5<NT;t+=2){
    STEP(pB0,pB1,pA0,pA1,t,true,true,true);     WAIT_BAR(2); RESC(); ROT();
    STEP(pA0,pA1,pB0,pB1,t+1,true,true,true);   WAIT_BAR(2); RESC(); ROT();
  }
  #define ENDW(tt) do{ if((tt)+3<NT){WAIT_BAR(2);} else if((tt)+2<NT){WAIT_BAR(1);} else {WAIT_BAR(0);} }while(0)
  for(;t+1<NT;t+=2){
    STEP(pB0,pB1,pA0,pA1,t,(t+3<NT),(t+1<NT),(t+1<NT));       ENDW(t);   RESC(); ROT();
    STEP(pA0,pA1,pB0,pB1,t+1,(t+4<NT),(t+2<NT),(t+2<NT));     ENDW(t+1); RESC(); ROT();
  }
  STEP(pB0,pB1,pA0,pA1,NT-1,false,false,false); RESC();
  { float sacc=pB0[0]+pB0[1]; _Pragma("unroll") for(int r=2;r<16;++r)sacc+=pB0[r]; _Pragma("unroll") for(int r=0;r<16;++r)sacc+=pB1[r]; l_reg+=sacc;
    pw0=(u32x4){PKW(pB0,0),PKW(pB0,2),PKW(pB0,4),PKW(pB0,6)};pw1=(u32x4){PKW(pB0,8),PKW(pB0,10),PKW(pB0,12),PKW(pB0,14)};pw2=(u32x4){PKW(pB1,0),PKW(pB1,2),PKW(pB1,4),PKW(pB1,6)};pw3=(u32x4){PKW(pB1,8),PKW(pB1,10),PKW(pB1,12),PKW(pB1,14)};
    SBAR(); pv(o,vb0+sl_cur,PAF(0),PAF(1),PAF(2),PAF(3)); }
  #undef PKW
  #undef PAF
  #undef VFR
  #undef PIN
  #undef MX3
  #undef GAPA
  #undef GAPB
  #undef EX
  #undef VRD
  #undef KRD
  #undef STEP
  #undef ENDW
  {auto rr=__builtin_amdgcn_permlane32_swap(__float_as_uint(l_reg),__float_as_uint(l_reg),false,false);l_reg=__uint_as_float(rr[0])+__uint_as_float(rr[1]);}
  if(hi==0)wsf[32+r32]=l_reg;asm volatile("s_waitcnt lgkmcnt(0)":::"memory");
  float rli[16];
  #pragma unroll
  for(int r=0;r<16;++r)rli[r]=__builtin_amdgcn_rcpf(wsf[32+crow(r,hi)]);
  bf16*Ow=O+(rowbase+q0+wid*QBLK)*1024+h*D; const bf16*Gw=GA+(rowbase+q0+wid*QBLK)*DM+h*D;
  { bf16*stg=(bf16*)(shm+LDS_OST)+wid*2048;
    #pragma unroll
    for(int r=0;r<16;++r){const int orow=crow(r,hi);
      #pragma unroll
      for(int d0=0;d0<2;++d0)stg[orow*64+d0*32+r32]=__float2bfloat16(o[d0][r]*rli[r]);}
    asm volatile("s_waitcnt lgkmcnt(0)":::"memory");
    #pragma unroll
    for(int i=0;i<4;++i){const int row=i*8+(lane>>3),ch=lane&7; const u32x4 v=*(const u32x4*)(stg+row*64+ch*8); const u32x4 g=*(const u32x4*)(Gw+(long)row*DM+ch*8); u32x4 w;
      #pragma unroll
      for(int k=0;k<4;++k){ const float lo=__uint_as_float(v[k]<<16)*__uint_as_float(g[k]<<16), hh=__uint_as_float(v[k]&0xffff0000u)*__uint_as_float(g[k]&0xffff0000u); w[k]=cvtpk_s(lo,hh); }
      ATTN_STORE16(Ow+(long)row*1024+ch*8,w);} }
  asm volatile("s_waitcnt lgkmcnt(0)\n\ts_barrier":::"memory");
  #undef DMA_K
  #undef PHYS
  #undef DMA_V
  #undef CINIT
  #undef START
  #undef RESC
  #undef ROT
}
constexpr int ATTN_LDS_BYTES=LDS_TOTAL;
#undef SBAR
#undef WAIT_BAR
}
#define XB_TMO      128
#define XB_XCNT(j)  (256  + 64 * (j))
#define XB_XSUB(j)  (1280 + 64 * (j))
#define XB_XGEN(j)  (2304 + 64 * (j))
#define XB_TOP      3328
#define XB_TOPGEN   3392
#define XCD_BAR_WORDS 3456
#define XB_SPIN_CAP (1u << 18)

__device__ __forceinline__ unsigned xb_ld(unsigned* p)              { return __hip_atomic_load(p, __ATOMIC_RELAXED, __HIP_MEMORY_SCOPE_AGENT); }
__device__ __forceinline__ unsigned xb_add(unsigned* p, unsigned v) { return __hip_atomic_fetch_add(p, v, __ATOMIC_RELAXED, __HIP_MEMORY_SCOPE_AGENT); }
__device__ __forceinline__ unsigned xb_xcc_id() { return (unsigned)__builtin_amdgcn_s_getreg((3 << 11) | 20) & 0xFu; }
#define XB_SPIN(cond, bar) do { unsigned _sp = 0; while (cond) { __builtin_amdgcn_s_sleep(1); \
    if ((++_sp & 255u) == 0u) { if (xb_ld(&(bar)[XB_TMO])) break; if (_sp > XB_SPIN_CAP) { atomicAdd(&(bar)[XB_TMO], 1u); break; } } } } while (0)

struct XcdBarrier {
    unsigned* bar; unsigned x;
    volatile LAS unsigned* st;
};

__device__ __forceinline__ XcdBarrier xcd_barrier_post(unsigned* bar, volatile LAS unsigned* st) {
    XcdBarrier b; b.bar = bar; b.x = xb_xcc_id(); b.st = st;
    if (threadIdx.x == 0) (void)xb_add(&bar[XB_XCNT(b.x)], 1u);
    return b;
}
__device__ __forceinline__ void xcd_barrier_complete(unsigned* bar, unsigned x, unsigned& nloc, unsigned& nx) {
    const unsigned G = gridDim.x * gridDim.y * gridDim.z;
    unsigned sum, cnt, mine, sp = 0u;
    for (;;) {
        sum = 0u; cnt = 0u; mine = 0u;
#pragma unroll
        for (unsigned j = 0; j < 16; ++j) { const unsigned c = xb_ld(&bar[XB_XCNT(j)]); sum += c; cnt += (c > 0u) ? 1u : 0u; mine = (j == x) ? c : mine; }
        if (sum == G) break;
        __builtin_amdgcn_s_sleep(1);
        if ((++sp & 255u) == 0u) { if (xb_ld(&bar[XB_TMO])) break; if (sp > XB_SPIN_CAP) { atomicAdd(&bar[XB_TMO], 1u); break; } }
    }
    nloc = mine > 0u ? mine : 1u; nx = cnt > 0u ? cnt : 1u;
}

__device__ __forceinline__ void xcd_barrier(const XcdBarrier& b) {
    asm volatile("s_waitcnt vmcnt(0)" ::: "memory");
    __syncthreads();
    if (threadIdx.x == 0) {
        unsigned* bar = b.bar;
        __builtin_amdgcn_s_waitcnt(0);
        unsigned nloc = b.st[0], nx = b.st[1];
        if (nloc == 0u) { xcd_barrier_complete(bar, b.x, nloc, nx); b.st[0] = nloc; b.st[1] = nx; }
        const unsigned old = xb_add(&bar[XB_XSUB(b.x)], 1u);
        const unsigned gen = old / nloc;
        if (old + 1u == (gen + 1u) * nloc) {
            __builtin_amdgcn_fence(__ATOMIC_RELEASE, "agent");
            asm volatile("s_waitcnt vmcnt(0)" ::: "memory");
            const unsigned og = xb_add(&bar[XB_TOP], 1u);
            const unsigned tg = og / nx;
            if (og + 1u == (tg + 1u) * nx) xb_add(&bar[XB_TOPGEN], 1u);
            else XB_SPIN(xb_ld(&bar[XB_TOPGEN]) == tg, bar);
            __builtin_amdgcn_fence(__ATOMIC_ACQUIRE, "agent");
            asm volatile("s_waitcnt vmcnt(0)" ::: "memory");
        } else {
            XB_SPIN(xb_ld(&bar[XB_TOPGEN]) == gen, bar);
            __builtin_amdgcn_fence(__ATOMIC_ACQUIRE, "agent");
            asm volatile("s_waitcnt vmcnt(0)" ::: "memory");
        }
    }
    __syncthreads();
}

struct Frame {
    unsigned char* lds;
    int tid, lane, wave, G;
    float* out; unsigned char* ws;
};
#define WSP(T, off) ((T*)(F.ws + (off)))

struct EpiZ {
    static constexpr bool PERM = true, AFTER_DRAIN = false;
    bf16* O; int ldc; float* dt;
    __device__ __forceinline__ void operator()(const pg8::f32x4 (&acc)[2][2][4][2], const pg8::Unit& u, int wr_, int wc_, int fr_, int fq_) const {
        int tz_ = threadIdx.x; asm volatile("" : "+v"(tz_));
        const int fr = tz_ & 15, fq = (tz_ & 63) >> 4, wid_ = __builtin_amdgcn_readfirstlane(tz_ >> 6), wr = wid_ >> 2, wc = wid_ & 3; (void)wr_; (void)wc_; (void)fr_; (void)fq_;
        const int row0 = u.pm * 256 + wr * 64 + fr, col0 = u.pn * 256 + wc * 32 + 8 * fq;
#pragma unroll
        for (int ai = 0; ai < 2; ++ai)
#pragma unroll
            for (int m = 0; m < 4; ++m) { const int row = row0 + ai * 128 + m * 16; bf16* rp = O + (size_t)row * ldc + col0;
#pragma unroll
                for (int bj = 0; bj < 2; ++bj) { const pg8::f32x4 v0 = acc[ai][bj][m][0], v1 = acc[ai][bj][m][1];
                    v4u w; w.x = pg8::cvt_pk_bf16(v0[0], v0[1]); w.y = pg8::cvt_pk_bf16(v0[2], v0[3]); w.z = pg8::cvt_pk_bf16(v1[0], v1[1]); w.w = pg8::cvt_pk_bf16(v1[2], v1[3]);
                    *(v4u*)(rp + bj * 128) = w;
                    if (dt != nullptr && bj == 0 && col0 == YDT) { *(f32x4*)(dt + (size_t)row * 8) = v0; *(f32x4*)(dt + (size_t)row * 8 + 4) = v1; } } }
    }
};
template <bool XB16, bool OB16> struct EpiRes {
    static constexpr bool PERM = true, AFTER_DRAIN = false;
    const void* xp; const void* xs; const float* mod; void* out;
    __device__ __forceinline__ void operator()(const pg8::f32x4 (&acc)[2][2][4][2], const pg8::Unit& u, int wr_, int wc_, int fr_, int fq_) const {
        int tz_ = threadIdx.x; asm volatile("" : "+v"(tz_));
        const int fr = tz_ & 15, fq = (tz_ & 63) >> 4, wid_ = __builtin_amdgcn_readfirstlane(tz_ >> 6), wr = wid_ >> 2, wc = wid_ & 3; (void)wr_; (void)wc_; (void)fr_; (void)fq_;
        const int row0 = u.pm * 256 + wr * 64 + fr, col0 = u.pn * 256 + wc * 32 + 8 * fq;
        const float* gr = mod + (size_t)(u.pm >> 4) * 3072 + 2048; const void* xb = xp;
        f32x4 gv[2][2];
#pragma unroll
        for (int bj = 0; bj < 2; ++bj) { gv[bj][0] = *(const f32x4*)(gr + col0 + bj * 128); gv[bj][1] = *(const f32x4*)(gr + col0 + bj * 128 + 4); }
#pragma unroll
        for (int ai = 0; ai < 2; ++ai)
#pragma unroll
            for (int m = 0; m < 4; ++m) { const int row = row0 + ai * 128 + m * 16;
                const size_t xo = (size_t)row * DM;
#pragma unroll
                for (int bj = 0; bj < 2; ++bj) { const int c = col0 + bj * 128; float x8[8];
                    if (XB16) unpack8(*(const v4u*)((const bf16*)xb + xo + c), x8);
                    else { const f32x4 x0 = *(const f32x4*)((const float*)xb + xo + c), x1 = *(const f32x4*)((const float*)xb + xo + c + 4); x8[0] = x0.x; x8[1] = x0.y; x8[2] = x0.z; x8[3] = x0.w; x8[4] = x1.x; x8[5] = x1.y; x8[6] = x1.z; x8[7] = x1.w; }
                    const f32x4 g0 = gv[bj][0], g1 = gv[bj][1]; const pg8::f32x4 a0 = acc[ai][bj][m][0], a1 = acc[ai][bj][m][1];
                    float o[8] = {x8[0] + g0.x * a0[0], x8[1] + g0.y * a0[1], x8[2] + g0.z * a0[2], x8[3] + g0.w * a0[3], x8[4] + g1.x * a1[0], x8[5] + g1.y * a1[1], x8[6] + g1.z * a1[2], x8[7] + g1.w * a1[3]};
                    if (OB16) *(v4u*)((bf16*)out + (size_t)row * DM + c) = pack8(o);
                    else { float* op = (float*)out + (size_t)row * DM + c; *(f32x4*)(op) = (f32x4){o[0], o[1], o[2], o[3]}; *(f32x4*)((op + 4)) = (f32x4){o[4], o[5], o[6], o[7]}; } } }
    }
};

template <bool PERMQK> __device__ __forceinline__ void transpose_item(const float* W, int K, int N, int Npad, bf16* WT, float* scr, int item, int lane) {
    const int nblk = Npad / 32, kb = item / nblk, nb = item % nblk, k0 = 64 * kb, n0 = 32 * nb;
    int nn = n0 + (lane & 31);
    if (PERMQK && nn >= ZQB && nn < ZVB) { const int p = nn & 63; nn = (nn & ~63) + (p >> 1) + 32 * (p & 1); }
#pragma unroll 8
    for (int i = 0; i < 32; ++i) { const int kk = 2 * i + (lane >> 5); scr[kk * 33 + (lane & 31)] = (nn < N) ? W[(size_t)(k0 + kk) * N + nn] : 0.f; }
    asm volatile("s_waitcnt lgkmcnt(0)" ::: "memory");
    const int c = lane & 7;
#pragma unroll
    for (int j = 0; j < 4; ++j) { const int n = (lane >> 3) + 8 * j; const float* s = scr + (8 * c) * 33 + n;
        v4u o; o.x = pk2(s[0 * 33], s[1 * 33]); o.y = pk2(s[2 * 33], s[3 * 33]); o.z = pk2(s[4 * 33], s[5 * 33]); o.w = pk2(s[6 * 33], s[7 * 33]);
        *(v4u*)(WT + (size_t)(n0 + n) * K + k0 + 8 * c) = o; }
    asm volatile("s_waitcnt lgkmcnt(0)" ::: "memory");
}
__device__ __forceinline__ void weights_phase(Frame& F, int nwg) {
    if ((int)blockIdx.x >= nwg) return;
    const int gw = blockIdx.x * NWAVES + F.wave, NGW = nwg * NWAVES;
    float* scr = (float*)(F.lds + F.wave * 8704);
    constexpr int I_EIN = 16 * (NE / 32), I_EOUT = 16 * 32, I_OIN = 16 * (NOP / 32), I_OOUT = 16 * 32;
    for (int it = gw; it < I_EIN + I_EOUT + I_OIN + I_OOUT; it += NGW) {
        int r = it;
        if (r < I_EIN) { transpose_item<true>(INP(14), DM, NE, NE, WSP(bf16, WS_WINE), scr, r, F.lane); continue; } r -= I_EIN;
        if (r < I_EOUT) { transpose_item<false>(INP(17), DM, DM, DM, WSP(bf16, WS_WOUTE), scr, r, F.lane); continue; } r -= I_EOUT;
        if (r < I_OIN) { transpose_item<false>(INP(21), DM, NO, NOP, WSP(bf16, WS_WINO), scr, r, F.lane); continue; } r -= I_OIN;
        transpose_item<false>(INP(30), DM, DM, DM, WSP(bf16, WS_WOUTO), scr, r, F.lane);
    }
}
__device__ __forceinline__ void rope_phase(Frame& F) {
    f32x2* rope = WSP(f32x2, WS_ROPE);
    for (int e = blockIdx.x * NTHR + F.tid; e < 4096 * 32; e += F.G * NTHR) { const int pos = e >> 5, i = e & 31;
        const float inv = exp2f(-(float)i * (13.287712379549449f / 32.f));
        const double turns = (double)((float)pos * inv) * 0.15915494309189535;
        const float fr = (float)(turns - floor(turns));
        f32x2 cs; cs.x = __builtin_amdgcn_cosf(fr); cs.y = __builtin_amdgcn_sinf(fr); rope[e] = cs; }
}
template <bool XB16> __device__ __forceinline__ void normmod_phase(Frame& F, const void* xp, const void* xs, const float* nw, const float* mod) {
    const int gw = blockIdx.x * NWAVES + F.wave, NGW = F.G * NWAVES; bf16* H = WSP(bf16, WS_H);
    f32x4 w4[4];
#pragma unroll
    for (int j = 0; j < 4; ++j) w4[j] = *(const f32x4*)(nw + 4 * F.lane + 256 * j);
    for (int r = gw; r < MR; r += NGW) {
        const size_t xo = (r < TP) ? (size_t)r * DM : (size_t)(r - TP) * DM; const void* xb = (r < TP) ? xp : xs; const float* mr = mod + (size_t)mod_row(r) * 3072;
        f32x4 v[4], sh[4], scl[4]; float s = 0.f;
#pragma unroll
        for (int j = 0; j < 4; ++j) { const int c = 4 * F.lane + 256 * j;
            if (XB16) { const v2u w = *(const v2u*)((const bf16*)xb + xo + c); v[j] = (f32x4){bf2f(w.x & 0xffffu), __uint_as_float(w.x & 0xffff0000u), bf2f(w.y & 0xffffu), __uint_as_float(w.y & 0xffff0000u)}; }
            else v[j] = *(const f32x4*)((const float*)xb + xo + c);
            sh[j] = *(const f32x4*)(mr + c); scl[j] = *(const f32x4*)(mr + 1024 + c); }
#pragma unroll
        for (int j = 0; j < 4; ++j) s += (v[j].x * v[j].x + v[j].y * v[j].y) + (v[j].z * v[j].z + v[j].w * v[j].w);
        const float rstd = rsqrtf(wave_sum(s) * (1.f / DM) + EPS);
#pragma unroll
        for (int j = 0; j < 4; ++j) { const int c = 4 * F.lane + 256 * j; const f32x4 w = w4[j];
            const float a = v[j].x * rstd * w.x * (1.f + scl[j].x) + sh[j].x, b = v[j].y * rstd * w.y * (1.f + scl[j].y) + sh[j].y, cc = v[j].z * rstd * w.z * (1.f + scl[j].z) + sh[j].z, d = v[j].w * rstd * w.w * (1.f + scl[j].w) + sh[j].w;
            v2u o; o.x = pk2(a, b); o.y = pk2(cc, d); *(v2u*)(H + (size_t)r * DM + c) = o; }
    }
}
struct EpiL0 {
    static constexpr bool PERM = true, AFTER_DRAIN = false;
    bf16* Z; float* out; const float* qw; const float* kw; const f32x2* rope; float* kmean; float* xs;
    __device__ __forceinline__ void store8(bf16* p, const float* f) const { v4u w; w.x = pg8::cvt_pk_bf16(f[0], f[1]); w.y = pg8::cvt_pk_bf16(f[2], f[3]); w.z = pg8::cvt_pk_bf16(f[4], f[5]); w.w = pg8::cvt_pk_bf16(f[6], f[7]); *(v4u*)p = w; }
    __device__ __forceinline__ void operator()(const pg8::f32x4 (&acc)[2][2][4][2], const pg8::Unit& u, int wr_, int wc_, int fr_, int fq_) const {
        int tz_ = threadIdx.x; asm volatile("" : "+v"(tz_));
        const int fr = tz_ & 15, fq = (tz_ & 63) >> 4, wid_ = __builtin_amdgcn_readfirstlane(tz_ >> 6), wr = wid_ >> 2, wc = wid_ & 3; (void)wr_; (void)wc_; (void)fr_; (void)fq_;
        const int pn = u.pn, rl0 = wr * 64 + fr, cw = wc * 32 + 8 * fq, col0 = pn * 256 + cw;
        if (pn < 4) {
            const bool isk = pn >= 2; const float* nw = isk ? kw : qw; const int ch = cw & 63;
            float w8[8];
#pragma unroll
            for (int j = 0; j < 8; ++j) w8[j] = nw[ch + j];
#pragma unroll
            for (int ai = 0; ai < 2; ++ai)
#pragma unroll
                for (int bj = 0; bj < 2; ++bj)
#pragma unroll
                    for (int m = 0; m < 4; ++m) { const pg8::f32x4 v0 = acc[ai][bj][m][0], v1 = acc[ai][bj][m][1];
                        float s = (v0[0] * v0[0] + v0[1] * v0[1]) + (v0[2] * v0[2] + v0[3] * v0[3]) + (v1[0] * v1[0] + v1[1] * v1[1]) + (v1[2] * v1[2] + v1[3] * v1[3]);
                        s += __shfl_xor(s, 16); s += __shfl_xor(s, 32);
                        if (fq == 0) xs[(ai * 128 + rl0 + m * 16) * 8 + bj * 4 + wc] = s; }
            asm volatile("s_waitcnt lgkmcnt(0)" ::: "memory"); __builtin_amdgcn_s_barrier(); asm volatile("" ::: "memory");
            float cs[2][8];
#pragma unroll
            for (int bj = 0; bj < 2; ++bj)
#pragma unroll
                for (int j = 0; j < 8; ++j) cs[bj][j] = 0.f;
#pragma unroll
            for (int ai = 0; ai < 2; ++ai)
#pragma unroll
                for (int m = 0; m < 4; ++m) { const int rl = ai * 128 + rl0 + m * 16, row = u.pm * 256 + rl;
#pragma unroll
                    for (int bj = 0; bj < 2; ++bj) { const float tot = xs[rl * 8 + bj * 4 + wc] + xs[rl * 8 + bj * 4 + (wc ^ 1)];
                        float rs = rsqrtf(tot * (1.f / 64.f) + EPS); if (!isk && row < TP) rs *= attn_body::C2;
                        const pg8::f32x4 v0 = acc[ai][bj][m][0], v1 = acc[ai][bj][m][1];
                        float f[8] = {v0[0] * rs * w8[0], v0[1] * rs * w8[1], v0[2] * rs * w8[2], v0[3] * rs * w8[3], v1[0] * rs * w8[4], v1[1] * rs * w8[5], v1[2] * rs * w8[6], v1[3] * rs * w8[7]};
                        store8(Z + (size_t)row * NE + col0 + bj * 128, f);
                        if (isk) { float* ko = ((row < TP) ? out + O_KP + (size_t)row * 512 : out + O_KS + (size_t)(row - TP) * 512) + (pn - 2) * 256 + bj * 128 + cw;
                            *(f32x4*)(ko) = (f32x4){f[0], f[1], f[2], f[3]}; *(f32x4*)((ko + 4)) = (f32x4){f[4], f[5], f[6], f[7]};
#pragma unroll
                            for (int j = 0; j < 8; ++j) cs[bj][j] += f[j]; } } }
            if (isk && u.pm < TP / 256) { float* ks = xs + 2048;
#pragma unroll
                for (int bj = 0; bj < 2; ++bj)
#pragma unroll
                    for (int j = 0; j < 8; ++j) { float v = cs[bj][j]; v += __shfl_xor(v, 1); v += __shfl_xor(v, 2); v += __shfl_xor(v, 4); v += __shfl_xor(v, 8); cs[bj][j] = v;
                        if (wr == 1 && fr == 0) ks[bj * 128 + cw + j] = v; }
                asm volatile("s_waitcnt lgkmcnt(0)" ::: "memory"); __builtin_amdgcn_s_barrier(); asm volatile("" ::: "memory");
                if (wr == 0 && fr == 0) {
#pragma unroll
                    for (int bj = 0; bj < 2; ++bj)
#pragma unroll
                        for (int j = 0; j < 8; ++j) kmean[(size_t)u.pm * 512 + (pn - 2) * 256 + bj * 128 + cw + j] = (cs[bj][j] + ks[bj * 128 + cw + j]) * (1.f / 256.f); } }
        } else if (pn == 8 || pn == 9) {
            const float sc = (pn == 9) ? 0.125f : 1.f; const int i0 = (cw & 63) >> 1;
#pragma unroll
            for (int ai = 0; ai < 2; ++ai)
#pragma unroll
                for (int m = 0; m < 4; ++m) { const int row = u.pm * 256 + ai * 128 + rl0 + m * 16; const f32x2* rp = rope + pos_of(row) * 32 + i0;
                    const f32x4 r01 = *(const f32x4*)rp, r23 = *(const f32x4*)(rp + 2);
#pragma unroll
                    for (int bj = 0; bj < 2; ++bj) { const pg8::f32x4 v0 = acc[ai][bj][m][0], v1 = acc[ai][bj][m][1];
                        float f[8] = {(v0[0] * r01.x - v0[1] * r01.y) * sc, (v0[0] * r01.y + v0[1] * r01.x) * sc, (v0[2] * r01.z - v0[3] * r01.w) * sc, (v0[2] * r01.w + v0[3] * r01.z) * sc,
                                      (v1[0] * r23.x - v1[1] * r23.y) * sc, (v1[0] * r23.y + v1[1] * r23.x) * sc, (v1[2] * r23.z - v1[3] * r23.w) * sc, (v1[2] * r23.w + v1[3] * r23.z) * sc};
                        store8(Z + (size_t)row * NE + col0 + bj * 128, f); } }
        } else {
            const bool act = (pn == 6 || pn == 7 || pn >= 12), isv = (pn == 4 || pn == 5);
#pragma unroll
            for (int ai = 0; ai < 2; ++ai)
#pragma unroll
                for (int m = 0; m < 4; ++m) { const int row = u.pm * 256 + ai * 128 + rl0 + m * 16;
#pragma unroll
                    for (int bj = 0; bj < 2; ++bj) { const pg8::f32x4 v0 = acc[ai][bj][m][0], v1 = acc[ai][bj][m][1];
                        float f[8] = {v0[0], v0[1], v0[2], v0[3], v1[0], v1[1], v1[2], v1[3]};
                        if (act) {
#pragma unroll
                            for (int j = 0; j < 8; ++j) f[j] = silu_f(f[j]); }
                        store8(Z + (size_t)row * NE + col0 + bj * 128, f);
                        if (isv) { float* vo = ((row < TP) ? out + O_VP + (size_t)row * 512 : out + O_VS + (size_t)(row - TP) * 512) + (pn - 4) * 256 + bj * 128 + cw;
                            *(f32x4*)(vo) = (f32x4){f[0], f[1], f[2], f[3]}; *(f32x4*)((vo + 4)) = (f32x4){f[4], f[5], f[6], f[7]}; } } }
        }
    }
};
__device__ __forceinline__ float ret_log2g(int h) { return log2f(1.f - exp2f(-5.f - (float)h)); }
__device__ __forceinline__ void smp_pass1_item(Frame& F, int item) {
    const int n = item & 7, b = item >> 3; const bf16* Z = WSP(bf16, WS_Z); const float* ck = INP(2); const int* pt = (const int*)INP(7);
    float* scs = (float*)F.lds;
    float* red = scs + 32 * 256;
    int tz_ = threadIdx.x; asm volatile("" : "+v"(tz_));
    const int tid_ = tz_, lane = tz_ & 63, wave_ = __builtin_amdgcn_readfirstlane(tz_ >> 6), c4 = lane * 4;
    float q[4][8];
#pragma unroll
    for (int t = 0; t < 4; ++t) { const bf16* qr = Z + (size_t)(TP + b * 4 + t) * NE + ZQA + c4; const uint2 lo = *(const uint2*)qr, hi = *(const uint2*)(qr + 256);
        q[t][0] = __uint_as_float(lo.x << 16); q[t][1] = __uint_as_float(lo.x & 0xffff0000u); q[t][2] = __uint_as_float(lo.y << 16); q[t][3] = __uint_as_float(lo.y & 0xffff0000u);
        q[t][4] = __uint_as_float(hi.x << 16); q[t][5] = __uint_as_float(hi.x & 0xffff0000u); q[t][6] = __uint_as_float(hi.y << 16); q[t][7] = __uint_as_float(hi.y & 0xffff0000u); }
    float ks[8];
#pragma unroll
    for (int i = 0; i < 8; ++i) ks[i] = 0.f;
    const int pg0 = pt[b * NPAGES + 2 * n], pg1 = pt[b * NPAGES + 2 * n + 1];
    __syncthreads();
    f32x4 ka0[4], kb0[4], ka1[4], kb1[4], ka2[4], kb2[4];
    const __amdgpu_buffer_rsrc_t krs = __builtin_amdgcn_make_buffer_rsrc((void*)ck, (short)0, (int)((size_t)NPHYS * PAGE * 512 * 4), 0x00020000);
    const int kvo = lane * 16, pgu0 = __builtin_amdgcn_readfirstlane(pg0), pgu1 = __builtin_amdgcn_readfirstlane(pg1);
#define P1_LOAD(KA, KB, bt) do { const int so_ = ((((bt) < 4) ? pgu0 : pgu1) * PAGE + wave_ + 32 * ((bt) & 3)) * 2048; \
        _Pragma("unroll") for (int u = 0; u < 4; ++u) { KA[u] = __builtin_bit_cast(f32x4, __builtin_amdgcn_raw_buffer_load_b128(krs, kvo, so_ + u * 16384, 2)); \
                                                         KB[u] = __builtin_bit_cast(f32x4, __builtin_amdgcn_raw_buffer_load_b128(krs, kvo + 1024, so_ + u * 16384, 2)); } } while (0)
#define P1_COMP(KA, KB, bt) do { _Pragma("unroll") for (int u = 0; u < 4; ++u) { const int r = wave_ + 8 * (4 * (bt) + u); \
        const float k[8] = {KA[u].x, KA[u].y, KA[u].z, KA[u].w, KB[u].x, KB[u].y, KB[u].z, KB[u].w}; \
        _Pragma("unroll") for (int i = 0; i < 8; ++i) ks[i] += k[i]; \
        _Pragma("unroll") for (int t = 0; t < 4; ++t) { float s0 = (q[t][0] * k[0] + q[t][1] * k[1]) + (q[t][2] * k[2] + q[t][3] * k[3]), s1 = (q[t][4] * k[4] + q[t][5] * k[5]) + (q[t][6] * k[6] + q[t][7] * k[7]); \
            s0 = red16_dpp(s0); s1 = red16_dpp(s1); \
            if ((lane & 15) == 0) { scs[((lane >> 4) * 4 + t) * 256 + r] = s0; scs[((4 + (lane >> 4)) * 4 + t) * 256 + r] = s1; } } } } while (0)
#define P1_SB __builtin_amdgcn_sched_barrier(0)
    P1_LOAD(ka0, kb0, 0); P1_LOAD(ka1, kb1, 1); P1_SB;
#pragma unroll 1
    for (int bt = 0; bt < 6; bt += 3) {
        P1_LOAD(ka2, kb2, bt + 2); P1_SB; P1_COMP(ka0, kb0, bt);     P1_SB;
        P1_LOAD(ka0, kb0, bt + 3); P1_SB; P1_COMP(ka1, kb1, bt + 1); P1_SB;
        P1_LOAD(ka1, kb1, bt + 4); P1_SB; P1_COMP(ka2, kb2, bt + 2); P1_SB;
    }
    P1_COMP(ka0, kb0, 6); P1_SB; P1_COMP(ka1, kb1, 7); P1_SB;
#undef P1_SB
#undef P1_LOAD
#undef P1_COMP
#pragma unroll
    for (int i = 0; i < 8; ++i) red[wave_ * 512 + (i >> 2) * 256 + c4 + (i & 3)] = ks[i];
    __syncthreads();
    { float s = 0.f;
#pragma unroll
      for (int w = 0; w < 8; ++w) s += red[w * 512 + tid_];
      WSP(float, WS_KMS)[(size_t)(b * 8 + n) * 512 + tid_] = s * (1.f / 256.f); }
    float* SC = WSP(float, WS_SC);
    for (int e = tid_; e < 32 * 256; e += NTHR) { const int ht = e >> 8, r = e & 255; SC[((size_t)(b * 8 + (ht >> 2)) * 4 + (ht & 3)) * 2048 + n * 256 + r] = scs[e]; }
}
__device__ __forceinline__ void smp_ret_item(Frame& F, int item) {
    const int h = item & 3, b = item >> 2; const bf16* Z = WSP(bf16, WS_Z); bf16* MIX = WSP(bf16, WS_MIX);
    float* qs = (float*)F.lds;
    float* ks = qs + 256;
    float* vs = ks + 256;
    float* po = vs + 512;
    float* qk = po + 2048;
    float* red = qk + 16;
    const int tid = F.tid, e = tid & 127, dq = tid >> 7; const int rs0 = TP + b * 4; const float lg = ret_log2g(h);
    const float* stp = INP(4) + (size_t)((b * 4 + h) * 64 + dq * 16) * 128 + e; float* nsp = F.out + O_RSS + (size_t)((b * 4 + h) * 64 + dq * 16) * 128 + e;
    float st[16];
#pragma unroll
    for (int dd = 0; dd < 16; ++dd) st[dd] = __builtin_nontemporal_load(stp + dd * 128);
    const float gb = bf2f(Z[(size_t)(rs0 + dq) * NE + ZGB + h * 128 + e]);
    __syncthreads();
    if (tid < 256) { const int i = tid >> 6, d = tid & 63, pd = 2 * (d & 31) + (d >> 5);
        qs[tid] = bf2f(Z[(size_t)(rs0 + i) * NE + ZQB + h * 64 + pd]); ks[tid] = bf2f(Z[(size_t)(rs0 + i) * NE + ZKB + h * 64 + pd]); }
    { const int i = tid >> 7; vs[tid] = bf2f(Z[(size_t)(rs0 + i) * NE + ZVB + h * 128 + e]); }
    __syncthreads();
    if (tid < 16) { const int i = tid >> 2, jj = tid & 3; float s = 0.f; for (int d = 0; d < 64; ++d) s += qs[i * 64 + d] * ks[jj * 64 + d]; qk[tid] = (jj <= i) ? s * exp2f((float)(i - jj) * lg) : 0.f; }
    float pa[4] = {0.f, 0.f, 0.f, 0.f};
    const float g4 = exp2f(4.f * lg), g3 = exp2f(3.f * lg), g2 = exp2f(2.f * lg), g1 = exp2f(lg);
#pragma unroll
    for (int dd = 0; dd < 16; ++dd) { const int d = dq * 16 + dd;
        const float ns = st[dd] * g4 + g3 * ks[d] * vs[e] + g2 * ks[64 + d] * vs[128 + e] + g1 * ks[128 + d] * vs[256 + e] + ks[192 + d] * vs[384 + e];
        __builtin_nontemporal_store(ns, nsp + dd * 128);
#pragma unroll
        for (int i = 0; i < 4; ++i) pa[i] += qs[i * 64 + d] * st[dd]; }
#pragma unroll
    for (int i = 0; i < 4; ++i) po[(dq * 4 + i) * 128 + e] = pa[i];
    __syncthreads();
    { const int i = dq; float inter = po[(0 * 4 + i) * 128 + e] + po[(1 * 4 + i) * 128 + e] + po[(2 * 4 + i) * 128 + e] + po[(3 * 4 + i) * 128 + e];
      inter *= exp2f((float)(i + 1) * lg); float intra = 0.f;
      for (int jj = 0; jj <= i; ++jj) intra += qk[i * 4 + jj] * vs[jj * 128 + e];
      const float ov = intra + inter; const float ss = wave_sum(ov * ov);
      if (F.lane == 0) red[F.wave] = ss;
      __syncthreads();
      const float rstd = rsqrtf((red[2 * i] + red[2 * i + 1]) * (1.f / 128.f) + EPS);
      MIX[(size_t)(rs0 + i) * DM + 512 + h * 128 + e] = (bf16)f2bf(ov * rstd * gb); }
}
__device__ __forceinline__ void ret_scan_phase(Frame& F) {
    const float* S = WSP(float, WS_SLR); bf16* PB = WSP(bf16, WS_PBR);
    for (int idx = blockIdx.x * NTHR + F.tid; idx < 16 * 4096; idx += F.G * NTHR) { const int bh = idx >> 12, e = (idx & 4095) * 2; const float g128 = exp2f(128.f * ret_log2g(bh & 3));
        const float* p = S + (size_t)bh * 32 * 8192 + e; bf16* q = PB + (size_t)bh * 32 * 8192 + e; f32x2 st = (f32x2){0.f, 0.f};
        f32x2 loc[32];
#pragma unroll
        for (int c = 0; c < 32; ++c) loc[c] = *(const f32x2*)(p + (size_t)c * 8192);
#pragma unroll
        for (int c = 0; c < 32; ++c) { *(unsigned*)(q + (size_t)c * 8192) = pk2(st.x, st.y); st = st * g128 + loc[c]; }
        { const int dp = e >> 7, dorig = (dp >> 1) + 32 * (dp & 1); *(f32x2*)(F.out + O_RSP + (size_t)bh * 8192 + dorig * 128 + (e & 127)) = st; } }
}
__device__ __forceinline__ void smp_pass2_item(Frame& F, int item) {
    const int h = item & 7, b = item >> 3; const bf16* Z = WSP(bf16, WS_Z); bf16* MIX = WSP(bf16, WS_MIX); const float* cv = INP(3); const int* pt = (const int*)INP(7);
    float* P = (float*)F.lds;
    float* km = P + 4 * 2056;
    float* qs = km + 512;
    float* gts = qs + 256;
    float* biasT = gts + 32;
    float* red = biasT + 264;
    float* stat = red + 2304;
    unsigned* selm = (unsigned*)(stat + 8);
    int* pgl = (int*)(selm + 8);
    int tz_ = threadIdx.x; asm volatile("" : "+v"(tz_));
    const int tid = tz_, lane_ = tz_ & 63, rs0 = TP + b * 4;
    float scv[16];
    { const float* SC = WSP(float, WS_SC) + (size_t)(b * 8 + h) * 4 * 2048;
#pragma unroll
      for (int k = 0; k < 16; ++k) scv[k] = SC[tid + NTHR * k]; }
    __syncthreads();
    if (tid < 16) pgl[tid] = pt[b * NPAGES + tid];
    { const int n = tid >> 6, d = tid & 63; km[tid] = WSP(float, WS_KMS)[(size_t)(b * 8 + n) * 512 + h * 64 + d]; }
    if (tid < 256) qs[tid] = bf2f(Z[(size_t)(rs0 + (tid >> 6)) * NE + ZQA + h * 64 + (tid & 63)]);
    { const float* rb = INP(10); for (int e = tid; e < 264; e += NTHR) biasT[e] = rb[t5_bucket(e) * 8 + h]; }
    __syncthreads();
    if (tid < 32) { const int t = tid >> 3, n = tid & 7; float s = 0.f; for (int d = 0; d < 64; ++d) s += qs[t * 64 + d] * km[n * 64 + d]; gts[tid] = s; }
    __syncthreads();
    if (tid < 4) { unsigned mk = 0u;
        for (int r = 0; r < 3; ++r) { float best = -3e38f; int bi = 0; for (int n = 0; n < 8; ++n) if (!((mk >> n) & 1u) && gts[tid * 8 + n] > best) { best = gts[tid * 8 + n]; bi = n; } mk |= 1u << bi; }
        selm[tid] = mk; }
    __syncthreads();
    const unsigned un = selm[0] | selm[1] | selm[2] | selm[3]; const int rsub = lane_ >> 4, d4 = (lane_ & 15) * 4;
    f32x4 va[8], vb[8];
    const __amdgpu_buffer_rsrc_t vrs = __builtin_amdgcn_make_buffer_rsrc((void*)cv, (short)0, (int)((size_t)NPHYS * PAGE * 512 * 4), 0x00020000);
    const int vvo = rsub * 2048 + h * 256 + d4 * 4;
#define P2_LOAD(V, n) do { const int pg0_ = __builtin_amdgcn_readfirstlane(pgl[2 * (n)]), pg1_ = __builtin_amdgcn_readfirstlane(pgl[2 * (n) + 1]); \
        _Pragma("unroll") for (int it = 0; it < 8; ++it) { const int so_ = (((it < 4) ? pg0_ : pg1_) * PAGE + (it & 3) * 32 + F.wave * 4) * 2048; \
            V[it] = __builtin_bit_cast(f32x4, __builtin_amdgcn_raw_buffer_load_b128(vrs, vvo, so_, 2)); } } while (0)
    unsigned rem = un; int nA = __ffs(rem) - 1; rem &= rem - 1u; P2_LOAD(va, nA);
#pragma unroll
    for (int k = 0; k < 16; ++k) { const int e = tid + NTHR * k, t = e >> 11, idx = e & 2047, n = idx >> 8; const int dist = PAST + t - idx;
        P[t * 2056 + idx] = ((selm[t] >> n) & 1u) ? scv[k] * 0.125f + biasT[dist > 263 ? 263 : dist] : -1e30f; }
    if (tid < 16) { const int t = tid >> 2, t2 = tid & 3; float s = -1e30f;
        if (t2 <= t) { float a = 0.f; for (int d = 0; d < 64; ++d) a += qs[t * 64 + d] * bf2f(Z[(size_t)(rs0 + t2) * NE + ZKA + h * 64 + d]); s = a * 0.125f + biasT[t - t2]; }
        P[t * 2056 + 2048 + t2] = s; }
    __syncthreads();
    { const int t = F.wave >> 1, hf = F.wave & 1; float mx = -1e30f;
      for (int i = lane_ + 64 * hf; i < 2052; i += 128) mx = fmaxf(mx, P[t * 2056 + i]);
      mx = wave_max(mx); if (lane_ == 0) red[F.wave] = mx;
      __syncthreads();
      const float M = fmaxf(red[2 * t], red[2 * t + 1]); float sm = 0.f;
      for (int i = lane_ + 64 * hf; i < 2052; i += 128) { const float x = P[t * 2056 + i]; const float p = (x > -1e29f) ? __expf(x - M) : 0.f; P[t * 2056 + i] = p; sm += p; }
      sm = wave_sum(sm); if (lane_ == 0) red[8 + F.wave] = sm;
      __syncthreads();
      if (tid < 4) stat[4 + tid] = 1.f / (red[8 + 2 * tid] + red[8 + 2 * tid + 1]); }
    __syncthreads();
    float acc[4][4];
#pragma unroll
    for (int t = 0; t < 4; ++t)
#pragma unroll
        for (int k = 0; k < 4; ++k) acc[t][k] = 0.f;
#define P2_COMP(V, n) do { _Pragma("unroll") for (int it = 0; it < 8; ++it) { const int r = (it * 8 + F.wave) * 4 + rsub; \
        _Pragma("unroll") for (int t = 0; t < 4; ++t) { const float p = P[t * 2056 + (n) * 256 + r]; acc[t][0] += p * V[it].x; acc[t][1] += p * V[it].y; acc[t][2] += p * V[it].z; acc[t][3] += p * V[it].w; } } } while (0)
    f32x4 vc[8];
    int nB = __ffs(rem) - 1; rem &= rem - 1u; P2_LOAD(vb, nB);
    int nC = __ffs(rem) - 1; rem &= rem - 1u; P2_LOAD(vc, nC);
    for (;;) {
        P2_COMP(va, nA); nA = -1; if (rem) { nA = __ffs(rem) - 1; rem &= rem - 1u; P2_LOAD(va, nA); }
        if (nB < 0) break;
        P2_COMP(vb, nB); nB = -1; if (rem) { nB = __ffs(rem) - 1; rem &= rem - 1u; P2_LOAD(vb, nB); }
        if (nC < 0) break;
        P2_COMP(vc, nC); nC = -1; if (rem) { nC = __ffs(rem) - 1; rem &= rem - 1u; P2_LOAD(vc, nC); }
        if (nA < 0) break; }
#undef P2_LOAD
#undef P2_COMP
    if (F.wave == 0 && rsub == 0) { for (int t2 = 0; t2 < 4; ++t2) { float vf[4];
#pragma unroll
            for (int k = 0; k < 4; ++k) vf[k] = bf2f(Z[(size_t)(rs0 + t2) * NE + ZVA + h * 64 + d4 + k]);
#pragma unroll
            for (int t = 0; t < 4; ++t) { const float p = P[t * 2056 + 2048 + t2];
#pragma unroll
                for (int k = 0; k < 4; ++k) acc[t][k] += p * vf[k]; } } }
#pragma unroll
    for (int t = 0; t < 4; ++t)
#pragma unroll
        for (int k = 0; k < 4; ++k) { float v = acc[t][k]; v += __shfl_xor(v, 16); v += __shfl_xor(v, 32); acc[t][k] = v; }
    if (rsub == 0) {
#pragma unroll
        for (int t = 0; t < 4; ++t)
#pragma unroll
            for (int k = 0; k < 4; ++k) red[256 + (F.wave * 4 + t) * 64 + d4 + k] = acc[t][k]; }
    __syncthreads();
    if (tid < 256) { const int t = tid >> 6, d = tid & 63; float s = 0.f;
#pragma unroll
        for (int w = 0; w < 8; ++w) s += red[256 + (w * 4 + t) * 64 + d];
        const float g = bf2f(Z[(size_t)(rs0 + t) * NE + ZGA + h * 64 + d]);
        MIX[(size_t)(rs0 + t) * DM + h * 64 + d] = (bf16)f2bf(s * stat[4 + t] * g); }
}
__device__ __forceinline__ void post1_phase(Frame& F) {
    bf16* Z = WSP(bf16, WS_Z); bf16* XC = WSP(bf16, WS_XC); const float* cw = INP(24); const float* cb = INP(25); const float* scv = INP(6); const float* dtb = INP(26);
    const int gw = blockIdx.x * NWAVES + F.wave, NGW = F.G * NWAVES, lane = F.lane, c8 = lane * 8;
    float wgt[2][4][8], bia[2][8];
#pragma unroll
    for (int hf = 0; hf < 2; ++hf) { const int cc = hf * 512 + c8;
#pragma unroll
        for (int i = 0; i < 8; ++i) { bia[hf][i] = cb[cc + i];
#pragma unroll
            for (int w = 0; w < 4; ++w) wgt[hf][w][i] = cw[w * 1024 + cc + i]; } }
    const float dtbl = (lane < 8) ? dtb[lane] : 0.f;
    auto tap = [&](int r, int w, int cc) -> v4u { const int t = (r < TP) ? (r & (SEQ - 1)) : (r & 3), tt = t - 3 + w;
        if (tt >= 0) return *(const v4u*)(Z + (size_t)(r - 3 + w) * NOP + YXBC + cc);
        if (r >= TP) { const float* sp = scv + (size_t)(((r - TP) >> 2) * 3 + (tt + 3)) * 1024 + cc; const f32x4 a = *(const f32x4*)sp, b = *(const f32x4*)(sp + 4);
            v4u o; o.x = pk2(a.x, a.y); o.y = pk2(a.z, a.w); o.z = pk2(b.x, b.y); o.w = pk2(b.z, b.w); return o; }
        return (v4u){0u, 0u, 0u, 0u}; };
    for (int r0 = gw; r0 < MR; r0 += 2 * NGW) {
        const int r1 = (r0 + NGW < MR) ? r0 + NGW : r0;
        v4u vraw[2], xt[2][2][4]; float dtr[2];
#pragma unroll
        for (int q = 0; q < 2; ++q) { const int r = q ? r1 : r0; vraw[q] = *(const v4u*)(Z + (size_t)r * NOP + YV + c8); dtr[q] = (lane < 8) ? WSP(float, WS_DTRAW)[(size_t)r * 8 + lane] : 0.f;
#pragma unroll
            for (int hf = 0; hf < 2; ++hf)
#pragma unroll
                for (int w = 0; w < 4; ++w) xt[q][hf][w] = tap(r, w, hf * 512 + c8); }
#pragma unroll
        for (int q = 0; q < 2; ++q) { const int r = q ? r1 : r0; bf16* zr = Z + (size_t)r * NOP; float f[8];
            unpack8(vraw[q], f); float s = 0.f;
#pragma unroll
            for (int i = 0; i < 8; ++i) { f[i] = gelu_f(f[i]); s += f[i]; }
            const float mu = wave_sum(s) * (1.f / 512.f); float s2 = 0.f;
#pragma unroll
            for (int i = 0; i < 8; ++i) { f[i] -= mu; s2 += f[i] * f[i]; }
            const float rstd = rsqrtf(wave_sum(s2) * (1.f / 512.f) + EPS);
#pragma unroll
            for (int i = 0; i < 8; ++i) f[i] *= rstd;
            *(v4u*)(zr + YV + c8) = pack8(f);
            if (r >= TP) { float* o = F.out + O_SGV + (size_t)(r - TP) * 512 + c8; *(f32x4*)o = (f32x4){f[0], f[1], f[2], f[3]}; *(f32x4*)(o + 4) = (f32x4){f[4], f[5], f[6], f[7]}; }
            const int t = (r < TP) ? (r & (SEQ - 1)) : (r & 3); const int bs = (r - TP) >> 2;
#pragma unroll
            for (int hf = 0; hf < 2; ++hf) { const int cc = hf * 512 + c8; float a[8], x[8];
#pragma unroll
                for (int i = 0; i < 8; ++i) a[i] = bia[hf][i];
#pragma unroll
                for (int w = 0; w < 4; ++w) { unpack8(xt[q][hf][w], x);
#pragma unroll
                    for (int i = 0; i < 8; ++i) a[i] += x[i] * wgt[hf][w][i]; }
#pragma unroll
                for (int i = 0; i < 8; ++i) a[i] = silu_f(a[i]);
                *(v4u*)(XC + (size_t)r * 1024 + cc) = pack8(a);
                float* so = nullptr;
                if (r < TP) { if (t >= SEQ - 3) so = F.out + O_CSP + (size_t)((r >> 12) * 3 + (t - (SEQ - 3))) * 1024 + cc; }
                else if (t >= 1) so = F.out + O_CSS + (size_t)(bs * 3 + (t - 1)) * 1024 + cc;
                if (so) { *(f32x4*)so = (f32x4){x[0], x[1], x[2], x[3]}; *(f32x4*)(so + 4) = (f32x4){x[4], x[5], x[6], x[7]}; } }
            if (lane < 8) WSP(float, WS_DTH)[(size_t)r * 8 + lane] = softplus_f(dtr[q] + dtbl);
        }
    }
}
__device__ __forceinline__ void smp_l1_item(Frame& F, int item) {
    const int g = item & 1, b = item >> 1; const bf16* Z = WSP(bf16, WS_Z); const bf16* XC = WSP(bf16, WS_XC); bf16* MIX = WSP(bf16, WS_MIX); const float* DTH = WSP(float, WS_DTH);
    float* st = (float*)F.lds;
    float* xs = st + 64 * 129;
    float* bsm = xs + 1024;
    float* csm = bsm + 512;
    float* ygs = csm + 512;
    float* yp = ygs + 1024;
    float* cum = yp + 512;
    float* dts = cum + 16;
    float* cbs = dts + 16;
    const int tid = F.tid, rs0 = TP + b * 4;
    const float* sgw = INP(22); const float* sgb = INP(23); const float* alog = INP(27); const float* ssm_in = INP(5); const float* Dp = INP(28); const float* nw = INP(29);
    f32x4 sreg[4];
#pragma unroll
    for (int k = 0; k < 4; ++k) sreg[k] = __builtin_nontemporal_load((const f32x4*)(ssm_in + (size_t)(b * 8 + g * 4) * 8192 + tid * 4 + 2048 * k));
    __syncthreads();
    if (tid < 256) { const int col = g * 256 + tid, gc = col >> 7; float vn[4];
#pragma unroll
        for (int i = 0; i < 4; ++i) vn[i] = bf2f(Z[(size_t)(rs0 + i) * NOP + YV + col]);
#pragma unroll
        for (int i = 0; i < 4; ++i) { float a = sgb[gc * 128 + i];
#pragma unroll
            for (int jj = 0; jj < 4; ++jj) if (jj <= i) a += sgw[(size_t)gc * 16384 + i * 128 + jj] * vn[jj];
            const size_t zo = (size_t)(rs0 + i) * NOP + col;
            MIX[(size_t)(rs0 + i) * DM + col] = (bf16)f2bf(gelu_f(bf2f(Z[zo + YU])) * a * silu_f(bf2f(Z[zo + YGC]))); } }
    for (int e = tid; e < 1024; e += NTHR) { const int i = e >> 8, cc = e & 255; xs[e] = bf2f(XC[(size_t)(rs0 + i) * 1024 + g * 256 + cc]); }
    { const int i = tid >> 7, n = tid & 127; bsm[tid] = bf2f(XC[(size_t)(rs0 + i) * 1024 + 512 + g * 128 + n]); csm[tid] = bf2f(XC[(size_t)(rs0 + i) * 1024 + 768 + g * 128 + n]); }
    if (tid < 16) dts[tid] = DTH[(size_t)(rs0 + (tid >> 2)) * 8 + g * 4 + (tid & 3)];
    __syncthreads();
    if (tid < 4) { const float A = -__expf(alog[g * 4 + tid]); float s = 0.f; for (int i = 0; i < 4; ++i) { s += dts[i * 4 + tid] * A; cum[i * 4 + tid] = s; } }
    if (tid >= 64 && tid < 80) { const int i = (tid - 64) >> 2, jj = (tid - 64) & 3; float s = 0.f; for (int n = 0; n < 128; ++n) s += csm[i * 128 + n] * bsm[jj * 128 + n]; cbs[i * 4 + jj] = s; }
    __syncthreads();
    for (int hq = 0; hq < 4; ++hq) { const int h = g * 4 + hq; const float* sp = ssm_in + (size_t)(b * 8 + h) * 8192; float* so = F.out + O_SSS + (size_t)(b * 8 + h) * 8192;
#pragma unroll
        for (int k = 0; k < 4; ++k) { const int e = tid * 4 + 2048 * k; float* sd = st + (e >> 7) * 129 + (e & 127); sd[0] = sreg[k].x; sd[1] = sreg[k].y; sd[2] = sreg[k].z; sd[3] = sreg[k].w; }
        __syncthreads();
        if (hq < 3) {
#pragma unroll
            for (int k = 0; k < 4; ++k) sreg[k] = __builtin_nontemporal_load((const f32x4*)(sp + 8192 + tid * 4 + 2048 * k)); }
        const float c0 = cum[0 * 4 + hq], c1 = cum[1 * 4 + hq], c2 = cum[2 * 4 + hq], c3 = cum[3 * 4 + hq];
        { const int n = tid & 127, pq = tid >> 7; const float e3 = __expf(c3);
          const float w0 = __expf(c3 - c0) * dts[0 * 4 + hq] * bsm[n], w1 = __expf(c3 - c1) * dts[1 * 4 + hq] * bsm[128 + n], w2 = __expf(c3 - c2) * dts[2 * 4 + hq] * bsm[256 + n], w3 = dts[3 * 4 + hq] * bsm[384 + n];
#pragma unroll 4
          for (int pp = 0; pp < 16; ++pp) { const int p = pq * 16 + pp;
              __builtin_nontemporal_store(st[p * 129 + n] * e3 + w0 * xs[hq * 64 + p] + w1 * xs[256 + hq * 64 + p] + w2 * xs[512 + hq * 64 + p] + w3 * xs[768 + hq * 64 + p], so + p * 128 + n); } }
        { const int p = tid & 63, i = (tid >> 6) & 3, nh = tid >> 8; float s = 0.f;
          for (int n = nh * 64; n < nh * 64 + 64; ++n) s += csm[i * 128 + n] * st[p * 129 + n];
          yp[(nh * 4 + i) * 64 + p] = s; }
        __syncthreads();
        if (tid < 256) { const int p = tid & 63, i = tid >> 6; const float ci = cum[i * 4 + hq]; float y = __expf(ci) * (yp[i * 64 + p] + yp[(4 + i) * 64 + p]);
            for (int jj = 0; jj <= i; ++jj) y += cbs[i * 4 + jj] * __expf(ci - cum[jj * 4 + hq]) * dts[jj * 4 + hq] * xs[jj * 256 + hq * 64 + p];
            y += Dp[h] * xs[i * 256 + hq * 64 + p];
            ygs[i * 256 + hq * 64 + p] = y * silu_f(bf2f(Z[(size_t)(rs0 + i) * NOP + YZG + h * 64 + p])); }
        __syncthreads();
    }
    if (tid < 256) { const int i = tid >> 6; float v[4]; float ss = 0.f;
#pragma unroll
        for (int k = 0; k < 4; ++k) { v[k] = ygs[i * 256 + F.lane + 64 * k]; ss += v[k] * v[k]; }
        const float rstd = rsqrtf(wave_sum(ss) * (1.f / 256.f) + EPS);
#pragma unroll
        for (int k = 0; k < 4; ++k) { const int col = g * 256 + F.lane + 64 * k; MIX[(size_t)(rs0 + i) * DM + 512 + col] = (bf16)f2bf(v[k] * rstd * nw[col]); } }
}
__device__ __forceinline__ void ssd_scan_phase(Frame& F) {
    const float* S = WSP(float, WS_SLS); bf16* PB = WSP(bf16, WS_PBS); const float* cdec = WSP(float, WS_CDEC);
    for (int idx = blockIdx.x * NTHR + F.tid; idx < 32 * 4096; idx += F.G * NTHR) { const int bh = idx >> 12, e = (idx & 4095) * 2, b = bh >> 3, h = bh & 7; f32x2 st = (f32x2){0.f, 0.f};
        f32x2 loc[32];
#pragma unroll
        for (int c = 0; c < 32; ++c) loc[c] = *(const f32x2*)(S + (size_t)((b * 32 + c) * 8 + h) * 8192 + e);
#pragma unroll
        for (int c = 0; c < 32; ++c) { const size_t o = (size_t)((b * 32 + c) * 8 + h) * 8192 + e; *(unsigned*)(PB + o) = pk2(st.x, st.y); st = st * cdec[(b * 32 + c) * 8 + h] + loc[c]; }
        *(f32x2*)(F.out + O_SSP + (size_t)bh * 8192 + e) = st; }
}
namespace mm {
typedef short bf16x8 __attribute__((ext_vector_type(8)));
typedef short s16x4 __attribute__((ext_vector_type(4)));
#define MM_LAS __attribute__((address_space(3)))
__device__ __forceinline__ f32x4 mfma16(bf16x8 a, bf16x8 b, f32x4 c) { return __builtin_amdgcn_mfma_f32_16x16x32_bf16(a, b, c, 0, 0, 0); }
__device__ __forceinline__ bf16x8 frag_kc(const bf16* X, int pitch, int r0, int k0, int lane) { return *(const bf16x8*)(X + (r0 + (lane & 15)) * pitch + k0 + 8 * (lane >> 4)); }
__device__ __forceinline__ s16x4 trd(const bf16* p) { return __builtin_bit_cast(s16x4, __builtin_amdgcn_ds_read_tr16_b64_v4i16((MM_LAS s16x4*)p)); }
__device__ __forceinline__ bf16x8 frag_tr(const bf16* Y, int pitch, int ka, int kb, int n0, int lane) {
    const int m = lane & 15; const bf16* pa = Y + (ka + (m >> 2)) * pitch + n0 + 4 * (m & 3); const bf16* pb = Y + (kb + (m >> 2)) * pitch + n0 + 4 * (m & 3);
    const s16x4 lo = trd(pa), hi = trd(pb); return (bf16x8){lo[0], lo[1], lo[2], lo[3], hi[0], hi[1], hi[2], hi[3]};
}
__device__ __forceinline__ bf16x8 frag_tr_std(const bf16* Y, int pitch, int k0, int n0, int lane) { const int g = lane >> 4; return frag_tr(Y, pitch, k0 + 8 * g, k0 + 8 * g + 4, n0, lane); }
__device__ __forceinline__ bf16x8 frag_tr_acc(const bf16* Y, int pitch, int k0, int n0, int lane) { const int g = lane >> 4; return frag_tr(Y, pitch, k0 + 4 * g, k0 + 16 + 4 * g, n0, lane); }
__device__ __forceinline__ bf16x8 pack_acc(const float* l0, const float* l1) { v4u w; w.x = pk2(l0[0], l0[1]); w.y = pk2(l0[2], l0[3]); w.z = pk2(l1[0], l1[1]); w.w = pk2(l1[2], l1[3]); return __builtin_bit_cast(bf16x8, w); }
}

template <bool SSD> __device__ __forceinline__ void kv_local_item(Frame& F, int item) {
    bf16* As = (bf16*)F.lds;
    bf16* Bs = As + 128 * 72;
    float* wj = (float*)(Bs + 128 * 144);
    float* cum = wj + 128;
    const int tid = F.tid; int b, c, h; float* S;
    if (SSD) { h = item & 7; c = (item >> 3) & 31; b = item >> 8; S = WSP(float, WS_SLS) + (size_t)((b * 32 + c) * 8 + h) * 8192; }
    else { c = item & 31; h = (item >> 5) & 3; b = item >> 7; S = WSP(float, WS_SLR) + (size_t)((b * 4 + h) * 32 + c) * 8192; }
    const int r0 = b * SEQ + c * 128;
    const bf16* srcA = SSD ? WSP(bf16, WS_XC) + (size_t)r0 * 1024 + h * 64 : WSP(bf16, WS_Z) + (size_t)r0 * NE + ZKB + h * 64;
    const bf16* srcB = SSD ? WSP(bf16, WS_XC) + (size_t)r0 * 1024 + 512 + (h >> 2) * 128 : WSP(bf16, WS_Z) + (size_t)r0 * NE + ZVB + h * 128;
    const int pitch = SSD ? 1024 : NE;
    v4u ra[2], rb[4];
#pragma unroll
    for (int k = 0; k < 2; ++k) { const int e = tid + NTHR * k; ra[k] = *(const v4u*)(srcA + (size_t)(e >> 3) * pitch + (e & 7) * 8); }
#pragma unroll
    for (int k = 0; k < 4; ++k) { const int e = tid + NTHR * k; rb[k] = *(const v4u*)(srcB + (size_t)(e >> 4) * pitch + (e & 15) * 8); }
    float dthv = 0.f, Aneg = 0.f;
    if (SSD) { if (tid < 128) dthv = WSP(float, WS_DTH)[(size_t)(r0 + tid) * 8 + h]; Aneg = -__expf(INP(27)[h]); }
    __syncthreads();
    if (SSD) { float* dts = cum + 128;
        if (tid < 128) dts[tid] = dthv;
        __syncthreads();
        if (tid < 64) { const float a0 = dts[2 * tid] * Aneg, a1 = dts[2 * tid + 1] * Aneg; float s = a0 + a1;
#pragma unroll
            for (int o = 1; o < 64; o <<= 1) { const float t = __shfl_up(s, o); if (F.lane >= o) s += t; }
            cum[2 * tid] = s - a1; cum[2 * tid + 1] = s; }
        __syncthreads();
        if (tid < 128) { const float cj = cum[tid], cl = cum[127]; WSP(float, WS_CUM)[(size_t)(r0 + tid) * 8 + h] = cj; wj[tid] = __expf(cl - cj) * dthv;
            if (tid == 0) WSP(float, WS_CDEC)[(b * 32 + c) * 8 + h] = __expf(cl); }
    } else { if (tid < 128) wj[tid] = exp2f((float)(127 - tid) * ret_log2g(h)); }
    __syncthreads();
#pragma unroll
    for (int k = 0; k < 2; ++k) { const int e = tid + NTHR * k, j = e >> 3, cc = (e & 7) * 8; float f[8]; unpack8(ra[k], f); const float w = wj[j];
#pragma unroll
        for (int q = 0; q < 8; ++q) f[q] *= w;
        *(v4u*)(As + j * 72 + cc) = pack8(f); }
#pragma unroll
    for (int k = 0; k < 4; ++k) { const int e = tid + NTHR * k; *(v4u*)(Bs + (e >> 4) * 144 + (e & 15) * 8) = rb[k]; }
    __syncthreads();
    const int lane = F.lane, dt = F.wave & 3, et0 = (F.wave >> 2) * 4;
    f32x4 acc[4];
#pragma unroll
    for (int q = 0; q < 4; ++q) acc[q] = (f32x4){0.f, 0.f, 0.f, 0.f};
#pragma unroll
    for (int ks = 0; ks < 4; ++ks) { const mm::bf16x8 af = mm::frag_tr_std(As, 72, 32 * ks, 16 * dt, lane);
#pragma unroll
        for (int q = 0; q < 4; ++q) acc[q] = mm::mfma16(af, mm::frag_tr_std(Bs, 144, 32 * ks, 16 * (et0 + q), lane), acc[q]); }
    const int gq = lane >> 4, cl = lane & 15;
#pragma unroll
    for (int q = 0; q < 4; ++q)
#pragma unroll
        for (int r = 0; r < 4; ++r) S[(16 * dt + 4 * gq + r) * 128 + 16 * (et0 + q) + cl] = acc[q][r];
}
__device__ __forceinline__ void ret_out_mfma(Frame& F, int item) {
    const int c = item & 31, h = (item >> 5) & 3, b = item >> 7; const bf16* Z = WSP(bf16, WS_Z); bf16* MIX = WSP(bf16, WS_MIX);
    bf16* Qs = (bf16*)F.lds;
    bf16* Ks = Qs + 128 * 72;
    bf16* Vs = Ks + 128 * 72;
    bf16* Ps = Vs + 128 * 144;
    const int tid = F.tid, r0 = b * SEQ + c * 128; const float lg = ret_log2g(h);
    __syncthreads();
    for (int e = tid; e < 128 * 8; e += NTHR) { const int j = e >> 3, cc = (e & 7) * 8; const size_t zo = (size_t)(r0 + j) * NE + h * 64 + cc;
        *(v4u*)(Qs + j * 72 + cc) = *(const v4u*)(Z + zo + ZQB); *(v4u*)(Ks + j * 72 + cc) = *(const v4u*)(Z + zo + ZKB); }
    for (int e = tid; e < 128 * 16; e += NTHR) { const int j = e >> 4, cc = (e & 15) * 8; *(v4u*)(Vs + j * 144 + cc) = *(const v4u*)(Z + (size_t)(r0 + j) * NE + ZVB + h * 128 + cc); }
    { const bf16* Pp = WSP(bf16, WS_PBR) + (size_t)((b * 4 + h) * 32 + c) * 8192;
      for (int e = tid; e < 64 * 16; e += NTHR) { const int d = e >> 4, cc = (e & 15) * 8; *(v4u*)(Ps + d * 144 + cc) = *(const v4u*)(Pp + d * 128 + cc); } }
    __syncthreads();
    v4u gbr[4];
#pragma unroll
    for (int k = 0; k < 4; ++k) { const int e = tid + NTHR * k; gbr[k] = *(const v4u*)(Z + (size_t)(r0 + (e >> 4)) * NE + ZGB + h * 128 + (e & 15) * 8); }
    const int w = F.wave, lane = F.lane, gq = lane >> 4, cl = lane & 15;
    f32x4 sT[8];
#pragma unroll
    for (int a = 0; a < 8; ++a) { sT[a] = (f32x4){0.f, 0.f, 0.f, 0.f};
        if (a <= w) {
#pragma unroll
            for (int ks = 0; ks < 2; ++ks) sT[a] = mm::mfma16(mm::frag_kc(Ks, 72, 16 * a, 32 * ks, lane), mm::frag_kc(Qs, 72, 16 * w, 32 * ks, lane), sT[a]); } }
    f32x4 ain[8], aix[8];
#pragma unroll
    for (int et = 0; et < 8; ++et) { ain[et] = (f32x4){0.f, 0.f, 0.f, 0.f}; aix[et] = (f32x4){0.f, 0.f, 0.f, 0.f}; }
#pragma unroll
    for (int ks = 0; ks < 2; ++ks) { const mm::bf16x8 af = mm::frag_kc(Qs, 72, 16 * w, 32 * ks, lane);
#pragma unroll
        for (int et = 0; et < 8; ++et) ain[et] = mm::mfma16(af, mm::frag_tr_std(Ps, 144, 32 * ks, 16 * et, lane), ain[et]); }
    const int ii = 16 * w + cl;
#pragma unroll
    for (int m = 0; m < 4; ++m) { if (2 * m <= w) { float l0[4], l1[4];
#pragma unroll
            for (int r = 0; r < 4; ++r) { const int j0 = 32 * m + 4 * gq + r, j1 = j0 + 16;
                l0[r] = (j0 <= ii) ? sT[2 * m][r] * exp2f((float)(ii - j0) * lg) : 0.f; l1[r] = (j1 <= ii) ? sT[2 * m + 1][r] * exp2f((float)(ii - j1) * lg) : 0.f; }
            const mm::bf16x8 af = mm::pack_acc(l0, l1);
#pragma unroll
            for (int et = 0; et < 8; ++et) aix[et] = mm::mfma16(af, mm::frag_tr_acc(Vs, 144, 32 * m, 16 * et, lane), aix[et]); } }
    float ssq[4], qd[4];
#pragma unroll
    for (int r = 0; r < 4; ++r) { ssq[r] = 0.f; qd[r] = exp2f((float)(16 * w + 4 * gq + r + 1) * lg); }
#pragma unroll
    for (int et = 0; et < 8; ++et)
#pragma unroll
        for (int r = 0; r < 4; ++r) { const float o = aix[et][r] + qd[r] * ain[et][r]; aix[et][r] = o; ssq[r] += o * o; }
#pragma unroll
    for (int r = 0; r < 4; ++r) { float s = ssq[r]; s += __shfl_xor(s, 1); s += __shfl_xor(s, 2); s += __shfl_xor(s, 4); s += __shfl_xor(s, 8); ssq[r] = rsqrtf(s * (1.f / 128.f) + EPS); }
    __syncthreads();
    bf16* Ot = Vs;
#pragma unroll
    for (int et = 0; et < 8; ++et)
#pragma unroll
        for (int r = 0; r < 4; ++r) Ot[(16 * w + 4 * gq + r) * 144 + 16 * et + cl] = (bf16)f2bf(aix[et][r] * ssq[r]);
    __syncthreads();
#pragma unroll
    for (int k = 0; k < 4; ++k) { const int e = tid + NTHR * k, i = e >> 4, cc = (e & 15) * 8; float o[8], g8[8];
        unpack8(*(const v4u*)(Ot + i * 144 + cc), o); unpack8(gbr[k], g8);
#pragma unroll
        for (int k = 0; k < 8; ++k) o[k] *= g8[k];
        *(v4u*)(MIX + (size_t)(r0 + i) * DM + 512 + h * 128 + cc) = pack8(o); }
}
__device__ __forceinline__ void sgu_mfma(Frame& F, int item) {
    const int g = item & 3, c = (item >> 2) & 31, b = item >> 7; const bf16* Z = WSP(bf16, WS_Z); bf16* MIX = WSP(bf16, WS_MIX);
    bf16* Ws = (bf16*)F.lds;
    bf16* Vs = Ws + 128 * 136;
    const int tid = F.tid, r0 = b * SEQ + c * 128; const float* W = INP(22) + (size_t)g * 16384; const float* sgb = INP(23);
    __syncthreads();
    for (int e = tid; e < 128 * 16; e += NTHR) { const int i = e >> 4, cc = (e & 15) * 8; const f32x4 a = *(const f32x4*)(W + i * 128 + cc), bb = *(const f32x4*)(W + i * 128 + cc + 4);
        float f[8] = {a.x, a.y, a.z, a.w, bb.x, bb.y, bb.z, bb.w};
#pragma unroll
        for (int k = 0; k < 8; ++k) if (cc + k > i) f[k] = 0.f;
        *(v4u*)(Ws + i * 136 + cc) = pack8(f);
        *(v4u*)(Vs + i * 144 + cc) = *(const v4u*)(Z + (size_t)(r0 + i) * NOP + YV + g * 128 + cc); }
    __syncthreads();
    v4u ur[4], gr[4];
#pragma unroll
    for (int k = 0; k < 4; ++k) { const int e = tid + NTHR * k; const size_t zo = (size_t)(r0 + (e >> 4)) * NOP + g * 128 + (e & 15) * 8; ur[k] = *(const v4u*)(Z + zo + YU); gr[k] = *(const v4u*)(Z + zo + YGC); }
    const int w = F.wave, lane = F.lane, gq = lane >> 4, cl = lane & 15;
    float sbv[4];
#pragma unroll
    for (int r = 0; r < 4; ++r) sbv[r] = sgb[g * 128 + 16 * w + 4 * gq + r];
    f32x4 acc[8];
#pragma unroll
    for (int dt = 0; dt < 8; ++dt) acc[dt] = (f32x4){0.f, 0.f, 0.f, 0.f};
#pragma unroll
    for (int ks = 0; ks < 4; ++ks) { if (ks <= (w >> 1)) { const mm::bf16x8 af = mm::frag_kc(Ws, 136, 16 * w, 32 * ks, lane);
#pragma unroll
            for (int dt = 0; dt < 8; ++dt) acc[dt] = mm::mfma16(af, mm::frag_tr_std(Vs, 144, 32 * ks, 16 * dt, lane), acc[dt]); } }
    __syncthreads();
    bf16* St = Ws;
#pragma unroll
    for (int r = 0; r < 4; ++r) { const int i = 16 * w + 4 * gq + r; const float sb = sbv[r];
#pragma unroll
        for (int dt = 0; dt < 8; ++dt) St[i * 136 + 16 * dt + cl] = (bf16)f2bf(acc[dt][r] + sb); }
    __syncthreads();
#pragma unroll
    for (int k = 0; k < 4; ++k) { const int e = tid + NTHR * k, i = e >> 4, cc = (e & 15) * 8; float s8[8], u8[8], g8[8];
        unpack8(*(const v4u*)(St + i * 136 + cc), s8); unpack8(ur[k], u8); unpack8(gr[k], g8);
#pragma unroll
        for (int k = 0; k < 8; ++k) s8[k] = gelu_f(u8[k]) * s8[k] * silu_f(g8[k]);
        *(v4u*)(MIX + (size_t)(r0 + i) * DM + g * 128 + cc) = pack8(s8); }
}
__device__ __forceinline__ void ssd_out_mfma(Frame& F, int item) {
    const int g = item & 1, c = (item >> 1) & 31, b = item >> 6; const bf16* Z = WSP(bf16, WS_Z); const bf16* XC = WSP(bf16, WS_XC); bf16* MIX = WSP(bf16, WS_MIX);
    bf16* Xs = (bf16*)F.lds;
    bf16* Cs = Xs + 128 * 272;
    bf16* Bs = Cs + 128 * 144;
    float* cums = (float*)(Bs + 128 * 144);
    float* dths = cums + 512;
    const int tid = F.tid, r0 = b * SEQ + c * 128; const float* Dp = INP(28); const float* nw = INP(29);
    const f32x4 n0 = *(const f32x4*)(nw + g * 256 + (tid & 31) * 8), n1 = *(const f32x4*)(nw + g * 256 + (tid & 31) * 8 + 4);
    __syncthreads();
    for (int e = tid; e < 128 * 32; e += NTHR) { const int j = e >> 5, cc = (e & 31) * 8; *(v4u*)(Xs + j * 272 + cc) = *(const v4u*)(XC + (size_t)(r0 + j) * 1024 + g * 256 + cc); }
    for (int e = tid; e < 128 * 16; e += NTHR) { const int j = e >> 4, cc = (e & 15) * 8; *(v4u*)(Bs + j * 144 + cc) = *(const v4u*)(XC + (size_t)(r0 + j) * 1024 + 512 + g * 128 + cc);
        *(v4u*)(Cs + j * 144 + cc) = *(const v4u*)(XC + (size_t)(r0 + j) * 1024 + 768 + g * 128 + cc); }
    { const int hq = tid >> 7, j = tid & 127; cums[tid] = WSP(float, WS_CUM)[(size_t)(r0 + j) * 8 + g * 4 + hq]; dths[tid] = WSP(float, WS_DTH)[(size_t)(r0 + j) * 8 + g * 4 + hq]; }
    v4u pra[2];
    { const bf16* Pn = WSP(bf16, WS_PBS) + (size_t)((b * 32 + c) * 8 + g * 4) * 8192;
#pragma unroll
      for (int k = 0; k < 2; ++k) { const int e = tid + NTHR * k, p = e >> 4, cc = (e & 15) * 8; pra[k] = *(const v4u*)(Pn + p * 128 + cc); } }
    __syncthreads();
    const int w = F.wave, lane = F.lane, gq = lane >> 4, cl = lane & 15;
    f32x4 cb[8];
#pragma unroll
    for (int a = 0; a < 8; ++a) { cb[a] = (f32x4){0.f, 0.f, 0.f, 0.f};
        if (a <= w) {
#pragma unroll
            for (int ks = 0; ks < 4; ++ks) cb[a] = mm::mfma16(mm::frag_kc(Bs, 144, 16 * a, 32 * ks, lane), mm::frag_kc(Cs, 144, 16 * w, 32 * ks, lane), cb[a]); } }
    __syncthreads();
    bf16* Ps = Bs;
    float* ssqs = dths + 512;
    if (tid < 128) ssqs[tid] = 0.f;
    const int ii = 16 * w + cl;
#pragma unroll 1
    for (int hq = 0; hq < 4; ++hq) { const int h = g * 4 + hq;
#pragma unroll
        for (int k = 0; k < 2; ++k) { const int e = tid + NTHR * k, p = e >> 4, cc = (e & 15) * 8; *(v4u*)(Ps + p * 144 + cc) = pra[k]; }
        __syncthreads();
        if (hq < 3) { const bf16* Pn = WSP(bf16, WS_PBS) + (size_t)((b * 32 + c) * 8 + h + 1) * 8192;
#pragma unroll
            for (int k = 0; k < 2; ++k) { const int e = tid + NTHR * k, p = e >> 4, cc = (e & 15) * 8; pra[k] = *(const v4u*)(Pn + p * 128 + cc); } }
        v4u zgr[2];
#pragma unroll
        for (int k = 0; k < 2; ++k) { const int e = tid + NTHR * k, i = e >> 3, cc = (e & 7) * 8; zgr[k] = *(const v4u*)(Z + (size_t)(r0 + i) * NOP + YZG + h * 64 + cc); }
        f32x4 ain[4], aix[4];
#pragma unroll
        for (int pt = 0; pt < 4; ++pt) { ain[pt] = (f32x4){0.f, 0.f, 0.f, 0.f}; aix[pt] = (f32x4){0.f, 0.f, 0.f, 0.f}; }
#pragma unroll
        for (int ks = 0; ks < 4; ++ks) { const mm::bf16x8 af = mm::frag_kc(Cs, 144, 16 * w, 32 * ks, lane);
#pragma unroll
            for (int pt = 0; pt < 4; ++pt) ain[pt] = mm::mfma16(af, mm::frag_kc(Ps, 144, 16 * pt, 32 * ks, lane), ain[pt]); }
        const float ci = cums[hq * 128 + ii];
#pragma unroll
        for (int m = 0; m < 4; ++m) { if (2 * m <= w) { float l0[4], l1[4];
#pragma unroll
                for (int r = 0; r < 4; ++r) { const int j0 = 32 * m + 4 * gq + r, j1 = j0 + 16;
                    l0[r] = (j0 <= ii) ? cb[2 * m][r] * __expf(ci - cums[hq * 128 + j0]) * dths[hq * 128 + j0] : 0.f;
                    l1[r] = (j1 <= ii) ? cb[2 * m + 1][r] * __expf(ci - cums[hq * 128 + j1]) * dths[hq * 128 + j1] : 0.f; }
                const mm::bf16x8 af = mm::pack_acc(l0, l1);
#pragma unroll
                for (int pt = 0; pt < 4; ++pt) aix[pt] = mm::mfma16(af, mm::frag_tr_acc(Xs, 272, 32 * m, hq * 64 + 16 * pt, lane), aix[pt]); } }
        const float Dh = Dp[h];
        bf16* Yt = Bs + 64 * 144;
#pragma unroll
        for (int r = 0; r < 4; ++r) { const int i = 16 * w + 4 * gq + r; const float ei = __expf(cums[hq * 128 + i]);
#pragma unroll
            for (int pt = 0; pt < 4; ++pt) Yt[i * 72 + 16 * pt + cl] = (bf16)f2bf(aix[pt][r] + ei * ain[pt][r]); }
        __syncthreads();
#pragma unroll
        for (int k = 0; k < 2; ++k) { const int e = tid + NTHR * k, i = e >> 3, cc = (e & 7) * 8; float y8[8], x8[8], z8[8];
            unpack8(*(const v4u*)(Yt + i * 72 + cc), y8); unpack8(*(const v4u*)(Xs + i * 272 + hq * 64 + cc), x8); unpack8(zgr[k], z8);
            float s = 0.f;
#pragma unroll
            for (int k = 0; k < 8; ++k) { y8[k] = (y8[k] + Dh * x8[k]) * silu_f(z8[k]); s += y8[k] * y8[k]; }
            s = red8_dpp(s); if ((e & 7) == 0) ssqs[i] += s;
            *(v4u*)(Xs + i * 272 + hq * 64 + cc) = pack8(y8); }
        __syncthreads();
    }
    for (int e = tid; e < 128 * 32; e += NTHR) { const int i = e >> 5, cc = (e & 31) * 8; const float rstd = rsqrtf(ssqs[i] * (1.f / 256.f) + EPS); float v8[8]; unpack8(*(const v4u*)(Xs + i * 272 + cc), v8);
        v8[0] *= rstd * n0.x; v8[1] *= rstd * n0.y; v8[2] *= rstd * n0.z; v8[3] *= rstd * n0.w; v8[4] *= rstd * n1.x; v8[5] *= rstd * n1.y; v8[6] *= rstd * n1.z; v8[7] *= rstd * n1.w;
        *(v4u*)(MIX + (size_t)(r0 + i) * DM + 512 + g * 256 + cc) = pack8(v8); }
}
__device__ __forceinline__ void mod_item_mfma(Frame& F, int item) {
    const int l = item / 48, nb = item % 48;
    const float* We = INP(12); const float* Wo = INP(19); const float* be = INP(13); const float* bo = INP(20); const float* cpp = INP(8); const float* csp = INP(9);
    const float* W = (l ? Wo : We) + nb * 64; const float* bias = (l ? bo : be) + nb * 64; float* mod = WSP(float, l ? WS_MODO : WS_MODE) + nb * 64;
    bf16* As = (bf16*)F.lds;
    bf16* Ws = As + 144 * 136;
    const int tid = F.tid, lane = F.lane, w = F.wave, nt = w & 3, m0 = w >> 2, gq = lane >> 4, cl = lane & 15;
    f32x4 acc[5];
#pragma unroll
    for (int q = 0; q < 5; ++q) acc[q] = (f32x4){0.f, 0.f, 0.f, 0.f};
    f32x4 ca[5], cbv[5], wa[2], wb[2];
#define MOD_LOAD(k0) do { _Pragma("unroll") for (int k = 0; k < 5; ++k) { const int e = tid + NTHR * k, m = e >> 4, cc = (e & 15) * 8; ca[k] = (f32x4){0.f, 0.f, 0.f, 0.f}; cbv[k] = ca[k]; \
            if (e < 144 * 16 && m < 132) { const float* cr = (m < 4) ? cpp + (size_t)m * DM : csp + (size_t)(m - 4) * DM; ca[k] = *(const f32x4*)(cr + (k0) + cc); cbv[k] = *(const f32x4*)(cr + (k0) + cc + 4); } } \
        _Pragma("unroll") for (int k = 0; k < 2; ++k) { const int e = tid + NTHR * k, kk = e >> 3, cc = (e & 7) * 8; wa[k] = *(const f32x4*)(W + (size_t)((k0) + kk) * 3072 + cc); wb[k] = *(const f32x4*)(W + (size_t)((k0) + kk) * 3072 + cc + 4); } } while (0)
    MOD_LOAD(0);
    for (int k0 = 0; k0 < DM; k0 += 128) {
        __syncthreads();
#pragma unroll
        for (int k = 0; k < 5; ++k) { const int e = tid + NTHR * k, m = e >> 4, cc = (e & 15) * 8;
            if (e < 144 * 16) { float f[8] = {silu_f(ca[k].x), silu_f(ca[k].y), silu_f(ca[k].z), silu_f(ca[k].w), silu_f(cbv[k].x), silu_f(cbv[k].y), silu_f(cbv[k].z), silu_f(cbv[k].w)};
                *(v4u*)(As + m * 136 + cc) = pack8(f); } }
#pragma unroll
        for (int k = 0; k < 2; ++k) { const int e = tid + NTHR * k, kk = e >> 3, cc = (e & 7) * 8; v4u wv; wv.x = pk2(wa[k].x, wa[k].y); wv.y = pk2(wa[k].z, wa[k].w); wv.z = pk2(wb[k].x, wb[k].y); wv.w = pk2(wb[k].z, wb[k].w);
            *(v4u*)(Ws + kk * 72 + cc) = wv; }
        __syncthreads();
        if (k0 + 128 < DM) MOD_LOAD(k0 + 128);
#pragma unroll
        for (int ks = 0; ks < 4; ++ks) { const mm::bf16x8 bfr = mm::frag_tr_std(Ws, 72, 32 * ks, 16 * nt, lane);
#pragma unroll
            for (int q = 0; q < 5; ++q) { const int mt = m0 + 2 * q; if (mt < 9) acc[q] = mm::mfma16(mm::frag_kc(As, 136, 16 * mt, 32 * ks, lane), bfr, acc[q]); } }
    }
#undef MOD_LOAD
    const float bn = bias[16 * nt + cl];
#pragma unroll
    for (int q = 0; q < 5; ++q) { const int mt = m0 + 2 * q;
#pragma unroll
        for (int r = 0; r < 4; ++r) { const int m = 16 * mt + 4 * gq + r; if (mt < 9 && m < 132) mod[(size_t)m * 3072 + 16 * nt + cl] = acc[q][r] + bn; } }
    __syncthreads();
}

template <bool XB16, bool OB16> __device__ __forceinline__ void smp_outproj_item(Frame& F, int item, const bf16* Wt, const void* xsrc, const float* mod, void* out) {
    const int rt = item >> 4, ct = item & 15, row0 = TP + rt * 32, col0 = ct * 64; const bf16* MIX = WSP(bf16, WS_MIX);
    bf16* As = (bf16*)F.lds;
    bf16* Bs = As + 32 * 264;
    const int tid = F.tid, lane = F.lane, w = F.wave, mt = w >> 2, nt = w & 3, gq = lane >> 4, cl = lane & 15;
    f32x4 acc = (f32x4){0.f, 0.f, 0.f, 0.f};
    v4u pa[2], pb[4];
#define SO_LOAD(k0) do { _Pragma("unroll") for (int k = 0; k < 2; ++k) { const int e = tid + NTHR * k; pa[k] = *(const v4u*)(MIX + (size_t)(row0 + (e >> 5)) * DM + (k0) + (e & 31) * 8); } \
        _Pragma("unroll") for (int k = 0; k < 4; ++k) { const int e = tid + NTHR * k; pb[k] = *(const v4u*)(Wt + (size_t)(col0 + (e >> 5)) * DM + (k0) + (e & 31) * 8); } } while (0)
    SO_LOAD(0);
    float xv4[4], gm4[4];
#pragma unroll
    for (int r = 0; r < 4; ++r) { const int rr = row0 + 16 * mt + 4 * gq + r, cc = col0 + 16 * nt + cl; const size_t o = (size_t)(rr - TP) * DM + cc;
        xv4[r] = XB16 ? bf2f(((const bf16*)xsrc)[o]) : ((const float*)xsrc)[o]; gm4[r] = mod[(size_t)mod_row(rr) * 3072 + 2048 + cc]; }
    for (int k0 = 0; k0 < DM; k0 += 256) {
        __syncthreads();
#pragma unroll
        for (int k = 0; k < 2; ++k) { const int e = tid + NTHR * k; *(v4u*)(As + (e >> 5) * 264 + (e & 31) * 8) = pa[k]; }
#pragma unroll
        for (int k = 0; k < 4; ++k) { const int e = tid + NTHR * k; *(v4u*)(Bs + (e >> 5) * 264 + (e & 31) * 8) = pb[k]; }
        __syncthreads();
        if (k0 + 256 < DM) SO_LOAD(k0 + 256);
#pragma unroll
        for (int ks = 0; ks < 8; ++ks) acc = mm::mfma16(mm::frag_kc(As, 264, 16 * mt, 32 * ks, lane), mm::frag_kc(Bs, 264, 16 * nt, 32 * ks, lane), acc);
    }
#undef SO_LOAD
#pragma unroll
    for (int r = 0; r < 4; ++r) { const int rr = row0 + 16 * mt + 4 * gq + r, cc = col0 + 16 * nt + cl; const size_t o = (size_t)(rr - TP) * DM + cc;
        const float ov = xv4[r] + gm4[r] * acc[r];
        if (OB16) ((bf16*)out)[o] = (bf16)f2bf(ov); else ((float*)out)[o] = ov; }
    __syncthreads();
}
constexpr int NPHASE = 14;
struct Args { const float* in[31]; float* out; unsigned char* ws; int ph_lo, ph_hi; };
__global__ void __launch_bounds__(NTHR, 2) fwd_kernel(Args args) {
    extern __shared__ __attribute__((aligned(16))) unsigned char lds[];
    Frame F;
    F.lds = lds; F.tid = threadIdx.x; F.lane = F.tid & 63; F.wave = __builtin_amdgcn_readfirstlane(F.tid >> 6); F.G = gridDim.x;
    F.out = args.out; F.ws = args.ws;
    volatile LAS unsigned* MISC = (volatile LAS unsigned*)((LAS unsigned char*)lds + MISC_OFF);
    if (F.tid < 64) MISC[F.tid] = 0u;
    __syncthreads();
    const int lo = args.ph_lo, hi = args.ph_hi;
    XcdBarrier bar; bar.bar = (unsigned*)(F.ws + WS_CTL) + CW_BAR; bar.x = 0; bar.st = MISC + 8;
    if (hi - lo > 1) bar = xcd_barrier_post((unsigned*)(F.ws + WS_CTL) + CW_BAR, MISC + 8);
#ifndef DBL
#define DBL 0
#endif
#ifndef PH_MASK
#define PH_MASK 0xffff
#endif
#define IN(k) (((PH_MASK >> (k)) & 1) && lo <= (k) && (k) < hi)
#define SEAM(k) do { if (IN(k) && IN((k) + 1)) xcd_barrier(bar); } while (0)
#define REFRESH() do { int tz_ = threadIdx.x; asm volatile("" : "+v"(tz_)); F.tid = tz_; F.lane = tz_ & 63; } while (0)
    LAS unsigned char* ldsl = (LAS unsigned char*)lds;
    const int bx = blockIdx.x, G = F.G;
    const int vx = (G % 8 == 0) ? (bx % 8) * (G / 8) + bx / 8 : bx;

    if (IN(0)) { REFRESH(); for (int it = G - 1 - bx; it < 96; it += G) mod_item_mfma(F, it);
        rope_phase(F); weights_phase(F, G > 96 ? G - 96 : G); } SEAM(0);
    if (IN(1)) { REFRESH(); normmod_phase<false>(F, INP(0), INP(1), INP(11), WSP(float, WS_MODE)); } SEAM(1);
    if (IN(2)) { REFRESH(); pg8::Gemm g{WSP(bf16, WS_H), WSP(bf16, WS_WINE), MR, NE, DM}; pg8::StaticOrder S; S.init(MR, NE, G, bx);
        EpiL0 E{WSP(bf16, WS_Z), F.out, INP(15), INP(16), WSP(f32x2, WS_ROPE), WSP(float, WS_KMEAN), (float*)(lds + XCH_OFF)}; pg8::gemm_phase<EpiL0, pg8::StaticOrder, true, true>(ldsl, g, S, E); } SEAM(2);
    if (IN(3)) { REFRESH();
        const bool attn_first = (vx & 1) == 0;
        if (!attn_first) { for (int it = bx; it < 1536; it += G) { if (it < 512) kv_local_item<false>(F, it); else { smp_pass1_item(F, it - 512); REFRESH(); } } __syncthreads(); }
        { typedef attn_body::bf16 abf; const abf* Zb = (const abf*)WSP(bf16, WS_Z); abf* MX = (abf*)WSP(bf16, WS_MIX); const float* kpart = WSP(float, WS_KPART); const float* relb = INP(10);
          for (int pi = vx; pi < 256; pi += G) { const int bh = pi >> 3, s = pi & 7;
              attn_body::attn_unit<8>(bh >> 3, bh & 7, 15 - s, Zb + ZQA, Zb + ZKA, Zb + ZVA, Zb + ZGA, MX, kpart, relb, (char*)lds, true);
              attn_body::attn_unit<8>(bh >> 3, bh & 7, s, Zb + ZQA, Zb + ZKA, Zb + ZVA, Zb + ZGA, MX, kpart, relb, (char*)lds, false); } }
        if (attn_first) { for (int it = bx; it < 1536; it += G) { if (it < 512) kv_local_item<false>(F, it); else { smp_pass1_item(F, it - 512); REFRESH(); } } }
    } SEAM(3);
    if (IN(4)) { REFRESH(); ret_scan_phase(F); for (int it = bx; it < 1024; it += G) smp_pass2_item(F, it); } SEAM(4);
    if (IN(5)) { REFRESH(); for (int rep_ = 0; rep_ <= ((DBL >> 0) & 1); ++rep_) for (int it = bx; it < 1024; it += G) { if (it < 512) ret_out_mfma(F, it); else smp_ret_item(F, it - 512); } } SEAM(5);
    if (IN(6)) { REFRESH(); pg8::Gemm g{WSP(bf16, WS_MIX), WSP(bf16, WS_WOUTE), TP, DM, DM}; pg8::StaticOrder S; S.init(TP, DM, G, bx);
        EpiRes<false, true> E{INP(0), INP(1), WSP(float, WS_MODE), WSP(bf16, WS_X1)}; pg8::gemm_phase<EpiRes<false, true>, pg8::StaticOrder, true, true>(ldsl, g, S, E);
        for (int it = bx; it < 256; it += G) smp_outproj_item<false, true>(F, it, WSP(bf16, WS_WOUTE), INP(1), WSP(float, WS_MODE), WSP(bf16, WS_X1) + (size_t)TP * DM); } SEAM(6);
    if (IN(7)) { REFRESH(); normmod_phase<true>(F, WSP(bf16, WS_X1), WSP(bf16, WS_X1) + (size_t)TP * DM, INP(18), WSP(float, WS_MODO)); } SEAM(7);
    if (IN(8)) { REFRESH(); pg8::Gemm g{WSP(bf16, WS_H), WSP(bf16, WS_WINO), MR, NOP, DM}; pg8::StaticOrder S; S.init(MR, NOP, G, bx);
        EpiZ E{WSP(bf16, WS_Z), NOP, WSP(float, WS_DTRAW)}; pg8::gemm_phase<EpiZ, pg8::StaticOrder, true, true>(ldsl, g, S, E); } SEAM(8);
    if (IN(9)) { REFRESH(); post1_phase(F); } SEAM(9);
    if (IN(10)) { REFRESH(); for (int rep_ = 0; rep_ <= ((DBL >> 1) & 1); ++rep_) for (int it = vx; it < 1536; it += G) { if (it < 1024) kv_local_item<true>(F, it); else sgu_mfma(F, it - 1024); } } SEAM(10);
    if (IN(11)) { REFRESH(); ssd_scan_phase(F); for (int rep_ = 0; rep_ <= ((DBL >> 2) & 1); ++rep_) for (int it = bx; it < 256; it += G) smp_l1_item(F, it); } SEAM(11);
    if (IN(12)) { REFRESH(); for (int rep_ = 0; rep_ <= ((DBL >> 3) & 1); ++rep_) for (int it = vx; it < 256; it += G) ssd_out_mfma(F, it); } SEAM(12);
    if (IN(13)) { REFRESH(); pg8::Gemm g{WSP(bf16, WS_MIX), WSP(bf16, WS_WOUTO), TP, DM, DM}; pg8::StaticOrder S; S.init(TP, DM, G, bx);
        EpiRes<true, false> E{WSP(bf16, WS_X1), WSP(bf16, WS_X1) + (size_t)TP * DM, WSP(float, WS_MODO), F.out + O_YP}; pg8::gemm_phase<EpiRes<true, false>, pg8::StaticOrder, true, true>(ldsl, g, S, E);
        for (int it = bx; it < 256; it += G) smp_outproj_item<true, false>(F, it, WSP(bf16, WS_WOUTO), WSP(bf16, WS_X1) + (size_t)TP * DM, WSP(float, WS_MODO), F.out + O_YS); }
#undef IN
#undef SEAM
}

#ifndef N_LAUNCH_MODE
#define N_LAUNCH_MODE 1
#endif
extern "C" void kernel_launch(void* const* d_in, const int* in_sizes, int n_in, void* d_out, int out_size, void* d_ws, size_t ws_size, hipStream_t stream) {
    static int grid = 0;
    if (grid == 0) {
        if (n_in != 31 || out_size != (int)O_END || ws_size < WS_END) { fprintf(stderr, "kernel_launch: unexpected problem shape (n_in %d, out %d, ws %zu)\n", n_in, out_size, ws_size); grid = -1; return; }
        int dev = 0, cus = 0, per_cu = 0;
        if (hipGetDevice(&dev) != hipSuccess || hipDeviceGetAttribute(&cus, hipDeviceAttributeMultiprocessorCount, dev) != hipSuccess) { grid = -1; return; }
        if (hipFuncSetAttribute((const void*)fwd_kernel, hipFuncAttributeMaxDynamicSharedMemorySize, LDS_BYTES) != hipSuccess) { fprintf(stderr, "kernel_launch: hipFuncSetAttribute failed\n"); grid = -1; return; }
        if (hipOccupancyMaxActiveBlocksPerMultiprocessor(&per_cu, (const void*)fwd_kernel, NTHR, LDS_BYTES) != hipSuccess || per_cu < 1) fprintf(stderr, "kernel_launch: occupancy query reports %d\n", per_cu);
        (void)hipGetLastError();
        grid = cus;
    }
    if (grid < 0) return;
    (void)hipMemsetAsync((char*)d_ws + WS_CTL, 0, CTL_ZERO_BYTES, stream);
    Args a{};
    for (int i = 0; i < 31; ++i) a.in[i] = (const float*)d_in[i];
    a.out = (float*)d_out; a.ws = (unsigned char*)d_ws;
#if N_LAUNCH_MODE == 1
    a.ph_lo = 0; a.ph_hi = NPHASE;
    hipLaunchKernelGGL(fwd_kernel, dim3(grid), dim3(NTHR), LDS_BYTES, stream, a);
#else
    for (int k = 0; k < NPHASE; ++k) { a.ph_lo = k; a.ph_hi = k + 1; hipLaunchKernelGGL(fwd_kernel, dim3(grid), dim3(NTHR), LDS_BYTES, stream, a); }
#endif
}
```

```cpp
#include <hip/hip_runtime.h>
#include <cstdio>
#include <cstdint>
#include <hip/hip_bf16.h>
#include <cmath>
namespace pg8 {
#define PG8_LAS __attribute__((address_space(3)))
typedef unsigned short bf16_t;
typedef short bf16x8 __attribute__((ext_vector_type(8)));
typedef float f32x4 __attribute__((ext_vector_type(4)));
typedef unsigned u32x4 __attribute__((ext_vector_type(4)));
constexpr int BM = 256, BK = 64, HALF = 128, HTB = HALF * BK * 2  , STAGE_BYTES = 8 * HTB, NXCD = 8, WGM = 4;

__host__ __device__ __forceinline__ int lds_byte(int r, int c) { const int st = (r >> 4) * 2 + (c >> 5), rr = r & 15, cc = c & 31, ob = rr * 64 + cc * 2; return st * 1024 + (ob ^ (((ob >> 9) & 1) << 5)); }
__host__ __device__ __forceinline__ void stage_rc(int b, int& R, int& C) { const int st = b / 1024, sb = b % 1024, swz = sb ^ (((sb >> 9) & 1) << 5); R = (st >> 1) * 16 + swz / 64; C = (st & 1) * 32 + (swz % 64) / 2; }
__host__ __device__ __forceinline__ int perm32(int rho) { const int n = rho >> 4, i = rho & 15; return 8 * (i >> 2) + 4 * n + (i & 3); }

struct Unit { int pm, pn; };
struct Gemm { const bf16_t* A; const bf16_t* Bt; int M, N, K; };

struct StaticOrder {
    int nM, nN, nwg, G, c;
    __host__ __device__ void init(int M, int N, int G_, int c_) { nM = M / BM; nN = N / BM; nwg = nM * nN; G = G_; c = c_; }
    __host__ __device__ bool next(int i, Unit& u) const {
        const long L = (long)i * G + c; if (L >= nwg) return false;
        int wgid = (int)L; { const int q = nwg / NXCD, r = nwg % NXCD, xcd = wgid % NXCD, off = wgid / NXCD; wgid = (xcd < r ? xcd * (q + 1) : r * (q + 1) + (xcd - r) * q) + off; }
        const int nig = WGM * nN, gid = wgid / nig, fm = gid * WGM, gsz = (nM - fm) < WGM ? (nM - fm) : WGM;
        u.pm = fm + ((wgid % nig) % gsz); u.pn = (wgid % nig) / gsz; return true;
    }
    __device__ __forceinline__ void a_ready(const Unit&) const {}
    __device__ __forceinline__ void done(const Unit&) const {}
};
__device__ __forceinline__ unsigned cvt_pk_bf16(float lo, float hi) { unsigned r; asm volatile("v_cvt_pk_bf16_f32 %0, %1, %2" : "=v"(r) : "v"(lo), "v"(hi)); return r; }

template <class Epi, class Sched, bool ALIGN_EPI = false, bool SP2 = false>
__device__ __forceinline__ void gemm_phase(PG8_LAS unsigned char* lds, const Gemm g, const Sched& S, const Epi& E) {
    const int tid = threadIdx.x, wid = __builtin_amdgcn_readfirstlane(tid >> 6), lane = tid & 63, wr = wid >> 2, wc = wid & 3, fr = lane & 15, fq = lane >> 4;
    const int K = g.K, nt = K / BK;
    unsigned voffA[2], voffB[2];
#pragma unroll
    for (int i = 0; i < 2; ++i) { int R, C; stage_rc(tid * 16 + i * 8192, R, C); const int Rb = Epi::PERM ? ((R & ~31) + perm32(R & 31)) : R;
        voffA[i] = (unsigned)(R * K + C) * 2u; voffB[i] = (unsigned)(Rb * K + C) * 2u; }
    const size_t kstep = (size_t)(BK * 2);
    const size_t hstep = (size_t)HALF * K * 2;
    const size_t tstep = 2 * hstep;
    const unsigned ldsw = (unsigned)wid * 1024u;
    const int aoff = lds_byte(wr * 64 + fr, fq * 8), boff = lds_byte(wc * 32 + fr, fq * 8);
#define PG8_SA(b, h) (((b) * 2 + (h)) * HTB)
#define PG8_SB(b, h) ((4 + (b) * 2 + (h)) * HTB)
#define PG8_STAGE(bufoff, gbase, voff) do { _Pragma("unroll") for (int _i = 0; _i < 2; ++_i) \
        __builtin_amdgcn_global_load_lds((const unsigned*)((const char*)(gbase) + (voff)[_i]), (PG8_LAS unsigned*)(lds + (bufoff) + ldsw + _i * 8192), 16, 0, 0); } while (0)
#define PG8_LDA(dst, b, h) do { _Pragma("unroll") for (int m = 0; m < 4; ++m) _Pragma("unroll") for (int k = 0; k < 2; ++k) dst[m][k] = *(const PG8_LAS bf16x8*)(lds + PG8_SA(b, h) + aoff + m * 2048 + k * 1024); } while (0)
#define PG8_LDB(dst, b, h) do { _Pragma("unroll") for (int n = 0; n < 2; ++n) _Pragma("unroll") for (int k = 0; k < 2; ++k) dst[n][k] = *(const PG8_LAS bf16x8*)(lds + PG8_SB(b, h) + boff + n * 2048 + k * 1024); } while (0)
#define PG8_MMA(ai, bj, At, Bt) do { __builtin_amdgcn_s_setprio(1); _Pragma("unroll") for (int m = 0; m < 4; ++m) _Pragma("unroll") for (int n = 0; n < 2; ++n) _Pragma("unroll") for (int k = 0; k < 2; ++k) \
        acc[ai][bj][m][n] = __builtin_amdgcn_mfma_f32_16x16x32_bf16(Bt[n][k], At[m][k], acc[ai][bj][m][n], 0, 0, 0); __builtin_amdgcn_s_setprio(0); } while (0)
#define PG8_WAIT_V(n) asm volatile("s_waitcnt vmcnt(" #n ")" ::: "memory")
#define PG8_WAIT_L(n) asm volatile("s_waitcnt lgkmcnt(" #n ")" ::: "memory")
#define PG8_BAR __builtin_amdgcn_s_barrier()
#define PG8_SCHED __builtin_amdgcn_sched_barrier(0)
    Unit cur, nxt; int ui = 0;
    if (!S.next(0, cur)) return;
    f32x4 acc[2][2][4][2];
#pragma unroll
    for (int a = 0; a < 2; ++a)
#pragma unroll
        for (int b = 0; b < 2; ++b)
#pragma unroll
            for (int m = 0; m < 4; ++m)
#pragma unroll
                for (int n = 0; n < 2; ++n) acc[a][b][m][n] = (f32x4){0.f, 0.f, 0.f, 0.f};
    bf16x8 At[4][2], B0[2][2], B1[2][2];
    const char* cA = (const char*)g.A + (size_t)cur.pm * tstep; const char* cB = (const char*)g.Bt + (size_t)cur.pn * tstep;
    S.a_ready(cur);
    if constexpr (SP2) {
        PG8_STAGE(PG8_SB(0, 0), cB, voffB); PG8_STAGE(PG8_SB(0, 1), cB + hstep, voffB); PG8_STAGE(PG8_SA(0, 0), cA, voffA); PG8_STAGE(PG8_SA(0, 1), cA + hstep, voffA);
        if (wr == 1) PG8_BAR;
        PG8_WAIT_V(2); PG8_BAR;
        PG8_STAGE(PG8_SB(1, 0), cB + kstep, voffB); PG8_STAGE(PG8_SA(1, 0), cA + kstep, voffA); PG8_STAGE(PG8_SB(1, 1), cB + hstep + kstep, voffB);
        PG8_WAIT_V(6); PG8_BAR;
    } else {
        PG8_STAGE(PG8_SB(0, 0), cB, voffB); PG8_STAGE(PG8_SA(0, 0), cA, voffA); PG8_STAGE(PG8_SB(0, 1), cB + hstep, voffB); PG8_STAGE(PG8_SA(0, 1), cA + hstep, voffA);
        if (wr == 1) PG8_BAR;
        PG8_WAIT_V(4); PG8_BAR;
        PG8_STAGE(PG8_SB(1, 0), cB + kstep, voffB); PG8_STAGE(PG8_SA(1, 0), cA + kstep, voffA); PG8_STAGE(PG8_SB(1, 1), cB + hstep + kstep, voffB);
        PG8_WAIT_V(6); PG8_BAR;
    }
    for (;;) {
        const bool has_next = S.next(ui + 1, nxt);
        const char* nA = has_next ? (const char*)g.A + (size_t)nxt.pm * tstep : cA; const char* nB = has_next ? (const char*)g.Bt + (size_t)nxt.pn * tstep : cB;
        for (int t = 0; t < nt; t += 2) {
            const bool last = (t == nt - 2);
            const char* a1 = cA + (size_t)(t + 1) * kstep;
            const char* a2 = last ? nA : cA + (size_t)(t + 2) * kstep; const char* b2 = last ? nB : cB + (size_t)(t + 2) * kstep;
            const char* a3 = a2 + kstep; const char* b3 = b2 + kstep;
            if (last && has_next) S.a_ready(nxt);
            if constexpr (SP2) {
            PG8_LDB(B0, 0, 0); PG8_LDB(B1, 0, 1); PG8_SCHED; PG8_LDA(At, 0, 0); PG8_STAGE(PG8_SA(1, 1), a1 + hstep, voffA);
            PG8_WAIT_V(8); PG8_WAIT_L(0); PG8_BAR; PG8_MMA(0, 0, At, B0); PG8_MMA(0, 1, At, B1); PG8_BAR; PG8_SCHED;
            PG8_LDA(At, 0, 1); PG8_STAGE(PG8_SB(0, 0), b2, voffB); PG8_STAGE(PG8_SB(0, 1), b2 + hstep, voffB); PG8_STAGE(PG8_SA(0, 0), a2, voffA);
            PG8_WAIT_V(8); PG8_WAIT_L(0); PG8_BAR; PG8_MMA(1, 0, At, B0); PG8_MMA(1, 1, At, B1); PG8_BAR; PG8_SCHED;
            PG8_LDB(B0, 1, 0); PG8_LDB(B1, 1, 1); PG8_SCHED; PG8_LDA(At, 1, 0); PG8_STAGE(PG8_SA(0, 1), a2 + hstep, voffA);
            PG8_WAIT_V(8); PG8_WAIT_L(0); PG8_BAR; PG8_MMA(0, 0, At, B0); PG8_MMA(0, 1, At, B1); PG8_BAR; PG8_SCHED;
            PG8_LDA(At, 1, 1); PG8_STAGE(PG8_SB(1, 0), b3, voffB); PG8_STAGE(PG8_SB(1, 1), b3 + hstep, voffB); PG8_STAGE(PG8_SA(1, 0), a3, voffA);
            PG8_WAIT_V(8); PG8_WAIT_L(0); PG8_BAR; PG8_MMA(1, 0, At, B0); PG8_MMA(1, 1, At, B1); PG8_BAR; PG8_SCHED;
            } else {
            PG8_LDB(B0, 0, 0); PG8_SCHED; PG8_LDA(At, 0, 0); PG8_STAGE(PG8_SA(1, 1), a1 + hstep, voffA);
            PG8_WAIT_L(8); PG8_BAR; PG8_WAIT_L(0); PG8_MMA(0, 0, At, B0); PG8_BAR; PG8_SCHED;
            PG8_LDB(B1, 0, 1); PG8_STAGE(PG8_SB(0, 0), b2, voffB);
            PG8_BAR; PG8_WAIT_L(0); PG8_MMA(0, 1, At, B1); PG8_BAR;
            PG8_LDA(At, 0, 1); PG8_STAGE(PG8_SA(0, 0), a2, voffA);
            PG8_BAR; PG8_WAIT_L(0); PG8_MMA(1, 0, At, B0); PG8_BAR; PG8_SCHED;
            PG8_STAGE(PG8_SB(0, 1), b2 + hstep, voffB);
            PG8_WAIT_V(6); PG8_BAR; PG8_MMA(1, 1, At, B1); PG8_BAR;
            PG8_LDB(B0, 1, 0); PG8_SCHED; PG8_LDA(At, 1, 0); PG8_STAGE(PG8_SA(0, 1), a2 + hstep, voffA);
            PG8_WAIT_L(8); PG8_BAR; PG8_WAIT_L(0); PG8_MMA(0, 0, At, B0); PG8_BAR; PG8_SCHED;
            PG8_LDB(B1, 1, 1); PG8_STAGE(PG8_SB(1, 0), b3, voffB);
            PG8_BAR; PG8_WAIT_L(0); PG8_MMA(0, 1, At, B1); PG8_BAR;
            PG8_LDA(At, 1, 1); PG8_STAGE(PG8_SA(1, 0), a3, voffA);
            PG8_BAR; PG8_WAIT_L(0); PG8_MMA(1, 0, At, B0); PG8_BAR; PG8_SCHED;
            PG8_STAGE(PG8_SB(1, 1), b3 + hstep, voffB);
            PG8_WAIT_V(6); PG8_BAR; PG8_MMA(1, 1, At, B1); PG8_BAR;
            }
        }
        if constexpr (ALIGN_EPI) { if (wr == 0) PG8_BAR; }
        if constexpr (!Epi::AFTER_DRAIN) { E(acc, cur, wr, wc, fr, fq); S.done(cur); }
        if (!has_next) break;
#pragma unroll
        for (int a = 0; a < 2; ++a)
#pragma unroll
            for (int b = 0; b < 2; ++b)
#pragma unroll
                for (int m = 0; m < 4; ++m)
#pragma unroll
                    for (int n = 0; n < 2; ++n) acc[a][b][m][n] = (f32x4){0.f, 0.f, 0.f, 0.f};
        cur = nxt; cA = nA; cB = nB; ++ui;
        if constexpr (ALIGN_EPI) { if (wr == 1) PG8_BAR; }
    }
    PG8_WAIT_V(0);
    if constexpr (!ALIGN_EPI) { if (wr == 0) PG8_BAR; }
    PG8_BAR;
    if constexpr (Epi::AFTER_DRAIN) { E.fused(acc, cur, wr, wc, fr, fq, lds, wid, lane); S.done(cur); }
#undef PG8_SA
#undef PG8_SB
#undef PG8_STAGE
#undef PG8_LDA
#undef PG8_LDB
#undef PG8_MMA
#undef PG8_WAIT_V
#undef PG8_WAIT_L
#undef PG8_BAR
#undef PG8_SCHED
}
}
constexpr int NWAVES = 8, NTHR = 512;
constexpr int DM = 1024, SEQ = 4096, NBP = 4, NBS = 128, TS4 = 4;
constexpr int TP = NBP * SEQ, TS = NBS * TS4, MR = TP + TS;
constexpr int NE = 3584, NO = 3080, NOP = 3328;
constexpr int ZQA = 0, ZKA = 512, ZVA = 1024, ZGA = 1536, ZQB = 2048, ZKB = 2304, ZVB = 2560, ZGB = 3072;
constexpr int YU = 0, YV = 512, YGC = 1024, YZG = 1536, YXBC = 2048, YDT = 3072;
constexpr int NPHYS = 2560, PAGE = 128, NPAGES = 16, PAST = 2048;
constexpr float EPS = 1e-6f;
constexpr size_t O_YP = 0, O_YS = O_YP + (size_t)TP * DM, O_KP = O_YS + (size_t)TS * DM, O_VP = O_KP + (size_t)TP * 512, O_KS = O_VP + (size_t)TP * 512,
    O_VS = O_KS + (size_t)TS * 512, O_RSP = O_VS + (size_t)TS * 512, O_RSS = O_RSP + (size_t)NBP * 4 * 8192, O_SGV = O_RSS + (size_t)NBS * 4 * 8192,
    O_SSP = O_SGV + (size_t)TS * 512, O_SSS = O_SSP + (size_t)NBP * 8 * 8192, O_CSP = O_SSS + (size_t)NBS * 8 * 8192, O_CSS = O_CSP + (size_t)NBP * 3 * 1024,
    O_END = O_CSS + (size_t)NBS * 3 * 1024;
static_assert(O_END == 48246784, "output size");
constexpr size_t MiB = 1u << 20;
constexpr size_t WS_CTL = 0, CTL_ZERO_BYTES = 32768;
constexpr size_t WS_WINE = 2 * MiB, WS_WOUTE = 10 * MiB, WS_WINO = 12 * MiB, WS_WOUTO = 19 * MiB;
constexpr size_t WS_MODE = 21 * MiB, WS_MODO = 23 * MiB;
constexpr size_t WS_ROPE = 25 * MiB;
constexpr size_t WS_KMEAN = 26 * MiB;
constexpr size_t WS_KPART = 26 * MiB;
constexpr size_t WS_DTRAW = 27 * MiB, WS_DTH = 28 * MiB, WS_CUM = 29 * MiB, WS_CDEC = 30 * MiB;
constexpr size_t WS_H = 32 * MiB;
constexpr size_t WS_Z = 66 * MiB;
constexpr size_t WS_MIX = 182 * MiB;
constexpr size_t WS_X1 = 216 * MiB;
constexpr size_t WS_SLR = 282 * MiB;
constexpr size_t WS_SLS = 298 * MiB;
constexpr size_t WS_XC = 330 * MiB;
constexpr size_t WS_SC = 364 * MiB;
constexpr size_t WS_KMS = 396 * MiB;
constexpr size_t WS_PBR = 400 * MiB;
constexpr size_t WS_PBS = 410 * MiB;
constexpr size_t WS_END = 432 * MiB;
constexpr int CW_BAR = 4096;
constexpr int XCH_OFF = 131072;
constexpr int SCR_BYTES = 155648;
constexpr int MISC_OFF = SCR_BYTES;
constexpr int LDS_BYTES = SCR_BYTES + 256;

#define GAS __attribute__((address_space(1)))
#define LAS __attribute__((address_space(3)))
typedef unsigned short bf16;
typedef unsigned v4u __attribute__((ext_vector_type(4)));
typedef unsigned v2u __attribute__((ext_vector_type(2)));
typedef float f32x4 __attribute__((ext_vector_type(4)));
typedef float f32x2 __attribute__((ext_vector_type(2)));
typedef GAS unsigned gu32;
#define RLX_AGENT __ATOMIC_RELAXED, __HIP_MEMORY_SCOPE_AGENT
__device__ __forceinline__ float bf2f(unsigned v16) { return __uint_as_float(v16 << 16); }
__device__ __forceinline__ unsigned f2bf(float f) { unsigned u = __float_as_uint(f); return (u + 0x7fffu + ((u >> 16) & 1u)) >> 16; }
__device__ __forceinline__ unsigned pk2(float lo, float hi) { return f2bf(lo) | (f2bf(hi) << 16); }
__device__ __forceinline__ void unpack8(v4u w, float* f) {
    f[0] = __uint_as_float(w.x << 16); f[1] = __uint_as_float(w.x & 0xffff0000u); f[2] = __uint_as_float(w.y << 16); f[3] = __uint_as_float(w.y & 0xffff0000u);
    f[4] = __uint_as_float(w.z << 16); f[5] = __uint_as_float(w.z & 0xffff0000u); f[6] = __uint_as_float(w.w << 16); f[7] = __uint_as_float(w.w & 0xffff0000u); }
__device__ __forceinline__ v4u pack8(const float* f) { v4u w; w.x = pk2(f[0], f[1]); w.y = pk2(f[2], f[3]); w.z = pk2(f[4], f[5]); w.w = pk2(f[6], f[7]); return w; }
__device__ __forceinline__ float silu_f(float x) { return x / (1.f + __expf(-x)); }
__device__ __forceinline__ float gelu_f(float x) { const float y = 0.7978845608028654f * (x + 0.044715f * x * x * x); const float t = 1.f - 2.f / (__expf(2.f * y) + 1.f); return 0.5f * x * (1.f + t); }
__device__ __forceinline__ float softplus_f(float x) { return x > 20.f ? x : log1pf(__expf(x)); }
__device__ __forceinline__ float wave_sum(float v) {
#pragma unroll
    for (int o = 1; o < 64; o <<= 1) v += __shfl_xor(v, o);
    return v;
}
__device__ __forceinline__ float red8_dpp(float s) {
    s += __int_as_float(__builtin_amdgcn_update_dpp(0, __float_as_int(s), 0xB1, 0xF, 0xF, true));
    s += __int_as_float(__builtin_amdgcn_update_dpp(0, __float_as_int(s), 0x4E, 0xF, 0xF, true));
    s += __int_as_float(__builtin_amdgcn_update_dpp(0, __float_as_int(s), 0x141, 0xF, 0xF, true));
    return s;
}
__device__ __forceinline__ float red16_dpp(float s) {
    s = red8_dpp(s);
    s += __int_as_float(__builtin_amdgcn_update_dpp(0, __float_as_int(s), 0x140, 0xF, 0xF, true));
    return s;
}
__device__ __forceinline__ float wave_max(float v) {
#pragma unroll
    for (int o = 1; o < 64; o <<= 1) v = fmaxf(v, __shfl_xor(v, o));
    return v;
}
__device__ __forceinline__ int t5_bucket(int n) { if (n < 16) return n; const int l = 16 + (int)(logf((float)n * 0.0625f) / 2.0794415416798357f * 16.f); return l < 31 ? l : 31; }
__device__ __forceinline__ int mod_row(int r) { return r < TP ? (r >> 12) : 4 + ((r - TP) >> 2); }
__device__ __forceinline__ int pos_of(int r) { return r < TP ? (r & (SEQ - 1)) : PAST + (r & 3); }
template <int I> __device__ __forceinline__ const float* inp_ptr() {
    const unsigned long long kp = (unsigned long long)__builtin_amdgcn_kernarg_segment_ptr(); unsigned long long v;
    asm volatile("s_load_dwordx2 %0, %1, %2\n\ts_waitcnt lgkmcnt(0)" : "=s"(v) : "s"(kp), "i"(I * 8));
    return (const float*)(const GAS float*)v;
}
#define INP(i) inp_ptr<i>()
namespace attn_body {
using bf16=__hip_bfloat16;
using bf16x8=__attribute__((ext_vector_type(8)))short;
using s16x4=__attribute__((ext_vector_type(4)))short;
using f32x16=__attribute__((ext_vector_type(16)))float;
using u32x4=__attribute__((ext_vector_type(4)))unsigned;
constexpr int BATCH=4,NHEAD=8,SEQ=4096,D=64,DM=3584;
constexpr int NW=8,QBLK=32,QB=QBLK*NW,KVBLK=64,NQB=SEQ/QB;
constexpr int ATTN_PITCH=DM, ATTN_UNIT_ROWS=QB;
__device__ __forceinline__ int crow(int r,int hi){return (r&3)+8*(r>>2)+4*hi;}
#define SBAR() __builtin_amdgcn_sched_barrier(0)
__device__ __forceinline__ void cmask(f32x16&p0,f32x16&p1,int jb,int qrel,int hi){
  const float NEG=-INFINITY; int kb=64*jb+4*hi;
  #pragma unroll
  for(int r=0;r<16;++r){int kv=kb+(r&3)+8*(r>>2); if(kv>qrel)p0[r]=NEG; if(kv+32>qrel)p1[r]=NEG;}
}

__device__ __forceinline__ void cinit(f32x16&c0,f32x16&c1,int t,int NT,int qb,int qrel,int hi,unsigned selm,const float*lut,float mhat){
  const float NEG=-INFINITY; const bool band=t<4; const int pt=band?4*qb+t:t-4;
  const bool keep=(((selm>>((pt>>2)&15))&1u)!=0u);
  if(t>=4&&t<NT-2){ const float v=keep?-mhat:NEG;
    #pragma unroll
    for(int r=0;r<16;++r){c0[r]=v;c1[r]=v;} }
  else { const int lim=band?(qrel-64*t-4*hi):(keep?4096:-4096); const float*lp=lut+256+(256*qb+qrel-64*pt)-4*hi;
    #pragma unroll
    for(int r=0;r<16;++r){ const int c=(r&3)+8*(r>>2); const float b0=lp[-c], b1=lp[-c-32]; c0[r]=(c>lim)?NEG:b0-mhat; c1[r]=(c+32>lim)?NEG:b1-mhat; } }
}
constexpr int NSLOT=3, SLOTB=8192;
constexpr int LDS_K=0, LDS_V=NSLOT*SLOTB, LDS_WS=2*NSLOT*SLOTB, LDS_OST=LDS_WS+NW*64*4, LDS_BYTES=LDS_OST+NW*4096;
constexpr int LUTN=4352;
constexpr int LDS_KM=LDS_BYTES, LDS_LUT=LDS_KM+4096, LDS_TOTAL=LDS_LUT+LUTN*4;
constexpr float C2=0.125f*1.4426950408889634f;
__device__ __forceinline__ void glds16(const void*gsrc,unsigned lds_dst){unsigned keep;
  asm volatile("s_mov_b32 %0, m0\n\ts_mov_b32 m0, %2\n\ts_nop 0\n\tglobal_load_lds_dwordx4 %1, off\n\ts_mov_b32 m0, %0":"=&s"(keep):"v"(gsrc),"s"(lds_dst):"memory");}
__device__ __forceinline__ float max3f(float a,float b,float c){float r;asm("v_max3_f32 %0, %1, %2, %3":"=v"(r):"v"(a),"v"(b),"v"(c));return r;}
__device__ __forceinline__ float max2f(float a,float b){float r;asm("v_max_f32_e32 %0, %1, %2":"=v"(r):"v"(a),"v"(b));return r;}
__device__ __forceinline__ float fadd_s(float a,float b){float r;asm("v_add_f32_e32 %0, %1, %2":"=v"(r):"v"(a),"v"(b));return r;}
__device__ __forceinline__ float fsub_s(float a,float b){float r;asm("v_sub_f32_e32 %0, %1, %2":"=v"(r):"v"(a),"v"(b));return r;}
typedef float f32x2_t __attribute__((ext_vector_type(2))); typedef __bf16 bf16x2_t __attribute__((ext_vector_type(2)));
__device__ __forceinline__ unsigned cvtpk_s(float lo,float hi){f32x2_t v={lo,hi};bf16x2_t b=__builtin_convertvector(v,bf16x2_t);return __builtin_bit_cast(unsigned,b);}
#define WAIT_BAR(N) asm volatile("s_waitcnt vmcnt(" #N ") lgkmcnt(0)\n\ts_barrier":::"memory")

__device__ __forceinline__ void qkt(f32x16&p0,f32x16&p1,const char*Kslot,const bf16x8*qr,int r32,int hi){
  const char*kb=Kslot+hi*1024+r32*16;
  #pragma unroll
  for(int d0=0;d0<4;++d0){
    const bf16x8 b0=*reinterpret_cast<const bf16x8*>(kb+d0*2048);
    const bf16x8 b1=*reinterpret_cast<const bf16x8*>(kb+d0*2048+512);
    p0=__builtin_amdgcn_mfma_f32_32x32x16_bf16(b0,qr[d0],p0,0,0,0);p1=__builtin_amdgcn_mfma_f32_32x32x16_bf16(b1,qr[d0],p1,0,0,0);}
}
typedef __attribute__((address_space(3))) const char* lds_cptr;
typedef short v4i16_t __attribute__((ext_vector_type(4)));
__device__ __forceinline__ void kload8(bf16x8*kf,lds_cptr kp){
  kf[0]=*(const __attribute__((address_space(3))) bf16x8*)(kp);      kf[1]=*(const __attribute__((address_space(3))) bf16x8*)(kp+512);
  kf[2]=*(const __attribute__((address_space(3))) bf16x8*)(kp+2048); kf[3]=*(const __attribute__((address_space(3))) bf16x8*)(kp+2560);
  kf[4]=*(const __attribute__((address_space(3))) bf16x8*)(kp+4096); kf[5]=*(const __attribute__((address_space(3))) bf16x8*)(kp+4608);
  kf[6]=*(const __attribute__((address_space(3))) bf16x8*)(kp+6144); kf[7]=*(const __attribute__((address_space(3))) bf16x8*)(kp+6656);
}
__device__ __forceinline__ void kload2(bf16x8*kf,lds_cptr kp,int j){ kf[2*j]=*(const __attribute__((address_space(3))) bf16x8*)(kp+j*2048); kf[2*j+1]=*(const __attribute__((address_space(3))) bf16x8*)(kp+j*2048+512); }
__device__ __forceinline__ s16x4 vtr(lds_cptr p){ return __builtin_bit_cast(s16x4,__builtin_amdgcn_ds_read_tr16_b64_v4i16((__attribute__((address_space(3))) v4i16_t*)p)); }
__device__ __forceinline__ float rowmax(const f32x16&p0,const f32x16&p1){
  float a=max3f(p0[0],p0[1],p1[0]),b=max3f(p0[2],p0[3],p1[1]);a=max3f(a,p1[2],p1[3]);
  #pragma unroll
  for(int r=4;r<16;r+=4){a=max3f(a,p0[r],p0[r+1]);b=max3f(b,p0[r+2],p0[r+3]);a=max3f(a,p1[r],p1[r+1]);b=max3f(b,p1[r+2],p1[r+3]);}
  const float m=max2f(a,b);
  auto rr=__builtin_amdgcn_permlane32_swap(__float_as_uint(m),__float_as_uint(m),false,false);
  return max2f(__uint_as_float(rr[0]),__uint_as_float(rr[1]));
}
__device__ __forceinline__ void pv(f32x16*o,int vb,bf16x8 pa0,bf16x8 pa1,bf16x8 pa2,bf16x8 pa3){
  #pragma unroll
  for(int d0=0;d0<2;++d0){s16x4 lo[4],hi[4];
    #pragma unroll
    for(int ks=0;ks<4;++ks){
      asm volatile("ds_read_b64_tr_b16 %0,%1 offset:%c2":"=&v"(lo[ks]):"v"(vb),"i"(d0*4096+ks*1024):"memory");
      asm volatile("ds_read_b64_tr_b16 %0,%1 offset:%c2":"=&v"(hi[ks]):"v"(vb),"i"(d0*4096+ks*1024+512):"memory");}
    asm volatile("s_waitcnt lgkmcnt(0)":::"memory");SBAR();
    #define PK(k) (bf16x8){lo[k][0],lo[k][1],lo[k][2],lo[k][3],hi[k][0],hi[k][1],hi[k][2],hi[k][3]}
    o[d0]=__builtin_amdgcn_mfma_f32_32x32x16_bf16(pa0,PK(0),o[d0],0,0,0);
    o[d0]=__builtin_amdgcn_mfma_f32_32x32x16_bf16(pa1,PK(1),o[d0],0,0,0);
    o[d0]=__builtin_amdgcn_mfma_f32_32x32x16_bf16(pa2,PK(2),o[d0],0,0,0);
    o[d0]=__builtin_amdgcn_mfma_f32_32x32x16_bf16(pa3,PK(3),o[d0],0,0,0);
    #undef PK
  }
}

#ifndef ATTN_STORE16
#define ATTN_STORE16(p,v) (*(u32x4*)(p)=(v))
#endif
template<int THRL> __device__ __forceinline__ void attn_unit(int b,int h,int qb,const bf16*Q,const bf16*__restrict__ K,const bf16*__restrict__ V,const bf16*__restrict__ GA,bf16*O,const float*__restrict__ kpart,const float*__restrict__ relb,char*shm,bool setup){
  const int tid=threadIdx.x,lane=tid&63,r32=lane&31,hi=lane>>5; const int wid=__builtin_amdgcn_readfirstlane(tid>>6);
  const long rowbase=(long)b*SEQ; const int q0=qb*QB;
  const bf16*Qw=Q+(rowbase+q0+wid*QBLK)*DM+h*D;
  const bf16*Kh=K+rowbase*DM+h*D,*Vh=V+rowbase*DM+h*D;
  const unsigned lds0=(unsigned)(uintptr_t)shm;
  float*wsf=(float*)(shm+LDS_WS)+wid*64;
  const bf16*ksrc=Kh+(long)lane*DM+wid*8;
  const bf16*vsrc=Vh+(long)(16*(wid&3)+(lane>>2))*DM+(wid>>2)*32+(lane&3)*8;
  const unsigned kdst=lds0+LDS_K+wid*1024, vdst=lds0+LDS_V+wid*1024;
  #define PHYS(t) (((t)<4)?(4*qb+(t)):((t)-4))
  #define DMA_K(t,slot) glds16(ksrc+(long)(PHYS(t))*KVBLK*DM,(unsigned)__builtin_amdgcn_readfirstlane(kdst+(slot)))
  #define DMA_V(t,slot) glds16(vsrc+(long)(PHYS(t))*KVBLK*DM,(unsigned)__builtin_amdgcn_readfirstlane(vdst+(slot)))
  const int vb0=(int)(lds0+LDS_V)+((lane>>4)&1)*32+(lane&3)*8+(4*hi+((lane&15)>>2))*64;
  const char*Kbase=shm+LDS_K; bf16x8 kf[8];
  const lds_cptr shm3=(lds_cptr)shm; const lds_cptr kp0=shm3+LDS_K+hi*1024+r32*16; const lds_cptr vp0=shm3+LDS_V+((lane>>4)&1)*32+(lane&3)*8+(4*hi+((lane&15)>>2))*64;
  const int NT=(q0+QB)/KVBLK;
  bf16x8 qr[4];
  #pragma unroll
  for(int d0=0;d0<4;++d0)qr[d0]=*reinterpret_cast<const bf16x8*>(&Qw[(long)r32*DM+d0*16+hi*8]);
  unsigned selm=0u; const float*lut=(const float*)(shm+LDS_LUT);
  { float*kmn=(float*)(shm+LDS_KM); float*lw=(float*)(shm+LDS_LUT);
    if(setup){
    for(int e=tid;e<qb*64;e+=512){ const int n=e>>6,d=e&63; kmn[e]=kpart[(size_t)(b*16+n)*512+h*64+d]; }
    for(int e=tid;e<LUTN;e+=512){ float v=0.f; if(e>=256&&e<384){ const int dd=e-256; int bk=dd; if(dd>=16){ bk=16+(int)(logf((float)dd*0.0625f)/2.0794415416798357f*16.f); bk=bk<31?bk:31; } v=(relb[bk*8+h]-relb[31*8+h])*1.4426950408889634f; } lw[e]=v; }
    __syncthreads(); }
    float v1=-3e38f,v2=-3e38f,v3=-3e38f; int i1=-1,i2=-1,i3=-1;
    for(int n=0;n<qb;++n){ float s=0.f;
      #pragma unroll
      for(int d0=0;d0<4;++d0){ const float*kp=kmn+n*64+16*d0+8*hi;
        #pragma unroll
        for(int jj=0;jj<8;++jj)s+=__uint_as_float(((unsigned)(unsigned short)qr[d0][jj])<<16)*kp[jj]; }
      s+=__shfl_xor(s,32);
      if(s>v1){v3=v2;i3=i2;v2=v1;i2=i1;v1=s;i1=n;} else if(s>v2){v3=v2;i3=i2;v2=s;i2=n;} else if(s>v3){v3=s;i3=n;} }
    if(i1>=0)selm|=1u<<i1; if(i2>=0)selm|=1u<<i2; if(i3>=0)selm|=1u<<i3; }
  DMA_K(0,0);DMA_V(0,0);DMA_K(1,SLOTB);
  float mhat=0.f,l_reg=0.f;f32x16 o[2];o[0]=f32x16{};o[1]=f32x16{};
  const int qrel=wid*QBLK+r32;
  #define CINIT(P0,P1,t) cinit(P0,P1,(t),NT,qb,qrel,hi,selm,lut,mhat)
  bool resc=false;
  #define START(P0,P1) do{ const float rm=rowmax(P0,P1); resc=false; \
    { const float dl=rm; mhat=fadd_s(mhat,dl); \
      _Pragma("unroll") for(int r=0;r<16;++r){P0[r]=fsub_s(P0[r],dl);P1[r]=fsub_s(P1[r],dl);} \
      } \
    _Pragma("unroll") for(int r=0;r<16;++r)P0[r]=__builtin_amdgcn_exp2f(P0[r]); }while(0)
  #define RESC() do{ if(resc){ asm volatile("s_waitcnt lgkmcnt(0)":::"memory"); \
      _Pragma("unroll") for(int d_=0;d_<2;++d_) _Pragma("unroll") for(int r=0;r<16;++r)o[d_][r]*=wsf[crow(r,hi)]; } }while(0)
  f32x16 pA0,pA1,pB0,pB1;
  int sl_prev=0,sl_cur=0,sl_next=SLOTB;
  #define ROT() do{sl_prev=sl_cur;sl_cur=sl_next;sl_next=(sl_next==(NSLOT-1)*SLOTB)?0:sl_next+SLOTB;}while(0)
  DMA_K(2,2*SLOTB);
  WAIT_BAR(3);
  CINIT(pA0,pA1,0); qkt(pA0,pA1,Kbase,qr,r32,hi);asm volatile("s_nop 15\n\ts_nop 7":"+v"(pA0),"+v"(pA1));
  START(pA0,pA1);
  _Pragma("unroll") for(int r=0;r<16;++r)pA1[r]=__builtin_amdgcn_exp2f(pA1[r]);
  WAIT_BAR(0);
  DMA_K(3,0);DMA_V(1,SLOTB);
  ROT();
  kload8(kf,kp0+sl_cur);
  WAIT_BAR(2);
  s16x4 vlo[8],vhi[8]; u32x4 pw0,pw1,pw2,pw3;
  #define PKW(P,B) cvtpk_s(P[B],P[B+1])
  #define PAF(k) __builtin_bit_cast(bf16x8,pw##k)
  #define VFR(i) (bf16x8){vlo[i][0],vlo[i][1],vlo[i][2],vlo[i][3],vhi[i][0],vhi[i][1],vhi[i][2],vhi[i][3]}
  #define PIN(x) asm volatile("":"+v"(x))
  #define MX3(a,b,c) __builtin_fmaxf(__builtin_fmaxf((a),(b)),(c))
  #define GAPA(MF,A0,A1,A2,A3,W0,W1,PW) do{ MF; sacc+=A0; sacc+=A1; sacc+=A2; sacc+=A3; PIN(sacc); W0; W1; PIN(PW); SBAR(); }while(0)
  #define EX(v) __builtin_amdgcn_exp2f(v)
  #define GAPB(MF,X,B) do{ MF; X[B]=EX(X[B]); X[B+1]=EX(X[B+1]); X[B+2]=EX(X[B+2]); X[B+3]=EX(X[B+3]); PIN(X); SBAR(); }while(0)
  #define VRD(i) do{ vlo[i]=vtr(vp_+(((i)>>2)*4096+((i)&3)*1024)); vhi[i]=vtr(vp_+(((i)>>2)*4096+((i)&3)*1024+512)); }while(0)
  #define KRD(G,j) do{ if(G){ kload2(kf,kp0+sl_next,j); SBAR(); } }while(0)
  #define STEP(C0,C1,P0,P1,t,GK,GV,GL) do{ CINIT(C0,C1,t); SBAR(); \
    const lds_cptr vp_=vp0+sl_prev; \
    VRD(0); SBAR(); float sacc=(P0[0]+P0[1]); \
    GAPA(C0=__builtin_amdgcn_mfma_f32_32x32x16_bf16(kf[0],qr[0],C0,0,0,0), P0[2],P0[3],P0[4],P0[5],     pw0[0]=PKW(P0,0), pw0[1]=PKW(P0,2), pw0); \
    VRD(4); SBAR(); GAPA(C1=__builtin_amdgcn_mfma_f32_32x32x16_bf16(kf[1],qr[0],C1,0,0,0), P0[6],P0[7],P0[8],P0[9],     pw0[2]=PKW(P0,4), pw0[3]=PKW(P0,6), pw0); \
    VRD(1); SBAR(); GAPA(C0=__builtin_amdgcn_mfma_f32_32x32x16_bf16(kf[2],qr[1],C0,0,0,0),   P0[10],P0[11],P0[12],P0[13], pw1[0]=PKW(P0,8), pw1[1]=PKW(P0,10), pw1); \
    VRD(5); SBAR(); GAPA(C1=__builtin_amdgcn_mfma_f32_32x32x16_bf16(kf[3],qr[1],C1,0,0,0),   P0[14],P0[15],P1[0],P1[1],   pw1[2]=PKW(P0,12),pw1[3]=PKW(P0,14), pw1); \
    VRD(2); SBAR(); GAPA(C0=__builtin_amdgcn_mfma_f32_32x32x16_bf16(kf[4],qr[2],C0,0,0,0),   P1[2],P1[3],P1[4],P1[5],     pw2[0]=PKW(P1,0), pw2[1]=PKW(P1,2), pw2); \
    VRD(6); SBAR(); GAPA(C1=__builtin_amdgcn_mfma_f32_32x32x16_bf16(kf[5],qr[2],C1,0,0,0),   P1[6],P1[7],P1[8],P1[9],     pw2[2]=PKW(P1,4), pw2[3]=PKW(P1,6), pw2); \
    VRD(3); SBAR(); GAPA(C0=__builtin_amdgcn_mfma_f32_32x32x16_bf16(kf[6],qr[3],C0,0,0,0),   P1[10],P1[11],P1[12],P1[13], pw3[0]=PKW(P1,8), pw3[1]=PKW(P1,10), pw3); \
    VRD(7); SBAR(); GAPA(C1=__builtin_amdgcn_mfma_f32_32x32x16_bf16(kf[7],qr[3],C1,0,0,0),   P1[14],P1[15],0.f,0.f,       pw3[2]=PKW(P1,12),pw3[3]=PKW(P1,14), pw3); \
    l_reg+=sacc; \
    if(GK){DMA_K((t)+3,sl_cur);} if(GV){DMA_V((t)+1,sl_next);} \
    { float a=MX3(C0[0],C0[1],C1[0]),b=MX3(C0[2],C0[3],C1[1]); a=MX3(a,C1[2],C1[3]); \
      _Pragma("unroll") for(int r=4;r<16;r+=4){a=MX3(a,C0[r],C0[r+1]);b=MX3(b,C0[r+2],C0[r+3]);a=MX3(a,C1[r],C1[r+1]);b=MX3(b,C1[r+2],C1[r+3]);} \
      float rm=__builtin_fmaxf(a,b); { auto rr=__builtin_amdgcn_permlane32_swap(__float_as_uint(rm),__float_as_uint(rm),false,false); rm=__builtin_fmaxf(__uint_as_float(rr[0]),__uint_as_float(rr[1])); } \
      resc=false; \
      if(__builtin_expect(__any(rm>(float)THRL),0)){ const float dl=__builtin_fmaxf(rm,0.f); mhat+=dl; \
        _Pragma("unroll") for(int r=0;r<16;++r){C0[r]-=dl;C1[r]-=dl;} \
        const float f=__builtin_amdgcn_exp2f(-dl); l_reg*=f; if(hi==0)wsf[r32]=f; resc=true; } } \
    SBAR(); \
    GAPB(o[0]=__builtin_amdgcn_mfma_f32_32x32x16_bf16(PAF(0),VFR(0),o[0],0,0,0), C0,0); \
    GAPB(o[1]=__builtin_amdgcn_mfma_f32_32x32x16_bf16(PAF(0),VFR(4),o[1],0,0,0), C0,4); \
    KRD(GL,0); GAPB(o[0]=__builtin_amdgcn_mfma_f32_32x32x16_bf16(PAF(1),VFR(1),o[0],0,0,0), C0,8); \
    KRD(GL,1); GAPB(o[1]=__builtin_amdgcn_mfma_f32_32x32x16_bf16(PAF(1),VFR(5),o[1],0,0,0), C0,12); \
    KRD(GL,2); GAPB(o[0]=__builtin_amdgcn_mfma_f32_32x32x16_bf16(PAF(2),VFR(2),o[0],0,0,0), C1,0); \
    KRD(GL,3); GAPB(o[1]=__builtin_amdgcn_mfma_f32_32x32x16_bf16(PAF(2),VFR(6),o[1],0,0,0), C1,4); \
    GAPB(o[0]=__builtin_amdgcn_mfma_f32_32x32x16_bf16(PAF(3),VFR(3),o[0],0,0,0), C1,8); \
    GAPB(o[1]=__builtin_amdgcn_mfma_f32_32x32x16_bf16(PAF(3),VFR(7),o[1],0,0,0), C1,12); \
    }while(0)
  int t=1;
  for(;t+5<NT;t+=2){
    STEP(pB0,pB1,pA0,pA1,t,true,true,true);     WAIT_BAR(2); RESC(); ROT();
    STEP(pA0,pA1,pB0,pB1,t+1,true,true,true);   WAIT_BAR(2); RESC(); ROT();
  }
  #define ENDW(tt) do{ if((tt)+3<NT){WAIT_BAR(2);} else if((tt)+2<NT){WAIT_BAR(1);} else {WAIT_BAR(0);} }while(0)
  for(;t+1<NT;t+=2){
    STEP(pB0,pB1,pA0,pA1,t,(t+3<NT),(t+1<NT),(t+1<NT));       ENDW(t);   RESC(); ROT();
    STEP(pA0,pA1,pB0,pB1,t+1,(t+4<NT),(t+2<NT),(t+2<NT));     ENDW(t+1); RESC(); ROT();
  }
  STEP(pB0,pB1,pA0,pA1,NT-1,false,false,false); RESC();
  { float sacc=pB0[0]+pB0[1]; _Pragma("unroll") for(int r=2;r<16;++r)sacc+=pB0[r]; _Pragma("unroll") for(int r=0;r<16;++r)sacc+=pB1[r]; l_reg+=sacc;
    pw0=(u32x4){PKW(pB0,0),PKW(pB0,2),PKW(pB0,4),PKW(pB0,6)};pw1=(u32x4){PKW(pB0,8),PKW(pB0,10),PKW(pB0,12),PKW(pB0,14)};pw2=(u32x4){PKW(pB1,0),PKW(pB1,2),PKW(pB1,4),PKW(pB1,6)};pw3=(u32x4){PKW(pB1,8),PKW(pB1,10),PKW(pB1,12),PKW(pB1,14)};
    SBAR(); pv(o,vb0+sl_cur,PAF(0),PAF(1),PAF(2),PAF(3)); }
  #undef PKW
  #undef PAF
  #undef VFR
  #undef PIN
  #undef MX3
  #undef GAPA
  #undef GAPB
  #undef EX
  #undef VRD
  #undef KRD
  #undef STEP
  #undef ENDW
  {auto rr=__builtin_amdgcn_permlane32_swap(__float_as_uint(l_reg),__float_as_uint(l_reg),false,false);l_reg=__uint_as_float(rr[0])+__uint_as_float(rr[1]);}
  if(hi==0)wsf[32+r32]=l_reg;asm volatile("s_waitcnt lgkmcnt(0)":::"memory");
  float rli[16];
  #pragma unroll
  for(int r=0;r<16;++r)rli[r]=__builtin_amdgcn_rcpf(wsf[32+crow(r,hi)]);
  bf16*Ow=O+(rowbase+q0+wid*QBLK)*1024+h*D; const bf16*Gw=GA+(rowbase+q0+wid*QBLK)*DM+h*D;
  { bf16*stg=(bf16*)(shm+LDS_OST)+wid*2048;
    #pragma unroll
    for(int r=0;r<16;++r){const int orow=crow(r,hi);
      #pragma unroll
      for(int d0=0;d0<2;++d0)stg[orow*64+d0*32+r32]=__float2bfloat16(o[d0][r]*rli[r]);}
    asm volatile("s_waitcnt lgkmcnt(0)":::"memory");
    #pragma unroll
    for(int i=0;i<4;++i){const int row=i*8+(lane>>3),ch=lane&7; const u32x4 v=*(const u32x4*)(stg+row*64+ch*8); const u32x4 g=*(const u32x4*)(Gw+(long)row*DM+ch*8); u32x4 w;
      #pragma unroll
      for(int k=0;k<4;++k){ const float lo=__uint_as_float(v[k]<<16)*__uint_as_float(g[k]<<16), hh=__uint_as_float(v[k]&0xffff0000u)*__uint_as_float(g[k]&0xffff0000u); w[k]=cvtpk_s(lo,hh); }
      ATTN_STORE16(Ow+(long)row*1024+ch*8,w);} }
  asm volatile("s_waitcnt lgkmcnt(0)\n\ts_barrier":::"memory");
  #undef DMA_K
  #undef PHYS
  #undef DMA_V
  #undef CINIT
  #undef START
  #undef RESC
  #undef ROT
}
constexpr int ATTN_LDS_BYTES=LDS_TOTAL;
#undef SBAR
#undef WAIT_BAR
}
#define XB_TMO      128
#define XB_XCNT(j)  (256  + 64 * (j))
#define XB_XSUB(j)  (1280 + 64 * (j))
#define XB_XGEN(j)  (2304 + 64 * (j))
#define XB_TOP      3328
#define XB_TOPGEN   3392
#define XCD_BAR_WORDS 3456
#define XB_SPIN_CAP (1u << 18)

__device__ __forceinline__ unsigned xb_ld(unsigned* p)              { return __hip_atomic_load(p, __ATOMIC_RELAXED, __HIP_MEMORY_SCOPE_AGENT); }
__device__ __forceinline__ unsigned xb_add(unsigned* p, unsigned v) { return __hip_atomic_fetch_add(p, v, __ATOMIC_RELAXED, __HIP_MEMORY_SCOPE_AGENT); }
__device__ __forceinline__ unsigned xb_xcc_id() { return (unsigned)__builtin_amdgcn_s_getreg((3 << 11) | 20) & 0xFu; }
#define XB_SPIN(cond, bar) do { unsigned _sp = 0; while (cond) { __builtin_amdgcn_s_sleep(1); \
    if ((++_sp & 255u) == 0u) { if (xb_ld(&(bar)[XB_TMO])) break; if (_sp > XB_SPIN_CAP) { atomicAdd(&(bar)[XB_TMO], 1u); break; } } } } while (0)

struct XcdBarrier {
    unsigned* bar; unsigned x;
    volatile LAS unsigned* st;
};

__device__ __forceinline__ XcdBarrier xcd_barrier_post(unsigned* bar, volatile LAS unsigned* st) {
    XcdBarrier b; b.bar = bar; b.x = xb_xcc_id(); b.st = st;
    if (threadIdx.x == 0) (void)xb_add(&bar[XB_XCNT(b.x)], 1u);
    return b;
}
__device__ __forceinline__ void xcd_barrier_complete(unsigned* bar, unsigned x, unsigned& nloc, unsigned& nx) {
    const unsigned G = gridDim.x * gridDim.y * gridDim.z;
    unsigned sum, cnt, mine, sp = 0u;
    for (;;) {
        sum = 0u; cnt = 0u; mine = 0u;
#pragma unroll
        for (unsigned j = 0; j < 16; ++j) { const unsigned c = xb_ld(&bar[XB_XCNT(j)]); sum += c; cnt += (c > 0u) ? 1u : 0u; mine = (j == x) ? c : mine; }
        if (sum == G) break;
        __builtin_amdgcn_s_sleep(1);
        if ((++sp & 255u) == 0u) { if (xb_ld(&bar[XB_TMO])) break; if (sp > XB_SPIN_CAP) { atomicAdd(&bar[XB_TMO], 1u); break; } }
    }
    nloc = mine > 0u ? mine : 1u; nx = cnt > 0u ? cnt : 1u;
}

__device__ __forceinline__ void xcd_barrier(const XcdBarrier& b) {
    asm volatile("s_waitcnt vmcnt(0)" ::: "memory");
    __syncthreads();
    if (threadIdx.x == 0) {
        unsigned* bar = b.bar;
        __builtin_amdgcn_s_waitcnt(0);
        unsigned nloc = b.st[0], nx = b.st[1];
        if (nloc == 0u) { xcd_barrier_complete(bar, b.x, nloc, nx); b.st[0] = nloc; b.st[1] = nx; }
        const unsigned old = xb_add(&bar[XB_XSUB(b.x)], 1u);
        const unsigned gen = old / nloc;
        if (old + 1u == (gen + 1u) * nloc) {
            __builtin_amdgcn_fence(__ATOMIC_RELEASE, "agent");
            asm volatile("s_waitcnt vmcnt(0)" ::: "memory");
            const unsigned og = xb_add(&bar[XB_TOP], 1u);
            const unsigned tg = og / nx;
            if (og + 1u == (tg + 1u) * nx) xb_add(&bar[XB_TOPGEN], 1u);
            else XB_SPIN(xb_ld(&bar[XB_TOPGEN]) == tg, bar);
            __builtin_amdgcn_fence(__ATOMIC_ACQUIRE, "agent");
            asm volatile("s_waitcnt vmcnt(0)" ::: "memory");
        } else {
            XB_SPIN(xb_ld(&bar[XB_TOPGEN]) == gen, bar);
            __builtin_amdgcn_fence(__ATOMIC_ACQUIRE, "agent");
            asm volatile("s_waitcnt vmcnt(0)" ::: "memory");
        }
    }
    __syncthreads();
}

struct Frame {
    unsigned char* lds;
    int tid, lane, wave, G;
    float* out; unsigned char* ws;
};
#define WSP(T, off) ((T*)(F.ws + (off)))

struct EpiZ {
    static constexpr bool PERM = true, AFTER_DRAIN = false;
    bf16* O; int ldc; float* dt;
    __device__ __forceinline__ void operator()(const pg8::f32x4 (&acc)[2][2][4][2], const pg8::Unit& u, int wr_, int wc_, int fr_, int fq_) const {
        int tz_ = threadIdx.x; asm volatile("" : "+v"(tz_));
        const int fr = tz_ & 15, fq = (tz_ & 63) >> 4, wid_ = __builtin_amdgcn_readfirstlane(tz_ >> 6), wr = wid_ >> 2, wc = wid_ & 3; (void)wr_; (void)wc_; (void)fr_; (void)fq_;
        const int row0 = u.pm * 256 + wr * 64 + fr, col0 = u.pn * 256 + wc * 32 + 8 * fq;
#pragma unroll
        for (int ai = 0; ai < 2; ++ai)
#pragma unroll
            for (int m = 0; m < 4; ++m) { const int row = row0 + ai * 128 + m * 16; bf16* rp = O + (size_t)row * ldc + col0;
#pragma unroll
                for (int bj = 0; bj < 2; ++bj) { const pg8::f32x4 v0 = acc[ai][bj][m][0], v1 = acc[ai][bj][m][1];
                    v4u w; w.x = pg8::cvt_pk_bf16(v0[0], v0[1]); w.y = pg8::cvt_pk_bf16(v0[2], v0[3]); w.z = pg8::cvt_pk_bf16(v1[0], v1[1]); w.w = pg8::cvt_pk_bf16(v1[2], v1[3]);
                    *(v4u*)(rp + bj * 128) = w;
                    if (dt != nullptr && bj == 0 && col0 == YDT) { *(f32x4*)(dt + (size_t)row * 8) = v0; *(f32x4*)(dt + (size_t)row * 8 + 4) = v1; } } }
    }
};
template <bool XB16, bool OB16> struct EpiRes {
    static constexpr bool PERM = true, AFTER_DRAIN = false;
    const void* xp; const void* xs; const float* mod; void* out;
    __device__ __forceinline__ void operator()(const pg8::f32x4 (&acc)[2][2][4][2], const pg8::Unit& u, int wr_, int wc_, int fr_, int fq_) const {
        int tz_ = threadIdx.x; asm volatile("" : "+v"(tz_));
        const int fr = tz_ & 15, fq = (tz_ & 63) >> 4, wid_ = __builtin_amdgcn_readfirstlane(tz_ >> 6), wr = wid_ >> 2, wc = wid_ & 3; (void)wr_; (void)wc_; (void)fr_; (void)fq_;
        const int row0 = u.pm * 256 + wr * 64 + fr, col0 = u.pn * 256 + wc * 32 + 8 * fq;
        const float* gr = mod + (size_t)(u.pm >> 4) * 3072 + 2048; const void* xb = xp;
        f32x4 gv[2][2];
#pragma unroll
        for (int bj = 0; bj < 2; ++bj) { gv[bj][0] = *(const f32x4*)(gr + col0 + bj * 128); gv[bj][1] = *(const f32x4*)(gr + col0 + bj * 128 + 4); }
#pragma unroll
        for (int ai = 0; ai < 2; ++ai)
#pragma unroll
            for (int m = 0; m < 4; ++m) { const int row = row0 + ai * 128 + m * 16;
                const size_t xo = (size_t)row * DM;
#pragma unroll
                for (int bj = 0; bj < 2; ++bj) { const int c = col0 + bj * 128; float x8[8];
                    if (XB16) unpack8(*(const v4u*)((const bf16*)xb + xo + c), x8);
                    else { const f32x4 x0 = *(const f32x4*)((const float*)xb + xo + c), x1 = *(const f32x4*)((const float*)xb + xo + c + 4); x8[0] = x0.x; x8[1] = x0.y; x8[2] = x0.z; x8[3] = x0.w; x8[4] = x1.x; x8[5] = x1.y; x8[6] = x1.z; x8[7] = x1.w; }
                    const f32x4 g0 = gv[bj][0], g1 = gv[bj][1]; const pg8::f32x4 a0 = acc[ai][bj][m][0], a1 = acc[ai][bj][m][1];
                    float o[8] = {x8[0] + g0.x * a0[0], x8[1] + g0.y * a0[1], x8[2] + g0.z * a0[2], x8[3] + g0.w * a0[3], x8[4] + g1.x * a1[0], x8[5] + g1.y * a1[1], x8[6] + g1.z * a1[2], x8[7] + g1.w * a1[3]};
                    if (OB16) *(v4u*)((bf16*)out + (size_t)row * DM + c) = pack8(o);
                    else { float* op = (float*)out + (size_t)row * DM + c; *(f32x4*)(op) = (f32x4){o[0], o[1], o[2], o[3]}; *(f32x4*)((op + 4)) = (f32x4){o[4], o[5], o[6], o[7]}; } } }
    }
};

template <bool PERMQK> __device__ __forceinline__ void transpose_item(const float* W, int K, int N, int Npad, bf16* WT, float* scr, int item, int lane) {
    const int nblk = Npad / 32, kb = item / nblk, nb = item % nblk, k0 = 64 * kb, n0 = 32 * nb;
    int nn = n0 + (lane & 31);
    if (PERMQK && nn >= ZQB && nn < ZVB) { const int p = nn & 63; nn = (nn & ~63) + (p >> 1) + 32 * (p & 1); }
#pragma unroll 8
    for (int i = 0; i < 32; ++i) { const int kk = 2 * i + (lane >> 5); scr[kk * 33 + (lane & 31)] = (nn < N) ? W[(size_t)(k0 + kk) * N + nn] : 0.f; }
    asm volatile("s_waitcnt lgkmcnt(0)" ::: "memory");
    const int c = lane & 7;
#pragma unroll
    for (int j = 0; j < 4; ++j) { const int n = (lane >> 3) + 8 * j; const float* s = scr + (8 * c) * 33 + n;
        v4u o; o.x = pk2(s[0 * 33], s[1 * 33]); o.y = pk2(s[2 * 33], s[3 * 33]); o.z = pk2(s[4 * 33], s[5 * 33]); o.w = pk2(s[6 * 33], s[7 * 33]);
        *(v4u*)(WT + (size_t)(n0 + n) * K + k0 + 8 * c) = o; }
    asm volatile("s_waitcnt lgkmcnt(0)" ::: "memory");
}
__device__ __forceinline__ void weights_phase(Frame& F, int nwg) {
    if ((int)blockIdx.x >= nwg) return;
    const int gw = blockIdx.x * NWAVES + F.wave, NGW = nwg * NWAVES;
    float* scr = (float*)(F.lds + F.wave * 8704);
    constexpr int I_EIN = 16 * (NE / 32), I_EOUT = 16 * 32, I_OIN = 16 * (NOP / 32), I_OOUT = 16 * 32;
    for (int it = gw; it < I_EIN + I_EOUT + I_OIN + I_OOUT; it += NGW) {
        int r = it;
        if (r < I_EIN) { transpose_item<true>(INP(14), DM, NE, NE, WSP(bf16, WS_WINE), scr, r, F.lane); continue; } r -= I_EIN;
        if (r < I_EOUT) { transpose_item<false>(INP(17), DM, DM, DM, WSP(bf16, WS_WOUTE), scr, r, F.lane); continue; } r -= I_EOUT;
        if (r < I_OIN) { transpose_item<false>(INP(21), DM, NO, NOP, WSP(bf16, WS_WINO), scr, r, F.lane); continue; } r -= I_OIN;
        transpose_item<false>(INP(30), DM, DM, DM, WSP(bf16, WS_WOUTO), scr, r, F.lane);
    }
}
__device__ __forceinline__ void rope_phase(Frame& F) {
    f32x2* rope = WSP(f32x2, WS_ROPE);
    for (int e = blockIdx.x * NTHR + F.tid; e < 4096 * 32; e += F.G * NTHR) { const int pos = e >> 5, i = e & 31;
        const float inv = exp2f(-(float)i * (13.287712379549449f / 32.f));
        const double turns = (double)((float)pos * inv) * 0.15915494309189535;
        const float fr = (float)(turns - floor(turns));
        f32x2 cs; cs.x = __builtin_amdgcn_cosf(fr); cs.y = __builtin_amdgcn_sinf(fr); rope[e] = cs; }
}
template <bool XB16> __device__ __forceinline__ void normmod_phase(Frame& F, const void* xp, const void* xs, const float* nw, const float* mod) {
    const int gw = blockIdx.x * NWAVES + F.wave, NGW = F.G * NWAVES; bf16* H = WSP(bf16, WS_H);
    f32x4 w4[4];
#pragma unroll
    for (int j = 0; j < 4; ++j) w4[j] = *(const f32x4*)(nw + 4 * F.lane + 256 * j);
    for (int r = gw; r < MR; r += NGW) {
        const size_t xo = (r < TP) ? (size_t)r * DM : (size_t)(r - TP) * DM; const void* xb = (r < TP) ? xp : xs; const float* mr = mod + (size_t)mod_row(r) * 3072;
        f32x4 v[4], sh[4], scl[4]; float s = 0.f;
#pragma unroll
        for (int j = 0; j < 4; ++j) { const int c = 4 * F.lane + 256 * j;
            if (XB16) { const v2u w = *(const v2u*)((const bf16*)xb + xo + c); v[j] = (f32x4){bf2f(w.x & 0xffffu), __uint_as_float(w.x & 0xffff0000u), bf2f(w.y & 0xffffu), __uint_as_float(w.y & 0xffff0000u)}; }
            else v[j] = *(const f32x4*)((const float*)xb + xo + c);
            sh[j] = *(const f32x4*)(mr + c); scl[j] = *(const f32x4*)(mr + 1024 + c); }
#pragma unroll
        for (int j = 0; j < 4; ++j) s += (v[j].x * v[j].x + v[j].y * v[j].y) + (v[j].z * v[j].z + v[j].w * v[j].w);
        const float rstd = rsqrtf(wave_sum(s) * (1.f / DM) + EPS);
#pragma unroll
        for (int j = 0; j < 4; ++j) { const int c = 4 * F.lane + 256 * j; const f32x4 w = w4[j];
            const float a = v[j].x * rstd * w.x * (1.f + scl[j].x) + sh[j].x, b = v[j].y * rstd * w.y * (1.f + scl[j].y) + sh[j].y, cc = v[j].z * rstd * w.z * (1.f + scl[j].z) + sh[j].z, d = v[j].w * rstd * w.w * (1.f + scl[j].w) + sh[j].w;
            v2u o; o.x = pk2(a, b); o.y = pk2(cc, d); *(v2u*)(H + (size_t)r * DM + c) = o; }
    }
}
struct EpiL0 {
    static constexpr bool PERM = true, AFTER_DRAIN = false;
    bf16* Z; float* out; const float* qw; const float* kw; const f32x2* rope; float* kmean; float* xs;
    __device__ __forceinline__ void store8(bf16* p, const float* f) const { v4u w; w.x = pg8::cvt_pk_bf16(f[0], f[1]); w.y = pg8::cvt_pk_bf16(f[2], f[3]); w.z = pg8::cvt_pk_bf16(f[4], f[5]); w.w = pg8::cvt_pk_bf16(f[6], f[7]); *(v4u*)p = w; }
    __device__ __forceinline__ void operator()(const pg8::f32x4 (&acc)[2][2][4][2], const pg8::Unit& u, int wr_, int wc_, int fr_, int fq_) const {
        int tz_ = threadIdx.x; asm volatile("" : "+v"(tz_));
        const int fr = tz_ & 15, fq = (tz_ & 63) >> 4, wid_ = __builtin_amdgcn_readfirstlane(tz_ >> 6), wr = wid_ >> 2, wc = wid_ & 3; (void)wr_; (void)wc_; (void)fr_; (void)fq_;
        const int pn = u.pn, rl0 = wr * 64 + fr, cw = wc * 32 + 8 * fq, col0 = pn * 256 + cw;
        if (pn < 4) {
            const bool isk = pn >= 2; const float* nw = isk ? kw : qw; const int ch = cw & 63;
            float w8[8];
#pragma unroll
            for (int j = 0; j < 8; ++j) w8[j] = nw[ch + j];
#pragma unroll
            for (int ai = 0; ai < 2; ++ai)
#pragma unroll
                for (int bj = 0; bj < 2; ++bj)
#pragma unroll
                    for (int m = 0; m < 4; ++m) { const pg8::f32x4 v0 = acc[ai][bj][m][0], v1 = acc[ai][bj][m][1];
                        float s = (v0[0] * v0[0] + v0[1] * v0[1]) + (v0[2] * v0[2] + v0[3] * v0[3]) + (v1[0] * v1[0] + v1[1] * v1[1]) + (v1[2] * v1[2] + v1[3] * v1[3]);
                        s += __shfl_xor(s, 16); s += __shfl_xor(s, 32);
                        if (fq == 0) xs[(ai * 128 + rl0 + m * 16) * 8 + bj * 4 + wc] = s; }
            asm volatile("s_waitcnt lgkmcnt(0)" ::: "memory"); __builtin_amdgcn_s_barrier(); asm volatile("" ::: "memory");
            float cs[2][8];
#pragma unroll
            for (int bj = 0; bj < 2; ++bj)
#pragma unroll
                for (int j = 0; j < 8; ++j) cs[bj][j] = 0.f;
#pragma unroll
            for (int ai = 0; ai < 2; ++ai)
#pragma unroll
                for (int m = 0; m < 4; ++m) { const int rl = ai * 128 + rl0 + m * 16, row = u.pm * 256 + rl;
#pragma unroll
                    for (int bj = 0; bj < 2; ++bj) { const float tot = xs[rl * 8 + bj * 4 + wc] + xs[rl * 8 + bj * 4 + (wc ^ 1)];
                        float rs = rsqrtf(tot * (1.f / 64.f) + EPS); if (!isk && row < TP) rs *= attn_body::C2;
                        const pg8::f32x4 v0 = acc[ai][bj][m][0], v1 = acc[ai][bj][m][1];
                        float f[8] = {v0[0] * rs * w8[0], v0[1] * rs * w8[1], v0[2] * rs * w8[2], v0[3] * rs * w8[3], v1[0] * rs * w8[4], v1[1] * rs * w8[5], v1[2] * rs * w8[6], v1[3] * rs * w8[7]};
                        store8(Z + (size_t)row * NE + col0 + bj * 128, f);
                        if (isk) { float* ko = ((row < TP) ? out + O_KP + (size_t)row * 512 : out + O_KS + (size_t)(row - TP) * 512) + (pn - 2) * 256 + bj * 128 + cw;
                            *(f32x4*)(ko) = (f32x4){f[0], f[1], f[2], f[3]}; *(f32x4*)((ko + 4)) = (f32x4){f[4], f[5], f[6], f[7]};
#pragma unroll
                            for (int j = 0; j < 8; ++j) cs[bj][j] += f[j]; } } }
            if (isk && u.pm < TP / 256) { float* ks = xs + 2048;
#pragma unroll
                for (int bj = 0; bj < 2; ++bj)
#pragma unroll
                    for (int j = 0; j < 8; ++j) { float v = cs[bj][j]; v += __shfl_xor(v, 1); v += __shfl_xor(v, 2); v += __shfl_xor(v, 4); v += __shfl_xor(v, 8); cs[bj][j] = v;
                        if (wr == 1 && fr == 0) ks[bj * 128 + cw + j] = v; }
                asm volatile("s_waitcnt lgkmcnt(0)" ::: "memory"); __builtin_amdgcn_s_barrier(); asm volatile("" ::: "memory");
                if (wr == 0 && fr == 0) {
#pragma unroll
                    for (int bj = 0; bj < 2; ++bj)
#pragma unroll
                        for (int j = 0; j < 8; ++j) kmean[(size_t)u.pm * 512 + (pn - 2) * 256 + bj * 128 + cw + j] = (cs[bj][j] + ks[bj * 128 + cw + j]) * (1.f / 256.f); } }
        } else if (pn == 8 || pn == 9) {
            const float sc = (pn == 9) ? 0.125f : 1.f; const int i0 = (cw & 63) >> 1;
#pragma unroll
            for (int ai = 0; ai < 2; ++ai)
#pragma unroll
                for (int m = 0; m < 4; ++m) { const int row = u.pm * 256 + ai * 128 + rl0 + m * 16; const f32x2* rp = rope + pos_of(row) * 32 + i0;
                    const f32x4 r01 = *(const f32x4*)rp, r23 = *(const f32x4*)(rp + 2);
#pragma unroll
                    for (int bj = 0; bj < 2; ++bj) { const pg8::f32x4 v0 = acc[ai][bj][m][0], v1 = acc[ai][bj][m][1];
                        float f[8] = {(v0[0] * r01.x - v0[1] * r01.y) * sc, (v0[0] * r01.y + v0[1] * r01.x) * sc, (v0[2] * r01.z - v0[3] * r01.w) * sc, (v0[2] * r01.w + v0[3] * r01.z) * sc,
                                      (v1[0] * r23.x - v1[1] * r23.y) * sc, (v1[0] * r23.y + v1[1] * r23.x) * sc, (v1[2] * r23.z - v1[3] * r23.w) * sc, (v1[2] * r23.w + v1[3] * r23.z) * sc};
                        store8(Z + (size_t)row * NE + col0 + bj * 128, f); } }
        } else {
            const bool act = (pn == 6 || pn == 7 || pn >= 12), isv = (pn == 4 || pn == 5);
#pragma unroll
            for (int ai = 0; ai < 2; ++ai)
#pragma unroll
                for (int m = 0; m < 4; ++m) { const int row = u.pm * 256 + ai * 128 + rl0 + m * 16;
#pragma unroll
                    for (int bj = 0; bj < 2; ++bj) { const pg8::f32x4 v0 = acc[ai][bj][m][0], v1 = acc[ai][bj][m][1];
                        float f[8] = {v0[0], v0[1], v0[2], v0[3], v1[0], v1[1], v1[2], v1[3]};
                        if (act) {
#pragma unroll
                            for (int j = 0; j < 8; ++j) f[j] = silu_f(f[j]); }
                        store8(Z + (size_t)row * NE + col0 + bj * 128, f);
                        if (isv) { float* vo = ((row < TP) ? out + O_VP + (size_t)row * 512 : out + O_VS + (size_t)(row - TP) * 512) + (pn - 4) * 256 + bj * 128 + cw;
                            *(f32x4*)(vo) = (f32x4){f[0], f[1], f[2], f[3]}; *(f32x4*)((vo + 4)) = (f32x4){f[4], f[5], f[6], f[7]}; } } }
        }
    }
};
__device__ __forceinline__ float ret_log2g(int h) { return log2f(1.f - exp2f(-5.f - (float)h)); }
__device__ __forceinline__ void smp_pass1_item(Frame& F, int item) {
    const int n = item & 7, b = item >> 3; const bf16* Z = WSP(bf16, WS_Z); const float* ck = INP(2); const int* pt = (const int*)INP(7);
    float* scs = (float*)F.lds;
    float* red = scs + 32 * 256;
    int tz_ = threadIdx.x; asm volatile("" : "+v"(tz_));
    const int tid_ = tz_, lane = tz_ & 63, wave_ = __builtin_amdgcn_readfirstlane(tz_ >> 6), c4 = lane * 4;
    float q[4][8];
#pragma unroll
    for (int t = 0; t < 4; ++t) { const bf16* qr = Z + (size_t)(TP + b * 4 + t) * NE + ZQA + c4; const uint2 lo = *(const uint2*)qr, hi = *(const uint2*)(qr + 256);
        q[t][0] = __uint_as_float(lo.x << 16); q[t][1] = __uint_as_float(lo.x & 0xffff0000u); q[t][2] = __uint_as_float(lo.y << 16); q[t][3] = __uint_as_float(lo.y & 0xffff0000u);
        q[t][4] = __uint_as_float(hi.x << 16); q[t][5] = __uint_as_float(hi.x & 0xffff0000u); q[t][6] = __uint_as_float(hi.y << 16); q[t][7] = __uint_as_float(hi.y & 0xffff0000u); }
    float ks[8];
#pragma unroll
    for (int i = 0; i < 8; ++i) ks[i] = 0.f;
    const int pg0 = pt[b * NPAGES + 2 * n], pg1 = pt[b * NPAGES + 2 * n + 1];
    __syncthreads();
    f32x4 ka0[4], kb0[4], ka1[4], kb1[4], ka2[4], kb2[4];
    const __amdgpu_buffer_rsrc_t krs = __builtin_amdgcn_make_buffer_rsrc((void*)ck, (short)0, (int)((size_t)NPHYS * PAGE * 512 * 4), 0x00020000);
    const int kvo = lane * 16, pgu0 = __builtin_amdgcn_readfirstlane(pg0), pgu1 = __builtin_amdgcn_readfirstlane(pg1);
#define P1_LOAD(KA, KB, bt) do { const int so_ = ((((bt) < 4) ? pgu0 : pgu1) * PAGE + wave_ + 32 * ((bt) & 3)) * 2048; \
        _Pragma("unroll") for (int u = 0; u < 4; ++u) { KA[u] = __builtin_bit_cast(f32x4, __builtin_amdgcn_raw_buffer_load_b128(krs, kvo, so_ + u * 16384, 2)); \
                                                         KB[u] = __builtin_bit_cast(f32x4, __builtin_amdgcn_raw_buffer_load_b128(krs, kvo + 1024, so_ + u * 16384, 2)); } } while (0)
#define P1_COMP(KA, KB, bt) do { _Pragma("unroll") for (int u = 0; u < 4; ++u) { const int r = wave_ + 8 * (4 * (bt) + u); \
        const float k[8] = {KA[u].x, KA[u].y, KA[u].z, KA[u].w, KB[u].x, KB[u].y, KB[u].z, KB[u].w}; \
        _Pragma("unroll") for (int i = 0; i < 8; ++i) ks[i] += k[i]; \
        _Pragma("unroll") for (int t = 0; t < 4; ++t) { float s0 = (q[t][0] * k[0] + q[t][1] * k[1]) + (q[t][2] * k[2] + q[t][3] * k[3]), s1 = (q[t][4] * k[4] + q[t][5] * k[5]) + (q[t][6] * k[6] + q[t][7] * k[7]); \
            s0 = red16_dpp(s0); s1 = red16_dpp(s1); \
            if ((lane & 15) == 0) { scs[((lane >> 4) * 4 + t) * 256 + r] = s0; scs[((4 + (lane >> 4)) * 4 + t) * 256 + r] = s1; } } } } while (0)
#define P1_SB __builtin_amdgcn_sched_barrier(0)
    P1_LOAD(ka0, kb0, 0); P1_LOAD(ka1, kb1, 1); P1_SB;
#pragma unroll 1
    for (int bt = 0; bt < 6; bt += 3) {
        P1_LOAD(ka2, kb2, bt + 2); P1_SB; P1_COMP(ka0, kb0, bt);     P1_SB;
        P1_LOAD(ka0, kb0, bt + 3); P1_SB; P1_COMP(ka1, kb1, bt + 1); P1_SB;
        P1_LOAD(ka1, kb1, bt + 4); P1_SB; P1_COMP(ka2, kb2, bt + 2); P1_SB;
    }
    P1_COMP(ka0, kb0, 6); P1_SB; P1_COMP(ka1, kb1, 7); P1_SB;
#undef P1_SB
#undef P1_LOAD
#undef P1_COMP
#pragma unroll
    for (int i = 0; i < 8; ++i) red[wave_ * 512 + (i >> 2) * 256 + c4 + (i & 3)] = ks[i];
    __syncthreads();
    { float s = 0.f;
#pragma unroll
      for (int w = 0; w < 8; ++w) s += red[w * 512 + tid_];
      WSP(float, WS_KMS)[(size_t)(b * 8 + n) * 512 + tid_] = s * (1.f / 256.f); }
    float* SC = WSP(float, WS_SC);
    for (int e = tid_; e < 32 * 256; e += NTHR) { const int ht = e >> 8, r = e & 255; SC[((size_t)(b * 8 + (ht >> 2)) * 4 + (ht & 3)) * 2048 + n * 256 + r] = scs[e]; }
}
__device__ __forceinline__ void smp_ret_item(Frame& F, int item) {
    const int h = item & 3, b = item >> 2; const bf16* Z = WSP(bf16, WS_Z); bf16* MIX = WSP(bf16, WS_MIX);
    float* qs = (float*)F.lds;
    float* ks = qs + 256;
    float* vs = ks + 256;
    float* po = vs + 512;
    float* qk = po + 2048;
    float* red = qk + 16;
    const int tid = F.tid, e = tid & 127, dq = tid >> 7; const int rs0 = TP + b * 4; const float lg = ret_log2g(h);
    const float* stp = INP(4) + (size_t)((b * 4 + h) * 64 + dq * 16) * 128 + e; float* nsp = F.out + O_RSS + (size_t)((b * 4 + h) * 64 + dq * 16) * 128 + e;
    float st[16];
#pragma unroll
    for (int dd = 0; dd < 16; ++dd) st[dd] = __builtin_nontemporal_load(stp + dd * 128);
    const float gb = bf2f(Z[(size_t)(rs0 + dq) * NE + ZGB + h * 128 + e]);
    __syncthreads();
    if (tid < 256) { const int i = tid >> 6, d = tid & 63, pd = 2 * (d & 31) + (d >> 5);
        qs[tid] = bf2f(Z[(size_t)(rs0 + i) * NE + ZQB + h * 64 + pd]); ks[tid] = bf2f(Z[(size_t)(rs0 + i) * NE + ZKB + h * 64 + pd]); }
    { const int i = tid >> 7; vs[tid] = bf2f(Z[(size_t)(rs0 + i) * NE + ZVB + h * 128 + e]); }
    __syncthreads();
    if (tid < 16) { const int i = tid >> 2, jj = tid & 3; float s = 0.f; for (int d = 0; d < 64; ++d) s += qs[i * 64 + d] * ks[jj * 64 + d]; qk[tid] = (jj <= i) ? s * exp2f((float)(i - jj) * lg) : 0.f; }
    float pa[4] = {0.f, 0.f, 0.f, 0.f};
    const float g4 = exp2f(4.f * lg), g3 = exp2f(3.f * lg), g2 = exp2f(2.f * lg), g1 = exp2f(lg);
#pragma unroll
    for (int dd = 0; dd < 16; ++dd) { const int d = dq * 16 + dd;
        const float ns = st[dd] * g4 + g3 * ks[d] * vs[e] + g2 * ks[64 + d] * vs[128 + e] + g1 * ks[128 + d] * vs[256 + e] + ks[192 + d] * vs[384 + e];
        __builtin_nontemporal_store(ns, nsp + dd * 128);
#pragma unroll
        for (int i = 0; i < 4; ++i) pa[i] += qs[i * 64 + d] * st[dd]; }
#pragma unroll
    for (int i = 0; i < 4; ++i) po[(dq * 4 + i) * 128 + e] = pa[i];
    __syncthreads();
    { const int i = dq; float inter = po[(0 * 4 + i) * 128 + e] + po[(1 * 4 + i) * 128 + e] + po[(2 * 4 + i) * 128 + e] + po[(3 * 4 + i) * 128 + e];
      inter *= exp2f((float)(i + 1) * lg); float intra = 0.f;
      for (int jj = 0; jj <= i; ++jj) intra += qk[i * 4 + jj] * vs[jj * 128 + e];
      const float ov = intra + inter; const float ss = wave_sum(ov * ov);
      if (F.lane == 0) red[F.wave] = ss;
      __syncthreads();
      const float rstd = rsqrtf((red[2 * i] + red[2 * i + 1]) * (1.f / 128.f) + EPS);
      MIX[(size_t)(rs0 + i) * DM + 512 + h * 128 + e] = (bf16)f2bf(ov * rstd * gb); }
}
__device__ __forceinline__ void ret_scan_phase(Frame& F) {
    const float* S = WSP(float, WS_SLR); bf16* PB = WSP(bf16, WS_PBR);
    for (int idx = blockIdx.x * NTHR + F.tid; idx < 16 * 4096; idx += F.G * NTHR) { const int bh = idx >> 12, e = (idx & 4095) * 2; const float g128 = exp2f(128.f * ret_log2g(bh & 3));
        const float* p = S + (size_t)bh * 32 * 8192 + e; bf16* q = PB + (size_t)bh * 32 * 8192 + e; f32x2 st = (f32x2){0.f, 0.f};
        f32x2 loc[32];
#pragma unroll
        for (int c = 0; c < 32; ++c) loc[c] = *(const f32x2*)(p + (size_t)c * 8192);
#pragma unroll
        for (int c = 0; c < 32; ++c) { *(unsigned*)(q + (size_t)c * 8192) = pk2(st.x, st.y); st = st * g128 + loc[c]; }
        { const int dp = e >> 7, dorig = (dp >> 1) + 32 * (dp & 1); *(f32x2*)(F.out + O_RSP + (size_t)bh * 8192 + dorig * 128 + (e & 127)) = st; } }
}
__device__ __forceinline__ void smp_pass2_item(Frame& F, int item) {
    const int h = item & 7, b = item >> 3; const bf16* Z = WSP(bf16, WS_Z); bf16* MIX = WSP(bf16, WS_MIX); const float* cv = INP(3); const int* pt = (const int*)INP(7);
    float* P = (float*)F.lds;
    float* km = P + 4 * 2056;
    float* qs = km + 512;
    float* gts = qs + 256;
    float* biasT = gts + 32;
    float* red = biasT + 264;
    float* stat = red + 2304;
    unsigned* selm = (unsigned*)(stat + 8);
    int* pgl = (int*)(selm + 8);
    int tz_ = threadIdx.x; asm volatile("" : "+v"(tz_));
    const int tid = tz_, lane_ = tz_ & 63, rs0 = TP + b * 4;
    float scv[16];
    { const float* SC = WSP(float, WS_SC) + (size_t)(b * 8 + h) * 4 * 2048;
#pragma unroll
      for (int k = 0; k < 16; ++k) scv[k] = SC[tid + NTHR * k]; }
    __syncthreads();
    if (tid < 16) pgl[tid] = pt[b * NPAGES + tid];
    { const int n = tid >> 6, d = tid & 63; km[tid] = WSP(float, WS_KMS)[(size_t)(b * 8 + n) * 512 + h * 64 + d]; }
    if (tid < 256) qs[tid] = bf2f(Z[(size_t)(rs0 + (tid >> 6)) * NE + ZQA + h * 64 + (tid & 63)]);
    { const float* rb = INP(10); for (int e = tid; e < 264; e += NTHR) biasT[e] = rb[t5_bucket(e) * 8 + h]; }
    __syncthreads();
    if (tid < 32) { const int t = tid >> 3, n = tid & 7; float s = 0.f; for (int d = 0; d < 64; ++d) s += qs[t * 64 + d] * km[n * 64 + d]; gts[tid] = s; }
    __syncthreads();
    if (tid < 4) { unsigned mk = 0u;
        for (int r = 0; r < 3; ++r) { float best = -3e38f; int bi = 0; for (int n = 0; n < 8; ++n) if (!((mk >> n) & 1u) && gts[tid * 8 + n] > best) { best = gts[tid * 8 + n]; bi = n; } mk |= 1u << bi; }
        selm[tid] = mk; }
    __syncthreads();
    const unsigned un = selm[0] | selm[1] | selm[2] | selm[3]; const int rsub = lane_ >> 4, d4 = (lane_ & 15) * 4;
    f32x4 va[8], vb[8];
    const __amdgpu_buffer_rsrc_t vrs = __builtin_amdgcn_make_buffer_rsrc((void*)cv, (short)0, (int)((size_t)NPHYS * PAGE * 512 * 4), 0x00020000);
    const int vvo = rsub * 2048 + h * 256 + d4 * 4;
#define P2_LOAD(V, n) do { const int pg0_ = __builtin_amdgcn_readfirstlane(pgl[2 * (n)]), pg1_ = __builtin_amdgcn_readfirstlane(pgl[2 * (n) + 1]); \
        _Pragma("unroll") for (int it = 0; it < 8; ++it) { const int so_ = (((it < 4) ? pg0_ : pg1_) * PAGE + (it & 3) * 32 + F.wave * 4) * 2048; \
            V[it] = __builtin_bit_cast(f32x4, __builtin_amdgcn_raw_buffer_load_b128(vrs, vvo, so_, 2)); } } while (0)
    unsigned rem = un; int nA = __ffs(rem) - 1; rem &= rem - 1u; P2_LOAD(va, nA);
#pragma unroll
    for (int k = 0; k < 16; ++k) { const int e = tid + NTHR * k, t = e >> 11, idx = e & 2047, n = idx >> 8; const int dist = PAST + t - idx;
        P[t * 2056 + idx] = ((selm[t] >> n) & 1u) ? scv[k] * 0.125f + biasT[dist > 263 ? 263 : dist] : -1e30f; }
    if (tid < 16) { const int t = tid >> 2, t2 = tid & 3; float s = -1e30f;
        if (t2 <= t) { float a = 0.f; for (int d = 0; d < 64; ++d) a += qs[t * 64 + d] * bf2f(Z[(size_t)(rs0 + t2) * NE + ZKA + h * 64 + d]); s = a * 0.125f + biasT[t - t2]; }
        P[t * 2056 + 2048 + t2] = s; }
    __syncthreads();
    { const int t = F.wave >> 1, hf = F.wave & 1; float mx = -1e30f;
      for (int i = lane_ + 64 * hf; i < 2052; i += 128) mx = fmaxf(mx, P[t * 2056 + i]);
      mx = wave_max(mx); if (lane_ == 0) red[F.wave] = mx;
      __syncthreads();
      const float M = fmaxf(red[2 * t], red[2 * t + 1]); float sm = 0.f;
      for (int i = lane_ + 64 * hf; i < 2052; i += 128) { const float x = P[t * 2056 + i]; const float p = (x > -1e29f) ? __expf(x - M) : 0.f; P[t * 2056 + i] = p; sm += p; }
      sm = wave_sum(sm); if (lane_ == 0) red[8 + F.wave] = sm;
      __syncthreads();
      if (tid < 4) stat[4 + tid] = 1.f / (red[8 + 2 * tid] + red[8 + 2 * tid + 1]); }
    __syncthreads();
    float acc[4][4];
#pragma unroll
    for (int t = 0; t < 4; ++t)
#pragma unroll
        for (int k = 0; k < 4; ++k) acc[t][k] = 0.f;
#define P2_COMP(V, n) do { _Pragma("unroll") for (int it = 0; it < 8; ++it) { const int r = (it * 8 + F.wave) * 4 + rsub; \
        _Pragma("unroll") for (int t = 0; t < 4; ++t) { const float p = P[t * 2056 + (n) * 256 + r]; acc[t][0] += p * V[it].x; acc[t][1] += p * V[it].y; acc[t][2] += p * V[it].z; acc[t][3] += p * V[it].w; } } } while (0)
    f32x4 vc[8];
    int nB = __ffs(rem) - 1; rem &= rem - 1u; P2_LOAD(vb, nB);
    int nC = __ffs(rem) - 1; rem &= rem - 1u; P2_LOAD(vc, nC);
    for (;;) {
        P2_COMP(va, nA); nA = -1; if (rem) { nA = __ffs(rem) - 1; rem &= rem - 1u; P2_LOAD(va, nA); }
        if (nB < 0) break;
        P2_COMP(vb, nB); nB = -1; if (rem) { nB = __ffs(rem) - 1; rem &= rem - 1u; P2_LOAD(vb, nB); }
        if (nC < 0) break;
        P2_COMP(vc, nC); nC = -1; if (rem) { nC = __ffs(rem) - 1; rem &= rem - 1u; P2_LOAD(vc, nC); }
        if (nA < 0) break; }
#undef P2_LOAD
#undef P2_COMP
    if (F.wave == 0 && rsub == 0) { for (int t2 = 0; t2 < 4; ++t2) { float vf[4];
#pragma unroll
            for (int k = 0; k < 4; ++k) vf[k] = bf2f(Z[(size_t)(rs0 + t2) * NE + ZVA + h * 64 + d4 + k]);
#pragma unroll
            for (int t = 0; t < 4; ++t) { const float p = P[t * 2056 + 2048 + t2];
#pragma unroll
                for (int k = 0; k < 4; ++k) acc[t][k] += p * vf[k]; } } }
#pragma unroll
    for (int t = 0; t < 4; ++t)
#pragma unroll
        for (int k = 0; k < 4; ++k) { float v = acc[t][k]; v += __shfl_xor(v, 16); v += __shfl_xor(v, 32); acc[t][k] = v; }
    if (rsub == 0) {
#pragma unroll
        for (int t = 0; t < 4; ++t)
#pragma unroll
            for (int k = 0; k < 4; ++k) red[256 + (F.wave * 4 + t) * 64 + d4 + k] = acc[t][k]; }
    __syncthreads();
    if (tid < 256) { const int t = tid >> 6, d = tid & 63; float s = 0.f;
#pragma unroll
        for (int w = 0; w < 8; ++w) s += red[256 + (w * 4 + t) * 64 + d];
        const float g = bf2f(Z[(size_t)(rs0 + t) * NE + ZGA + h * 64 + d]);
        MIX[(size_t)(rs0 + t) * DM + h * 64 + d] = (bf16)f2bf(s * stat[4 + t] * g); }
}
__device__ __forceinline__ void post1_phase(Frame& F) {
    bf16* Z = WSP(bf16, WS_Z); bf16* XC = WSP(bf16, WS_XC); const float* cw = INP(24); const float* cb = INP(25); const float* scv = INP(6); const float* dtb = INP(26);
    const int gw = blockIdx.x * NWAVES + F.wave, NGW = F.G * NWAVES, lane = F.lane, c8 = lane * 8;
    float wgt[2][4][8], bia[2][8];
#pragma unroll
    for (int hf = 0; hf < 2; ++hf) { const int cc = hf * 512 + c8;
#pragma unroll
        for (int i = 0; i < 8; ++i) { bia[hf][i] = cb[cc + i];
#pragma unroll
            for (int w = 0; w < 4; ++w) wgt[hf][w][i] = cw[w * 1024 + cc + i]; } }
    const float dtbl = (lane < 8) ? dtb[lane] : 0.f;
    auto tap = [&](int r, int w, int cc) -> v4u { const int t = (r < TP) ? (r & (SEQ - 1)) : (r & 3), tt = t - 3 + w;
        if (tt >= 0) return *(const v4u*)(Z + (size_t)(r - 3 + w) * NOP + YXBC + cc);
        if (r >= TP) { const float* sp = scv + (size_t)(((r - TP) >> 2) * 3 + (tt + 3)) * 1024 + cc; const f32x4 a = *(const f32x4*)sp, b = *(const f32x4*)(sp + 4);
            v4u o; o.x = pk2(a.x, a.y); o.y = pk2(a.z, a.w); o.z = pk2(b.x, b.y); o.w = pk2(b.z, b.w); return o; }
        return (v4u){0u, 0u, 0u, 0u}; };
    for (int r0 = gw; r0 < MR; r0 += 2 * NGW) {
        const int r1 = (r0 + NGW < MR) ? r0 + NGW : r0;
        v4u vraw[2], xt[2][2][4]; float dtr[2];
#pragma unroll
        for (int q = 0; q < 2; ++q) { const int r = q ? r1 : r0; vraw[q] = *(const v4u*)(Z + (size_t)r * NOP + YV + c8); dtr[q] = (lane < 8) ? WSP(float, WS_DTRAW)[(size_t)r * 8 + lane] : 0.f;
#pragma unroll
            for (int hf = 0; hf < 2; ++hf)
#pragma unroll
                for (int w = 0; w < 4; ++w) xt[q][hf][w] = tap(r, w, hf * 512 + c8); }
#pragma unroll
        for (int q = 0; q < 2; ++q) { const int r = q ? r1 : r0; bf16* zr = Z + (size_t)r * NOP; float f[8];
            unpack8(vraw[q], f); float s = 0.f;
#pragma unroll
            for (int i = 0; i < 8; ++i) { f[i] = gelu_f(f[i]); s += f[i]; }
            const float mu = wave_sum(s) * (1.f / 512.f); float s2 = 0.f;
#pragma unroll
            for (int i = 0; i < 8; ++i) { f[i] -= mu; s2 += f[i] * f[i]; }
            const float rstd = rsqrtf(wave_sum(s2) * (1.f / 512.f) + EPS);
#pragma unroll
            for (int i = 0; i < 8; ++i) f[i] *= rstd;
            *(v4u*)(zr + YV + c8) = pack8(f);
            if (r >= TP) { float* o = F.out + O_SGV + (size_t)(r - TP) * 512 + c8; *(f32x4*)o = (f32x4){f[0], f[1], f[2], f[3]}; *(f32x4*)(o + 4) = (f32x4){f[4], f[5], f[6], f[7]}; }
            const int t = (r < TP) ? (r & (SEQ - 1)) : (r & 3); const int bs = (r - TP) >> 2;
#pragma unroll
            for (int hf = 0; hf < 2; ++hf) { const int cc = hf * 512 + c8; float a[8], x[8];
#pragma unroll
                for (int i = 0; i < 8; ++i) a[i] = bia[hf][i];
#pragma unroll
                for (int w = 0; w < 4; ++w) { unpack8(xt[q][hf][w], x);
#pragma unroll
                    for (int i = 0; i < 8; ++i) a[i] += x[i] * wgt[hf][w][i]; }
#pragma unroll
                for (int i = 0; i < 8; ++i) a[i] = silu_f(a[i]);
                *(v4u*)(XC + (size_t)r * 1024 + cc) = pack8(a);
                float* so = nullptr;
                if (r < TP) { if (t >= SEQ - 3) so = F.out + O_CSP + (size_t)((r >> 12) * 3 + (t - (SEQ - 3))) * 1024 + cc; }
                else if (t >= 1) so = F.out + O_CSS + (size_t)(bs * 3 + (t - 1)) * 1024 + cc;
                if (so) { *(f32x4*)so = (f32x4){x[0], x[1], x[2], x[3]}; *(f32x4*)(so + 4) = (f32x4){x[4], x[5], x[6], x[7]}; } }
            if (lane < 8) WSP(float, WS_DTH)[(size_t)r * 8 + lane] = softplus_f(dtr[q] + dtbl);
        }
    }
}
__device__ __forceinline__ void smp_l1_item(Frame& F, int item) {
    const int g = item & 1, b = item >> 1; const bf16* Z = WSP(bf16, WS_Z); const bf16* XC = WSP(bf16, WS_XC); bf16* MIX = WSP(bf16, WS_MIX); const float* DTH = WSP(float, WS_DTH);
    float* st = (float*)F.lds;
    float* xs = st + 64 * 129;
    float* bsm = xs + 1024;
    float* csm = bsm + 512;
    float* ygs = csm + 512;
    float* yp = ygs + 1024;
    float* cum = yp + 512;
    float* dts = cum + 16;
    float* cbs = dts + 16;
    const int tid = F.tid, rs0 = TP + b * 4;
    const float* sgw = INP(22); const float* sgb = INP(23); const float* alog = INP(27); const float* ssm_in = INP(5); const float* Dp = INP(28); const float* nw = INP(29);
    f32x4 sreg[4];
#pragma unroll
    for (int k = 0; k < 4; ++k) sreg[k] = __builtin_nontemporal_load((const f32x4*)(ssm_in + (size_t)(b * 8 + g * 4) * 8192 + tid * 4 + 2048 * k));
    __syncthreads();
    if (tid < 256) { const int col = g * 256 + tid, gc = col >> 7; float vn[4];
#pragma unroll
        for (int i = 0; i < 4; ++i) vn[i] = bf2f(Z[(size_t)(rs0 + i) * NOP + YV + col]);
#pragma unroll
        for (int i = 0; i < 4; ++i) { float a = sgb[gc * 128 + i];
#pragma unroll
            for (int jj = 0; jj < 4; ++jj) if (jj <= i) a += sgw[(size_t)gc * 16384 + i * 128 + jj] * vn[jj];
            const size_t zo = (size_t)(rs0 + i) * NOP + col;
            MIX[(size_t)(rs0 + i) * DM + col] = (bf16)f2bf(gelu_f(bf2f(Z[zo + YU])) * a * silu_f(bf2f(Z[zo + YGC]))); } }
    for (int e = tid; e < 1024; e += NTHR) { const int i = e >> 8, cc = e & 255; xs[e] = bf2f(XC[(size_t)(rs0 + i) * 1024 + g * 256 + cc]); }
    { const int i = tid >> 7, n = tid & 127; bsm[tid] = bf2f(XC[(size_t)(rs0 + i) * 1024 + 512 + g * 128 + n]); csm[tid] = bf2f(XC[(size_t)(rs0 + i) * 1024 + 768 + g * 128 + n]); }
    if (tid < 16) dts[tid] = DTH[(size_t)(rs0 + (tid >> 2)) * 8 + g * 4 + (tid & 3)];
    __syncthreads();
    if (tid < 4) { const float A = -__expf(alog[g * 4 + tid]); float s = 0.f; for (int i = 0; i < 4; ++i) { s += dts[i * 4 + tid] * A; cum[i * 4 + tid] = s; } }
    if (tid >= 64 && tid < 80) { const int i = (tid - 64) >> 2, jj = (tid - 64) & 3; float s = 0.f; for (int n = 0; n < 128; ++n) s += csm[i * 128 + n] * bsm[jj * 128 + n]; cbs[i * 4 + jj] = s; }
    __syncthreads();
    for (int hq = 0; hq < 4; ++hq) { const int h = g * 4 + hq; const float* sp = ssm_in + (size_t)(b * 8 + h) * 8192; float* so = F.out + O_SSS + (size_t)(b * 8 + h) * 8192;
#pragma unroll
        for (int k = 0; k < 4; ++k) { const int e = tid * 4 + 2048 * k; float* sd = st + (e >> 7) * 129 + (e & 127); sd[0] = sreg[k].x; sd[1] = sreg[k].y; sd[2] = sreg[k].z; sd[3] = sreg[k].w; }
        __syncthreads();
        if (hq < 3) {
#pragma unroll
            for (int k = 0; k < 4; ++k) sreg[k] = __builtin_nontemporal_load((const f32x4*)(sp + 8192 + tid * 4 + 2048 * k)); }
        const float c0 = cum[0 * 4 + hq], c1 = cum[1 * 4 + hq], c2 = cum[2 * 4 + hq], c3 = cum[3 * 4 + hq];
        { const int n = tid & 127, pq = tid >> 7; const float e3 = __expf(c3);
          const float w0 = __expf(c3 - c0) * dts[0 * 4 + hq] * bsm[n], w1 = __expf(c3 - c1) * dts[1 * 4 + hq] * bsm[128 + n], w2 = __expf(c3 - c2) * dts[2 * 4 + hq] * bsm[256 + n], w3 = dts[3 * 4 + hq] * bsm[384 + n];
#pragma unroll 4
          for (int pp = 0; pp < 16; ++pp) { const int p = pq * 16 + pp;
              __builtin_nontemporal_store(st[p * 129 + n] * e3 + w0 * xs[hq * 64 + p] + w1 * xs[256 + hq * 64 + p] + w2 * xs[512 + hq * 64 + p] + w3 * xs[768 + hq * 64 + p], so + p * 128 + n); } }
        { const int p = tid & 63, i = (tid >> 6) & 3, nh = tid >> 8; float s = 0.f;
          for (int n = nh * 64; n < nh * 64 + 64; ++n) s += csm[i * 128 + n] * st[p * 129 + n];
          yp[(nh * 4 + i) * 64 + p] = s; }
        __syncthreads();
        if (tid < 256) { const int p = tid & 63, i = tid >> 6; const float ci = cum[i * 4 + hq]; float y = __expf(ci) * (yp[i * 64 + p] + yp[(4 + i) * 64 + p]);
            for (int jj = 0; jj <= i; ++jj) y += cbs[i * 4 + jj] * __expf(ci - cum[jj * 4 + hq]) * dts[jj * 4 + hq] * xs[jj * 256 + hq * 64 + p];
            y += Dp[h] * xs[i * 256 + hq * 64 + p];
            ygs[i * 256 + hq * 64 + p] = y * silu_f(bf2f(Z[(size_t)(rs0 + i) * NOP + YZG + h * 64 + p])); }
        __syncthreads();
    }
    if (tid < 256) { const int i = tid >> 6; float v[4]; float ss = 0.f;
#pragma unroll
        for (int k = 0; k < 4; ++k) { v[k] = ygs[i * 256 + F.lane + 64 * k]; ss += v[k] * v[k]; }
        const float rstd = rsqrtf(wave_sum(ss) * (1.f / 256.f) + EPS);
#pragma unroll
        for (int k = 0; k < 4; ++k) { const int col = g * 256 + F.lane + 64 * k; MIX[(size_t)(rs0 + i) * DM + 512 + col] = (bf16)f2bf(v[k] * rstd * nw[col]); } }
}
__device__ __forceinline__ void ssd_scan_phase(Frame& F) {
    const float* S = WSP(float, WS_SLS); bf16* PB = WSP(bf16, WS_PBS); const float* cdec = WSP(float, WS_CDEC);
    for (int idx = blockIdx.x * NTHR + F.tid; idx < 32 * 4096; idx += F.G * NTHR) { const int bh = idx >> 12, e = (idx & 4095) * 2, b = bh >> 3, h = bh & 7; f32x2 st = (f32x2){0.f, 0.f};
        f32x2 loc[32];
#pragma unroll
        for (int c = 0; c < 32; ++c) loc[c] = *(const f32x2*)(S + (size_t)((b * 32 + c) * 8 + h) * 8192 + e);
#pragma unroll
        for (int c = 0; c < 32; ++c) { const size_t o = (size_t)((b * 32 + c) * 8 + h) * 8192 + e; *(unsigned*)(PB + o) = pk2(st.x, st.y); st = st * cdec[(b * 32 + c) * 8 + h] + loc[c]; }
        *(f32x2*)(F.out + O_SSP + (size_t)bh * 8192 + e) = st; }
}
namespace mm {
typedef short bf16x8 __attribute__((ext_vector_type(8)));
typedef short s16x4 __attribute__((ext_vector_type(4)));
#define MM_LAS __attribute__((address_space(3)))
__device__ __forceinline__ f32x4 mfma16(bf16x8 a, bf16x8 b, f32x4 c) { return __builtin_amdgcn_mfma_f32_16x16x32_bf16(a, b, c, 0, 0, 0); }
__device__ __forceinline__ bf16x8 frag_kc(const bf16* X, int pitch, int r0, int k0, int lane) { return *(const bf16x8*)(X + (r0 + (lane & 15)) * pitch + k0 + 8 * (lane >> 4)); }
__device__ __forceinline__ s16x4 trd(const bf16* p) { return __builtin_bit_cast(s16x4, __builtin_amdgcn_ds_read_tr16_b64_v4i16((MM_LAS s16x4*)p)); }
__device__ __forceinline__ bf16x8 frag_tr(const bf16* Y, int pitch, int ka, int kb, int n0, int lane) {
    const int m = lane & 15; const bf16* pa = Y + (ka + (m >> 2)) * pitch + n0 + 4 * (m & 3); const bf16* pb = Y + (kb + (m >> 2)) * pitch + n0 + 4 * (m & 3);
    const s16x4 lo = trd(pa), hi = trd(pb); return (bf16x8){lo[0], lo[1], lo[2], lo[3], hi[0], hi[1], hi[2], hi[3]};
}
__device__ __forceinline__ bf16x8 frag_tr_std(const bf16* Y, int pitch, int k0, int n0, int lane) { const int g = lane >> 4; return frag_tr(Y, pitch, k0 + 8 * g, k0 + 8 * g + 4, n0, lane); }
__device__ __forceinline__ bf16x8 frag_tr_acc(const bf16* Y, int pitch, int k0, int n0, int lane) { const int g = lane >> 4; return frag_tr(Y, pitch, k0 + 4 * g, k0 + 16 + 4 * g, n0, lane); }
__device__ __forceinline__ bf16x8 pack_acc(const float* l0, const float* l1) { v4u w; w.x = pk2(l0[0], l0[1]); w.y = pk2(l0[2], l0[3]); w.z = pk2(l1[0], l1[1]); w.w = pk2(l1[2], l1[3]); return __builtin_bit_cast(bf16x8, w); }
}

template <bool SSD> __device__ __forceinline__ void kv_local_item(Frame& F, int item) {
    bf16* As = (bf16*)F.lds;
    bf16* Bs = As + 128 * 72;
    float* wj = (float*)(Bs + 128 * 144);
    float* cum = wj + 128;
    const int tid = F.tid; int b, c, h; float* S;
    if (SSD) { h = item & 7; c = (item >> 3) & 31; b = item >> 8; S = WSP(float, WS_SLS) + (size_t)((b * 32 + c) * 8 + h) * 8192; }
    else { c = item & 31; h = (item >> 5) & 3; b = item >> 7; S = WSP(float, WS_SLR) + (size_t)((b * 4 + h) * 32 + c) * 8192; }
    const int r0 = b * SEQ + c * 128;
    const bf16* srcA = SSD ? WSP(bf16, WS_XC) + (size_t)r0 * 1024 + h * 64 : WSP(bf16, WS_Z) + (size_t)r0 * NE + ZKB + h * 64;
    const bf16* srcB = SSD ? WSP(bf16, WS_XC) + (size_t)r0 * 1024 + 512 + (h >> 2) * 128 : WSP(bf16, WS_Z) + (size_t)r0 * NE + ZVB + h * 128;
    const int pitch = SSD ? 1024 : NE;
    v4u ra[2], rb[4];
#pragma unroll
    for (int k = 0; k < 2; ++k) { const int e = tid + NTHR * k; ra[k] = *(const v4u*)(srcA + (size_t)(e >> 3) * pitch + (e & 7) * 8); }
#pragma unroll
    for (int k = 0; k < 4; ++k) { const int e = tid + NTHR * k; rb[k] = *(const v4u*)(srcB + (size_t)(e >> 4) * pitch + (e & 15) * 8); }
    float dthv = 0.f, Aneg = 0.f;
    if (SSD) { if (tid < 128) dthv = WSP(float, WS_DTH)[(size_t)(r0 + tid) * 8 + h]; Aneg = -__expf(INP(27)[h]); }
    __syncthreads();
    if (SSD) { float* dts = cum + 128;
        if (tid < 128) dts[tid] = dthv;
        __syncthreads();
        if (tid < 64) { const float a0 = dts[2 * tid] * Aneg, a1 = dts[2 * tid + 1] * Aneg; float s = a0 + a1;
#pragma unroll
            for (int o = 1; o < 64; o <<= 1) { const float t = __shfl_up(s, o); if (F.lane >= o) s += t; }
            cum[2 * tid] = s - a1; cum[2 * tid + 1] = s; }
        __syncthreads();
        if (tid < 128) { const float cj = cum[tid], cl = cum[127]; WSP(float, WS_CUM)[(size_t)(r0 + tid) * 8 + h] = cj; wj[tid] = __expf(cl - cj) * dthv;
            if (tid == 0) WSP(float, WS_CDEC)[(b * 32 + c) * 8 + h] = __expf(cl); }
    } else { if (tid < 128) wj[tid] = exp2f((float)(127 - tid) * ret_log2g(h)); }
    __syncthreads();
#pragma unroll
    for (int k = 0; k < 2; ++k) { const int e = tid + NTHR * k, j = e >> 3, cc = (e & 7) * 8; float f[8]; unpack8(ra[k], f); const float w = wj[j];
#pragma unroll
        for (int q = 0; q < 8; ++q) f[q] *= w;
        *(v4u*)(As + j * 72 + cc) = pack8(f); }
#pragma unroll
    for (int k = 0; k < 4; ++k) { const int e = tid + NTHR * k; *(v4u*)(Bs + (e >> 4) * 144 + (e & 15) * 8) = rb[k]; }
    __syncthreads();
    const int lane = F.lane, dt = F.wave & 3, et0 = (F.wave >> 2) * 4;
    f32x4 acc[4];
#pragma unroll
    for (int q = 0; q < 4; ++q) acc[q] = (f32x4){0.f, 0.f, 0.f, 0.f};
#pragma unroll
    for (int ks = 0; ks < 4; ++ks) { const mm::bf16x8 af = mm::frag_tr_std(As, 72, 32 * ks, 16 * dt, lane);
#pragma unroll
        for (int q = 0; q < 4; ++q) acc[q] = mm::mfma16(af, mm::frag_tr_std(Bs, 144, 32 * ks, 16 * (et0 + q), lane), acc[q]); }
    const int gq = lane >> 4, cl = lane & 15;
#pragma unroll
    for (int q = 0; q < 4; ++q)
#pragma unroll
        for (int r = 0; r < 4; ++r) S[(16 * dt + 4 * gq + r) * 128 + 16 * (et0 + q) + cl] = acc[q][r];
}
__device__ __forceinline__ void ret_out_mfma(Frame& F, int item) {
    const int c = item & 31, h = (item >> 5) & 3, b = item >> 7; const bf16* Z = WSP(bf16, WS_Z); bf16* MIX = WSP(bf16, WS_MIX);
    bf16* Qs = (bf16*)F.lds;
    bf16* Ks = Qs + 128 * 72;
    bf16* Vs = Ks + 128 * 72;
    bf16* Ps = Vs + 128 * 144;
    const int tid = F.tid, r0 = b * SEQ + c * 128; const float lg = ret_log2g(h);
    __syncthreads();
    for (int e = tid; e < 128 * 8; e += NTHR) { const int j = e >> 3, cc = (e & 7) * 8; const size_t zo = (size_t)(r0 + j) * NE + h * 64 + cc;
        *(v4u*)(Qs + j * 72 + cc) = *(const v4u*)(Z + zo + ZQB); *(v4u*)(Ks + j * 72 + cc) = *(const v4u*)(Z + zo + ZKB); }
    for (int e = tid; e < 128 * 16; e += NTHR) { const int j = e >> 4, cc = (e & 15) * 8; *(v4u*)(Vs + j * 144 + cc) = *(const v4u*)(Z + (size_t)(r0 + j) * NE + ZVB + h * 128 + cc); }
    { const bf16* Pp = WSP(bf16, WS_PBR) + (size_t)((b * 4 + h) * 32 + c) * 8192;
      for (int e = tid; e < 64 * 16; e += NTHR) { const int d = e >> 4, cc = (e & 15) * 8; *(v4u*)(Ps + d * 144 + cc) = *(const v4u*)(Pp + d * 128 + cc); } }
    __syncthreads();
    v4u gbr[4];
#pragma unroll
    for (int k = 0; k < 4; ++k) { const int e = tid + NTHR * k; gbr[k] = *(const v4u*)(Z + (size_t)(r0 + (e >> 4)) * NE + ZGB + h * 128 + (e & 15) * 8); }
    const int w = F.wave, lane = F.lane, gq = lane >> 4, cl = lane & 15;
    f32x4 sT[8];
#pragma unroll
    for (int a = 0; a < 8; ++a) { sT[a] = (f32x4){0.f, 0.f, 0.f, 0.f};
        if (a <= w) {
#pragma unroll
            for (int ks = 0; ks < 2; ++ks) sT[a] = mm::mfma16(mm::frag_kc(Ks, 72, 16 * a, 32 * ks, lane), mm::frag_kc(Qs, 72, 16 * w, 32 * ks, lane), sT[a]); } }
    f32x4 ain[8], aix[8];
#pragma unroll
    for (int et = 0; et < 8; ++et) { ain[et] = (f32x4){0.f, 0.f, 0.f, 0.f}; aix[et] = (f32x4){0.f, 0.f, 0.f, 0.f}; }
#pragma unroll
    for (int ks = 0; ks < 2; ++ks) { const mm::bf16x8 af = mm::frag_kc(Qs, 72, 16 * w, 32 * ks, lane);
#pragma unroll
        for (int et = 0; et < 8; ++et) ain[et] = mm::mfma16(af, mm::frag_tr_std(Ps, 144, 32 * ks, 16 * et, lane), ain[et]); }
    const int ii = 16 * w + cl;
#pragma unroll
    for (int m = 0; m < 4; ++m) { if (2 * m <= w) { float l0[4], l1[4];
#pragma unroll
            for (int r = 0; r < 4; ++r) { const int j0 = 32 * m + 4 * gq + r, j1 = j0 + 16;
                l0[r] = (j0 <= ii) ? sT[2 * m][r] * exp2f((float)(ii - j0) * lg) : 0.f; l1[r] = (j1 <= ii) ? sT[2 * m + 1][r] * exp2f((float)(ii - j1) * lg) : 0.f; }
            const mm::bf16x8 af = mm::pack_acc(l0, l1);
#pragma unroll
            for (int et = 0; et < 8; ++et) aix[et] = mm::mfma16(af, mm::frag_tr_acc(Vs, 144, 32 * m, 16 * et, lane), aix[et]); } }
    float ssq[4], qd[4];
#pragma unroll
    for (int r = 0; r < 4; ++r) { ssq[r] = 0.f; qd[r] = exp2f((float)(16 * w + 4 * gq + r + 1) * lg); }
#pragma unroll
    for (int et = 0; et < 8; ++et)
#pragma unroll
        for (int r = 0; r < 4; ++r) { const float o = aix[et][r] + qd[r] * ain[et][r]; aix[et][r] = o; ssq[r] += o * o; }
#pragma unroll
    for (int r = 0; r < 4; ++r) { float s = ssq[r]; s += __shfl_xor(s, 1); s += __shfl_xor(s, 2); s += __shfl_xor(s, 4); s += __shfl_xor(s, 8); ssq[r] = rsqrtf(s * (1.f / 128.f) + EPS); }
    __syncthreads();
    bf16* Ot = Vs;
#pragma unroll
    for (int et = 0; et < 8; ++et)
#pragma unroll
        for (int r = 0; r < 4; ++r) Ot[(16 * w + 4 * gq + r) * 144 + 16 * et + cl] = (bf16)f2bf(aix[et][r] * ssq[r]);
    __syncthreads();
#pragma unroll
    for (int k = 0; k < 4; ++k) { const int e = tid + NTHR * k, i = e >> 4, cc = (e & 15) * 8; float o[8], g8[8];
        unpack8(*(const v4u*)(Ot + i * 144 + cc), o); unpack8(gbr[k], g8);
#pragma unroll
        for (int k = 0; k < 8; ++k) o[k] *= g8[k];
        *(v4u*)(MIX + (size_t)(r0 + i) * DM + 512 + h * 128 + cc) = pack8(o); }
}
__device__ __forceinline__ void sgu_mfma(Frame& F, int item) {
    const int g = item & 3, c = (item >> 2) & 31, b = item >> 7; const bf16* Z = WSP(bf16, WS_Z); bf16* MIX = WSP(bf16, WS_MIX);
    bf16* Ws = (bf16*)F.lds;
    bf16* Vs = Ws + 128 * 136;
    const int tid = F.tid, r0 = b * SEQ + c * 128; const float* W = INP(22) + (size_t)g * 16384; const float* sgb = INP(23);
    __syncthreads();
    for (int e = tid; e < 128 * 16; e += NTHR) { const int i = e >> 4, cc = (e & 15) * 8; const f32x4 a = *(const f32x4*)(W + i * 128 + cc), bb = *(const f32x4*)(W + i * 128 + cc + 4);
        float f[8] = {a.x, a.y, a.z, a.w, bb.x, bb.y, bb.z, bb.w};
#pragma unroll
        for (int k = 0; k < 8; ++k) if (cc + k > i) f[k] = 0.f;
        *(v4u*)(Ws + i * 136 + cc) = pack8(f);
        *(v4u*)(Vs + i * 144 + cc) = *(const v4u*)(Z + (size_t)(r0 + i) * NOP + YV + g * 128 + cc); }
    __syncthreads();
    v4u ur[4], gr[4];
#pragma unroll
    for (int k = 0; k < 4; ++k) { const int e = tid + NTHR * k; const size_t zo = (size_t)(r0 + (e >> 4)) * NOP + g * 128 + (e & 15) * 8; ur[k] = *(const v4u*)(Z + zo + YU); gr[k] = *(const v4u*)(Z + zo + YGC); }
    const int w = F.wave, lane = F.lane, gq = lane >> 4, cl = lane & 15;
    float sbv[4];
#pragma unroll
    for (int r = 0; r < 4; ++r) sbv[r] = sgb[g * 128 + 16 * w + 4 * gq + r];
    f32x4 acc[8];
#pragma unroll
    for (int dt = 0; dt < 8; ++dt) acc[dt] = (f32x4){0.f, 0.f, 0.f, 0.f};
#pragma unroll
    for (int ks = 0; ks < 4; ++ks) { if (ks <= (w >> 1)) { const mm::bf16x8 af = mm::frag_kc(Ws, 136, 16 * w, 32 * ks, lane);
#pragma unroll
            for (int dt = 0; dt < 8; ++dt) acc[dt] = mm::mfma16(af, mm::frag_tr_std(Vs, 144, 32 * ks, 16 * dt, lane), acc[dt]); } }
    __syncthreads();
    bf16* St = Ws;
#pragma unroll
    for (int r = 0; r < 4; ++r) { const int i = 16 * w + 4 * gq + r; const float sb = sbv[r];
#pragma unroll
        for (int dt = 0; dt < 8; ++dt) St[i * 136 + 16 * dt + cl] = (bf16)f2bf(acc[dt][r] + sb); }
    __syncthreads();
#pragma unroll
    for (int k = 0; k < 4; ++k) { const int e = tid + NTHR * k, i = e >> 4, cc = (e & 15) * 8; float s8[8], u8[8], g8[8];
        unpack8(*(const v4u*)(St + i * 136 + cc), s8); unpack8(ur[k], u8); unpack8(gr[k], g8);
#pragma unroll
        for (int k = 0; k < 8; ++k) s8[k] = gelu_f(u8[k]) * s8[k] * silu_f(g8[k]);
        *(v4u*)(MIX + (size_t)(r0 + i) * DM + g * 128 + cc) = pack8(s8); }
}
__device__ __forceinline__ void ssd_out_mfma(Frame& F, int item) {
    const int g = item & 1, c = (item >> 1) & 31, b = item >> 6; const bf16* Z = WSP(bf16, WS_Z); const bf16* XC = WSP(bf16, WS_XC); bf16* MIX = WSP(bf16, WS_MIX);
    bf16* Xs = (bf16*)F.lds;
    bf16* Cs = Xs + 128 * 272;
    bf16* Bs = Cs + 128 * 144;
    float* cums = (float*)(Bs + 128 * 144);
    float* dths = cums + 512;
    const int tid = F.tid, r0 = b * SEQ + c * 128; const float* Dp = INP(28); const float* nw = INP(29);
    const f32x4 n0 = *(const f32x4*)(nw + g * 256 + (tid & 31) * 8), n1 = *(const f32x4*)(nw + g * 256 + (tid & 31) * 8 + 4);
    __syncthreads();
    for (int e = tid; e < 128 * 32; e += NTHR) { const int j = e >> 5, cc = (e & 31) * 8; *(v4u*)(Xs + j * 272 + cc) = *(const v4u*)(XC + (size_t)(r0 + j) * 1024 + g * 256 + cc); }
    for (int e = tid; e < 128 * 16; e += NTHR) { const int j = e >> 4, cc = (e & 15) * 8; *(v4u*)(Bs + j * 144 + cc) = *(const v4u*)(XC + (size_t)(r0 + j) * 1024 + 512 + g * 128 + cc);
        *(v4u*)(Cs + j * 144 + cc) = *(const v4u*)(XC + (size_t)(r0 + j) * 1024 + 768 + g * 128 + cc); }
    { const int hq = tid >> 7, j = tid & 127; cums[tid] = WSP(float, WS_CUM)[(size_t)(r0 + j) * 8 + g * 4 + hq]; dths[tid] = WSP(float, WS_DTH)[(size_t)(r0 + j) * 8 + g * 4 + hq]; }
    v4u pra[2];
    { const bf16* Pn = WSP(bf16, WS_PBS) + (size_t)((b * 32 + c) * 8 + g * 4) * 8192;
#pragma unroll
      for (int k = 0; k < 2; ++k) { const int e = tid + NTHR * k, p = e >> 4, cc = (e & 15) * 8; pra[k] = *(const v4u*)(Pn + p * 128 + cc); } }
    __syncthreads();
    const int w = F.wave, lane = F.lane, gq = lane >> 4, cl = lane & 15;
    f32x4 cb[8];
#pragma unroll
    for (int a = 0; a < 8; ++a) { cb[a] = (f32x4){0.f, 0.f, 0.f, 0.f};
        if (a <= w) {
#pragma unroll
            for (int ks = 0; ks < 4; ++ks) cb[a] = mm::mfma16(mm::frag_kc(Bs, 144, 16 * a, 32 * ks, lane), mm::frag_kc(Cs, 144, 16 * w, 32 * ks, lane), cb[a]); } }
    __syncthreads();
    bf16* Ps = Bs;
    float* ssqs = dths + 512;
    if (tid < 128) ssqs[tid] = 0.f;
    const int ii = 16 * w + cl;
#pragma unroll 1
    for (int hq = 0; hq < 4; ++hq) { const int h = g * 4 + hq;
#pragma unroll
        for (int k = 0; k < 2; ++k) { const int e = tid + NTHR * k, p = e >> 4, cc = (e & 15) * 8; *(v4u*)(Ps + p * 144 + cc) = pra[k]; }
        __syncthreads();
        if (hq < 3) { const bf16* Pn = WSP(bf16, WS_PBS) + (size_t)((b * 32 + c) * 8 + h + 1) * 8192;
#pragma unroll
            for (int k = 0; k < 2; ++k) { const int e = tid + NTHR * k, p = e >> 4, cc = (e & 15) * 8; pra[k] = *(const v4u*)(Pn + p * 128 + cc); } }
        v4u zgr[2];
#pragma unroll
        for (int k = 0; k < 2; ++k) { const int e = tid + NTHR * k, i = e >> 3, cc = (e & 7) * 8; zgr[k] = *(const v4u*)(Z + (size_t)(r0 + i) * NOP + YZG + h * 64 + cc); }
        f32x4 ain[4], aix[4];
#pragma unroll
        for (int pt = 0; pt < 4; ++pt) { ain[pt] = (f32x4){0.f, 0.f, 0.f, 0.f}; aix[pt] = (f32x4){0.f, 0.f, 0.f, 0.f}; }
#pragma unroll
        for (int ks = 0; ks < 4; ++ks) { const mm::bf16x8 af = mm::frag_kc(Cs, 144, 16 * w, 32 * ks, lane);
#pragma unroll
            for (int pt = 0; pt < 4; ++pt) ain[pt] = mm::mfma16(af, mm::frag_kc(Ps, 144, 16 * pt, 32 * ks, lane), ain[pt]); }
        const float ci = cums[hq * 128 + ii];
#pragma unroll
        for (int m = 0; m < 4; ++m) { if (2 * m <= w) { float l0[4], l1[4];
#pragma unroll
                for (int r = 0; r < 4; ++r) { const int j0 = 32 * m + 4 * gq + r, j1 = j0 + 16;
                    l0[r] = (j0 <= ii) ? cb[2 * m][r] * __expf(ci - cums[hq * 128 + j0]) * dths[hq * 128 + j0] : 0.f;
                    l1[r] = (j1 <= ii) ? cb[2 * m + 1][r] * __expf(ci - cums[hq * 128 + j1]) * dths[hq * 128 + j1] : 0.f; }
                const mm::bf16x8 af = mm::pack_acc(l0, l1);
#pragma unroll
                for (int pt = 0; pt < 4; ++pt) aix[pt] = mm::mfma16(af, mm::frag_tr_acc(Xs, 272, 32 * m, hq * 64 + 16 * pt, lane), aix[pt]); } }
        const float Dh = Dp[h];
        bf16* Yt = Bs + 64 * 144;
#pragma unroll
        for (int r = 0; r < 4; ++r) { const int i = 16 * w + 4 * gq + r; const float ei = __expf(cums[hq * 128 + i]);
#pragma unroll
            for (int pt = 0; pt < 4; ++pt) Yt[i * 72 + 16 * pt + cl] = (bf16)f2bf(aix[pt][r] + ei * ain[pt][r]); }
        __syncthreads();
#pragma unroll
        for (int k = 0; k < 2; ++k) { const int e = tid + NTHR * k, i = e >> 3, cc = (e & 7) * 8; float y8[8], x8[8], z8[8];
            unpack8(*(const v4u*)(Yt + i * 72 + cc), y8); unpack8(*(const v4u*)(Xs + i * 272 + hq * 64 + cc), x8); unpack8(zgr[k], z8);
            float s = 0.f;
#pragma unroll
            for (int k = 0; k < 8; ++k) { y8[k] = (y8[k] + Dh * x8[k]) * silu_f(z8[k]); s += y8[k] * y8[k]; }
            s = red8_dpp(s); if ((e & 7) == 0) ssqs[i] += s;
            *(v4u*)(Xs + i * 272 + hq * 64 + cc) = pack8(y8); }
        __syncthreads();
    }
    for (int e = tid; e < 128 * 32; e += NTHR) { const int i = e >> 5, cc = (e & 31) * 8; const float rstd = rsqrtf(ssqs[i] * (1.f / 256.f) + EPS); float v8[8]; unpack8(*(const v4u*)(Xs + i * 272 + cc), v8);
        v8[0] *= rstd * n0.x; v8[1] *= rstd * n0.y; v8[2] *= rstd * n0.z; v8[3] *= rstd * n0.w; v8[4] *= rstd * n1.x; v8[5] *= rstd * n1.y; v8[6] *= rstd * n1.z; v8[7] *= rstd * n1.w;
        *(v4u*)(MIX + (size_t)(r0 + i) * DM + 512 + g * 256 + cc) = pack8(v8); }
}
__device__ __forceinline__ void mod_item_mfma(Frame& F, int item) {
    const int l = item / 48, nb = item % 48;
    const float* We = INP(12); const float* Wo = INP(19); const float* be = INP(13); const float* bo = INP(20); const float* cpp = INP(8); const float* csp = INP(9);
    const float* W = (l ? Wo : We) + nb * 64; const float* bias = (l ? bo : be) + nb * 64; float* mod = WSP(float, l ? WS_MODO : WS_MODE) + nb * 64;
    bf16* As = (bf16*)F.lds;
    bf16* Ws = As + 144 * 136;
    const int tid = F.tid, lane = F.lane, w = F.wave, nt = w & 3, m0 = w >> 2, gq = lane >> 4, cl = lane & 15;
    f32x4 acc[5];
#pragma unroll
    for (int q = 0; q < 5; ++q) acc[q] = (f32x4){0.f, 0.f, 0.f, 0.f};
    f32x4 ca[5], cbv[5], wa[2], wb[2];
#define MOD_LOAD(k0) do { _Pragma("unroll") for (int k = 0; k < 5; ++k) { const int e = tid + NTHR * k, m = e >> 4, cc = (e & 15) * 8; ca[k] = (f32x4){0.f, 0.f, 0.f, 0.f}; cbv[k] = ca[k]; \
            if (e < 144 * 16 && m < 132) { const float* cr = (m < 4) ? cpp + (size_t)m * DM : csp + (size_t)(m - 4) * DM; ca[k] = *(const f32x4*)(cr + (k0) + cc); cbv[k] = *(const f32x4*)(cr + (k0) + cc + 4); } } \
        _Pragma("unroll") for (int k = 0; k < 2; ++k) { const int e = tid + NTHR * k, kk = e >> 3, cc = (e & 7) * 8; wa[k] = *(const f32x4*)(W + (size_t)((k0) + kk) * 3072 + cc); wb[k] = *(const f32x4*)(W + (size_t)((k0) + kk) * 3072 + cc + 4); } } while (0)
    MOD_LOAD(0);
    for (int k0 = 0; k0 < DM; k0 += 128) {
        __syncthreads();
#pragma unroll
        for (int k = 0; k < 5; ++k) { const int e = tid + NTHR * k, m = e >> 4, cc = (e & 15) * 8;
            if (e < 144 * 16) { float f[8] = {silu_f(ca[k].x), silu_f(ca[k].y), silu_f(ca[k].z), silu_f(ca[k].w), silu_f(cbv[k].x), silu_f(cbv[k].y), silu_f(cbv[k].z), silu_f(cbv[k].w)};
                *(v4u*)(As + m * 136 + cc) = pack8(f); } }
#pragma unroll
        for (int k = 0; k < 2; ++k) { const int e = tid + NTHR * k, kk = e >> 3, cc = (e & 7) * 8; v4u wv; wv.x = pk2(wa[k].x, wa[k].y); wv.y = pk2(wa[k].z, wa[k].w); wv.z = pk2(wb[k].x, wb[k].y); wv.w = pk2(wb[k].z, wb[k].w);
            *(v4u*)(Ws + kk * 72 + cc) = wv; }
        __syncthreads();
        if (k0 + 128 < DM) MOD_LOAD(k0 + 128);
#pragma unroll
        for (int ks = 0; ks < 4; ++ks) { const mm::bf16x8 bfr = mm::frag_tr_std(Ws, 72, 32 * ks, 16 * nt, lane);
#pragma unroll
            for (int q = 0; q < 5; ++q) { const int mt = m0 + 2 * q; if (mt < 9) acc[q] = mm::mfma16(mm::frag_kc(As, 136, 16 * mt, 32 * ks, lane), bfr, acc[q]); } }
    }
#undef MOD_LOAD
    const float bn = bias[16 * nt + cl];
#pragma unroll
    for (int q = 0; q < 5; ++q) { const int mt = m0 + 2 * q;
#pragma unroll
        for (int r = 0; r < 4; ++r) { const int m = 16 * mt + 4 * gq + r; if (mt < 9 && m < 132) mod[(size_t)m * 3072 + 16 * nt + cl] = acc[q][r] + bn; } }
    __syncthreads();
}

template <bool XB16, bool OB16> __device__ __forceinline__ void smp_outproj_item(Frame& F, int item, const bf16* Wt, const void* xsrc, const float* mod, void* out) {
    const int rt = item >> 4, ct = item & 15, row0 = TP + rt * 32, col0 = ct * 64; const bf16* MIX = WSP(bf16, WS_MIX);
    bf16* As = (bf16*)F.lds;
    bf16* Bs = As + 32 * 264;
    const int tid = F.tid, lane = F.lane, w = F.wave, mt = w >> 2, nt = w & 3, gq = lane >> 4, cl = lane & 15;
    f32x4 acc = (f32x4){0.f, 0.f, 0.f, 0.f};
    v4u pa[2], pb[4];
#define SO_LOAD(k0) do { _Pragma("unroll") for (int k = 0; k < 2; ++k) { const int e = tid + NTHR * k; pa[k] = *(const v4u*)(MIX + (size_t)(row0 + (e >> 5)) * DM + (k0) + (e & 31) * 8); } \
        _Pragma("unroll") for (int k = 0; k < 4; ++k) { const int e = tid + NTHR * k; pb[k] = *(const v4u*)(Wt + (size_t)(col0 + (e >> 5)) * DM + (k0) + (e & 31) * 8); } } while (0)
    SO_LOAD(0);
    float xv4[4], gm4[4];
#pragma unroll
    for (int r = 0; r < 4; ++r) { const int rr = row0 + 16 * mt + 4 * gq + r, cc = col0 + 16 * nt + cl; const size_t o = (size_t)(rr - TP) * DM + cc;
        xv4[r] = XB16 ? bf2f(((const bf16*)xsrc)[o]) : ((const float*)xsrc)[o]; gm4[r] = mod[(size_t)mod_row(rr) * 3072 + 2048 + cc]; }
    for (int k0 = 0; k0 < DM; k0 += 256) {
        __syncthreads();
#pragma unroll
        for (int k = 0; k < 2; ++k) { const int e = tid + NTHR * k; *(v4u*)(As + (e >> 5) * 264 + (e & 31) * 8) = pa[k]; }
#pragma unroll
        for (int k = 0; k < 4; ++k) { const int e = tid + NTHR * k; *(v4u*)(Bs + (e >> 5) * 264 + (e & 31) * 8) = pb[k]; }
        __syncthreads();
        if (k0 + 256 < DM) SO_LOAD(k0 + 256);
#pragma unroll
        for (int ks = 0; ks < 8; ++ks) acc = mm::mfma16(mm::frag_kc(As, 264, 16 * mt, 32 * ks, lane), mm::frag_kc(Bs, 264, 16 * nt, 32 * ks, lane), acc);
    }
#undef SO_LOAD
#pragma unroll
    for (int r = 0; r < 4; ++r) { const int rr = row0 + 16 * mt + 4 * gq + r, cc = col0 + 16 * nt + cl; const size_t o = (size_t)(rr - TP) * DM + cc;
        const float ov = xv4[r] + gm4[r] * acc[r];
        if (OB16) ((bf16*)out)[o] = (bf16)f2bf(ov); else ((float*)out)[o] = ov; }
    __syncthreads();
}
constexpr int NPHASE = 14;
struct Args { const float* in[31]; float* out; unsigned char* ws; int ph_lo, ph_hi; };
__global__ void __launch_bounds__(NTHR, 2) fwd_kernel(Args args) {
    extern __shared__ __attribute__((aligned(16))) unsigned char lds[];
    Frame F;
    F.lds = lds; F.tid = threadIdx.x; F.lane = F.tid & 63; F.wave = __builtin_amdgcn_readfirstlane(F.tid >> 6); F.G = gridDim.x;
    F.out = args.out; F.ws = args.ws;
    volatile LAS unsigned* MISC = (volatile LAS unsigned*)((LAS unsigned char*)lds + MISC_OFF);
    if (F.tid < 64) MISC[F.tid] = 0u;
    __syncthreads();
    const int lo = args.ph_lo, hi = args.ph_hi;
    XcdBarrier bar; bar.bar = (unsigned*)(F.ws + WS_CTL) + CW_BAR; bar.x = 0; bar.st = MISC + 8;
    if (hi - lo > 1) bar = xcd_barrier_post((unsigned*)(F.ws + WS_CTL) + CW_BAR, MISC + 8);
#ifndef DBL
#define DBL 0
#endif
#ifndef PH_MASK
#define PH_MASK 0xffff
#endif
#define IN(k) (((PH_MASK >> (k)) & 1) && lo <= (k) && (k) < hi)
#define SEAM(k) do { if (IN(k) && IN((k) + 1)) xcd_barrier(bar); } while (0)
#define REFRESH() do { int tz_ = threadIdx.x; asm volatile("" : "+v"(tz_)); F.tid = tz_; F.lane = tz_ & 63; } while (0)
    LAS unsigned char* ldsl = (LAS unsigned char*)lds;
    const int bx = blockIdx.x, G = F.G;
    const int vx = (G % 8 == 0) ? (bx % 8) * (G / 8) + bx / 8 : bx;

    if (IN(0)) { REFRESH(); for (int it = G - 1 - bx; it < 96; it += G) mod_item_mfma(F, it);
        rope_phase(F); weights_phase(F, G > 96 ? G - 96 : G); } SEAM(0);
    if (IN(1)) { REFRESH(); normmod_phase<false>(F, INP(0), INP(1), INP(11), WSP(float, WS_MODE)); } SEAM(1);
    if (IN(2)) { REFRESH(); pg8::Gemm g{WSP(bf16, WS_H), WSP(bf16, WS_WINE), MR, NE, DM}; pg8::StaticOrder S; S.init(MR, NE, G, bx);
        EpiL0 E{WSP(bf16, WS_Z), F.out, INP(15), INP(16), WSP(f32x2, WS_ROPE), WSP(float, WS_KMEAN), (float*)(lds + XCH_OFF)}; pg8::gemm_phase<EpiL0, pg8::StaticOrder, true, true>(ldsl, g, S, E); } SEAM(2);
    if (IN(3)) { REFRESH();
        const bool attn_first = (vx & 1) == 0;
        if (!attn_first) { for (int it = bx; it < 1536; it += G) { if (it < 512) kv_local_item<false>(F, it); else { smp_pass1_item(F, it - 512); REFRESH(); } } __syncthreads(); }
        { typedef attn_body::bf16 abf; const abf* Zb = (const abf*)WSP(bf16, WS_Z); abf* MX = (abf*)WSP(bf16, WS_MIX); const float* kpart = WSP(float, WS_KPART); const float* relb = INP(10);
          for (int pi = vx; pi < 256; pi += G) { const int bh = pi >> 3, s = pi & 7;
              attn_body::attn_unit<8>(bh >> 3, bh & 7, 15 - s, Zb + ZQA, Zb + ZKA, Zb + ZVA, Zb + ZGA, MX, kpart, relb, (char*)lds, true);
              attn_body::attn_unit<8>(bh >> 3, bh & 7, s, Zb + ZQA, Zb + ZKA, Zb + ZVA, Zb + ZGA, MX, kpart, relb, (char*)lds, false); } }
        if (attn_first) { for (int it = bx; it < 1536; it += G) { if (it < 512) kv_local_item<false>(F, it); else { smp_pass1_item(F, it - 512); REFRESH(); } } }
    } SEAM(3);
    if (IN(4)) { REFRESH(); ret_scan_phase(F); for (int it = bx; it < 1024; it += G) smp_pass2_item(F, it); } SEAM(4);
    if (IN(5)) { REFRESH(); for (int rep_ = 0; rep_ <= ((DBL >> 0) & 1); ++rep_) for (int it = bx; it < 1024; it += G) { if (it < 512) ret_out_mfma(F, it); else smp_ret_item(F, it - 512); } } SEAM(5);
    if (IN(6)) { REFRESH(); pg8::Gemm g{WSP(bf16, WS_MIX), WSP(bf16, WS_WOUTE), TP, DM, DM}; pg8::StaticOrder S; S.init(TP, DM, G, bx);
        EpiRes<false, true> E{INP(0), INP(1), WSP(float, WS_MODE), WSP(bf16, WS_X1)}; pg8::gemm_phase<EpiRes<false, true>, pg8::StaticOrder, true, true>(ldsl, g, S, E);
        for (int it = bx; it < 256; it += G) smp_outproj_item<false, true>(F, it, WSP(bf16, WS_WOUTE), INP(1), WSP(float, WS_MODE), WSP(bf16, WS_X1) + (size_t)TP * DM); } SEAM(6);
    if (IN(7)) { REFRESH(); normmod_phase<true>(F, WSP(bf16, WS_X1), WSP(bf16, WS_X1) + (size_t)TP * DM, INP(18), WSP(float, WS_MODO)); } SEAM(7);
    if (IN(8)) { REFRESH(); pg8::Gemm g{WSP(bf16, WS_H), WSP(bf16, WS_WINO), MR, NOP, DM}; pg8::StaticOrder S; S.init(MR, NOP, G, bx);
        EpiZ E{WSP(bf16, WS_Z), NOP, WSP(float, WS_DTRAW)}; pg8::gemm_phase<EpiZ, pg8::StaticOrder, true, true>(ldsl, g, S, E); } SEAM(8);
    if (IN(9)) { REFRESH(); post1_phase(F); } SEAM(9);
    if (IN(10)) { REFRESH(); for (int rep_ = 0; rep_ <= ((DBL >> 1) & 1); ++rep_) for (int it = vx; it < 1536; it += G) { if (it < 1024) kv_local_item<true>(F, it); else sgu_mfma(F, it - 1024); } } SEAM(10);
    if (IN(11)) { REFRESH(); ssd_scan_phase(F); for (int rep_ = 0; rep_ <= ((DBL >> 2) & 1); ++rep_) for (int it = bx; it < 256; it += G) smp_l1_item(F, it); } SEAM(11);
    if (IN(12)) { REFRESH(); for (int rep_ = 0; rep_ <= ((DBL >> 3) & 1); ++rep_) for (int it = vx; it < 256; it += G) ssd_out_mfma(F, it); } SEAM(12);
    if (IN(13)) { REFRESH(); pg8::Gemm g{WSP(bf16, WS_MIX), WSP(bf16, WS_WOUTO), TP, DM, DM}; pg8::StaticOrder S; S.init(TP, DM, G, bx);
        EpiRes<true, false> E{WSP(bf16, WS_X1), WSP(bf16, WS_X1) + (size_t)TP * DM, WSP(float, WS_MODO), F.out + O_YP}; pg8::gemm_phase<EpiRes<true, false>, pg8::StaticOrder, true, true>(ldsl, g, S, E);
        for (int it = bx; it < 256; it += G) smp_outproj_item<true, false>(F, it, WSP(bf16, WS_WOUTO), WSP(bf16, WS_X1) + (size_t)TP * DM, WSP(float, WS_MODO), F.out + O_YS); }
#undef IN
#undef SEAM
}

#ifndef N_LAUNCH_MODE
#define N_LAUNCH_MODE 1
#endif
extern "C" void kernel_launch(void* const* d_in, const int* in_sizes, int n_in, void* d_out, int out_size, void* d_ws, size_t ws_size, hipStream_t stream) {
    static int grid = 0;
    if (grid == 0) {
        if (n_in != 31 || out_size != (int)O_END || ws_size < WS_END) { fprintf(stderr, "kernel_launch: unexpected problem shape (n_in %d, out %d, ws %zu)\n", n_in, out_size, ws_size); grid = -1; return; }
        int dev = 0, cus = 0, per_cu = 0;
        if (hipGetDevice(&dev) != hipSuccess || hipDeviceGetAttribute(&cus, hipDeviceAttributeMultiprocessorCount, dev) != hipSuccess) { grid = -1; return; }
        if (hipFuncSetAttribute((const void*)fwd_kernel, hipFuncAttributeMaxDynamicSharedMemorySize, LDS_BYTES) != hipSuccess) { fprintf(stderr, "kernel_launch: hipFuncSetAttribute failed\n"); grid = -1; return; }
        if (hipOccupancyMaxActiveBlocksPerMultiprocessor(&per_cu, (const void*)fwd_kernel, NTHR, LDS_BYTES) != hipSuccess || per_cu < 1) fprintf(stderr, "kernel_launch: occupancy query reports %d\n", per_cu);
        (void)hipGetLastError();
        grid = cus;
    }
    if (grid < 0) return;
    (void)hipMemsetAsync((char*)d_ws + WS_CTL, 0, CTL_ZERO_BYTES, stream);
    Args a{};
    for (int i = 0; i < 31; ++i) a.in[i] = (const float*)d_in[i];
    a.out = (float*)d_out; a.ws = (unsigned char*)d_ws;
#if N_LAUNCH_MODE == 1
    a.ph_lo = 0; a.ph_hi = NPHASE;
    hipLaunchKernelGGL(fwd_kernel, dim3(grid), dim3(NTHR), LDS_BYTES, stream, a);
#else
    for (int k = 0; k < NPHASE; ++k) { a.ph_lo = k; a.ph_hi = k + 1; hipLaunchKernelGGL(fwd_kernel, dim3(grid), dim3(NTHR), LDS_BYTES, stream, a); }
#endif
}
```
